# Optimizing an MI355X kernel written in HIP

```python
import math
import jax, jax.numpy as jnp
from jax import lax
import numpy as np

D_MODEL = 2048
BATCH = 4
SEQ = 4096
DEPTH = 2

GRID_W = 64
CTX_LEN = 256
HEAD_DIM = 128
N_MIXERS = 4
GROUP_WIDTH = D_MODEL // N_MIXERS
N_GROUP_HEADS = GROUP_WIDTH // HEAD_DIM
N_KV_HEADS = N_GROUP_HEADS // 2
KV_WIDTH = N_KV_HEADS * HEAD_DIM
NA_ROWS = 8
NA_COLS = 16
Q_BLOCK = 128
ROPE_THETA = 10000.0
NORM_EPS = 1e-6
D_FF_DENSE = 5632
N_EXPERTS = 8
TOP_K = 2
D_FF_EXPERT = 7168
N_DENSE_LAYERS = (DEPTH + 1) // 2
N_MOE_LAYERS = DEPTH // 2

OFF_CONV_B = GROUP_WIDTH
OFF_CONV_C = 2 * GROUP_WIDTH
OFF_CONV_V = 3 * GROUP_WIDTH
OFF_NA_Q = 4 * GROUP_WIDTH
OFF_NA_K = 5 * GROUP_WIDTH
OFF_NA_V = 6 * GROUP_WIDTH
OFF_GQA_Q = 7 * GROUP_WIDTH
OFF_GQA_K = 8 * GROUP_WIDTH
OFF_GQA_V = 8 * GROUP_WIDTH + KV_WIDTH
IN_WIDTH = 8 * GROUP_WIDTH + 2 * KV_WIDTH

kernel_name = 'hybrid_parallel_group_diffusion_block'


def rms_norm(x, g):
    xf = x.astype(jnp.float32)
    y = xf * lax.rsqrt(jnp.mean(xf * xf, axis=-1, keepdims=True) + NORM_EPS)
    return (y * g.astype(jnp.float32)).astype(x.dtype)


def modulate(h, shift, scale):
    return h * (1 + scale) + shift


def heads(t):
    return t.reshape(t.shape[:-1] + (-1, HEAD_DIM))


def rope_tables(n_tokens):
    pos = jnp.arange(n_tokens)
    row = (pos // GRID_W).astype(jnp.float32)
    col = (pos % GRID_W).astype(jnp.float32)
    quarter = HEAD_DIM // 4
    inv = 1.0 / (ROPE_THETA ** (jnp.arange(quarter, dtype=jnp.float32) / quarter))
    ang_r = row[:, None] * inv
    ang_c = col[:, None] * inv
    return (jnp.cos(ang_r)[:, None, :], jnp.sin(ang_r)[:, None, :], jnp.cos(ang_c)[:, None, :], jnp.sin(ang_c)[:, None, :])


def _rotate(x, cos, sin):
    x1, x2 = jnp.split(x, 2, axis=-1)
    return jnp.concatenate([x1 * cos - x2 * sin, x2 * cos + x1 * sin], axis=-1)


def axial_rope(x, tables):
    cos_r, sin_r, cos_c, sin_c = tables
    xf = x.astype(jnp.float32)
    half = HEAD_DIM // 2
    out = jnp.concatenate([_rotate(xf[..., :half], cos_r, sin_r), _rotate(xf[..., half:], cos_c, sin_c)], axis=-1)
    return out.astype(x.dtype)


def fourier_mix(u, w_four):
    b, l, _ = u.shape
    uf = u.reshape(b, l, N_GROUP_HEADS, HEAD_DIM).astype(jnp.float32)
    spec = jnp.fft.fft2(uf, axes=(1, 3), norm='ortho').real.astype(u.dtype)
    y = jnp.einsum('blhd,hde->blhe', spec, w_four)
    return y.reshape(b, l, GROUP_WIDTH)


def short_conv_mix(gate_b, gate_c, val, conv_w):
    z = gate_c * val
    zp = jnp.pad(z, ((0, 0), (1, 1), (0, 0)))
    y = conv_w[0] * zp[:, :-2] + conv_w[1] * zp[:, 1:-1] + conv_w[2] * zp[:, 2:]
    return gate_b * y


def attend(q, k, v):
    s = jnp.einsum('bqhgd,bkhd->bhgqk', q, k, preferred_element_type=jnp.float32) * (HEAD_DIM ** -0.5)
    p = jax.nn.softmax(s, axis=-1).astype(v.dtype)
    return jnp.einsum('bhgqk,bkhd->bqhgd', p, v)


def gqa_latent(q, k, v, kc, vc):
    b, s, hq, dh = q.shape
    g = hq // N_KV_HEADS
    nb = s // Q_BLOCK
    k_all = jnp.concatenate([kc, k], axis=1)
    v_all = jnp.concatenate([vc, v], axis=1)
    qb = q.reshape(b, nb, Q_BLOCK, N_KV_HEADS, g, dh).transpose(1, 0, 2, 3, 4, 5)
    o = lax.map(lambda blk: attend(blk, k_all, v_all), qb)
    return o.transpose(1, 0, 2, 3, 4, 5).reshape(b, s, hq, dh)


def neighborhood_attention(q, k, v, kc, vc, rpb):
    b, s, h, dh = q.shape
    rows = s // GRID_W
    kr = min(NA_ROWS, rows)
    qg = q.reshape(b, rows, GRID_W, h, dh).transpose(1, 0, 3, 2, 4)
    kg = k.reshape(b, rows, GRID_W, h, dh).transpose(0, 3, 1, 2, 4)
    vg = v.reshape(b, rows, GRID_W, h, dh).transpose(0, 3, 1, 2, 4)
    kct = kc.transpose(0, 2, 1, 3)
    vct = vc.transpose(0, 2, 1, 3)
    cols = np.arange(GRID_W)
    col_start = np.clip(cols - NA_COLS // 2, 0, GRID_W - NA_COLS)
    col_idx = col_start[:, None] + np.arange(NA_COLS)[None, :]
    dc_idx = col_idx - cols[:, None] + (NA_COLS - 1)
    n_win = kr * NA_COLS
    scale = HEAD_DIM ** -0.5

    def row_block(args):
        r, q_r = args
        rs = jnp.clip(r - kr // 2, 0, rows - kr)
        k_win = lax.dynamic_slice_in_dim(kg, rs, kr, axis=2)[:, :, :, col_idx, :]
        v_win = lax.dynamic_slice_in_dim(vg, rs, kr, axis=2)[:, :, :, col_idx, :]
        dr_idx = rs + jnp.arange(kr) - r + (NA_ROWS - 1)
        bias = rpb[:, dr_idx[None, :, None], dc_idx[:, None, :]].astype(jnp.float32)
        s_win = jnp.einsum('bhqd,bhrqcd->bhqrc', q_r, k_win, preferred_element_type=jnp.float32) * scale + bias[None]
        s_ctx = jnp.einsum('bhqd,bhkd->bhqk', q_r, kct, preferred_element_type=jnp.float32) * scale
        p = jax.nn.softmax(jnp.concatenate([s_win.reshape(b, h, GRID_W, n_win), s_ctx], axis=-1), axis=-1).astype(v.dtype)
        p_win = p[..., :n_win].reshape(b, h, GRID_W, kr, NA_COLS)
        return jnp.einsum('bhqrc,bhrqcd->bhqd', p_win, v_win) + jnp.einsum('bhqk,bhkd->bhqd', p[..., n_win:], vct)

    out = lax.map(row_block, (jnp.arange(rows), qg))
    return out.transpose(1, 0, 3, 2, 4).reshape(b, s, h, dh)


def hybrid_mixer(h, h_c, w_in, w_out, w_four, conv_w, rpb, na_q_g, na_k_g, gqa_q_g, gqa_k_g, rope, ctx_out):
    b, s, _ = h.shape
    bc, lc, _ = h_c.shape
    g = N_GROUP_HEADS // N_KV_HEADS
    p = h @ w_in
    if ctx_out:
        pc = h_c @ w_in
        na_kv_c = pc[..., OFF_NA_K:OFF_GQA_Q]
        gqa_kv_c = pc[..., OFF_GQA_K:]
    else:
        na_kv_c = h_c @ w_in[:, OFF_NA_K:OFF_GQA_Q]
        gqa_kv_c = h_c @ w_in[:, OFF_GQA_K:]
    na_kc = rms_norm(heads(na_kv_c[..., :GROUP_WIDTH]), na_k_g)
    na_vc = heads(na_kv_c[..., GROUP_WIDTH:])
    gqa_kc = rms_norm(heads(gqa_kv_c[..., :KV_WIDTH]), gqa_k_g)
    gqa_vc = heads(gqa_kv_c[..., KV_WIDTH:])
    y_four = fourier_mix(p[..., :OFF_CONV_B], w_four)
    y_conv = short_conv_mix(p[..., OFF_CONV_B:OFF_CONV_C], p[..., OFF_CONV_C:OFF_CONV_V], p[..., OFF_CONV_V:OFF_NA_Q], conv_w)
    na_q = rms_norm(heads(p[..., OFF_NA_Q:OFF_NA_K]), na_q_g)
    na_k = rms_norm(heads(p[..., OFF_NA_K:OFF_NA_V]), na_k_g)
    na_v = heads(p[..., OFF_NA_V:OFF_GQA_Q])
    y_na = neighborhood_attention(na_q, na_k, na_v, na_kc, na_vc, rpb).reshape(b, s, GROUP_WIDTH)
    gq = axial_rope(rms_norm(heads(p[..., OFF_GQA_Q:OFF_GQA_K]), gqa_q_g), rope)
    gk = axial_rope(rms_norm(heads(p[..., OFF_GQA_K:OFF_GQA_V]), gqa_k_g), rope)
    gv = heads(p[..., OFF_GQA_V:])
    y_gqa = gqa_latent(gq, gk, gv, gqa_kc, gqa_vc).reshape(b, s, GROUP_WIDTH)
    y = jnp.concatenate([y_four, y_conv, y_na, y_gqa], axis=-1) @ w_out
    if not ctx_out:
        return y, None
    yc_four = fourier_mix(pc[..., :OFF_CONV_B], w_four)
    yc_conv = short_conv_mix(pc[..., OFF_CONV_B:OFF_CONV_C], pc[..., OFF_CONV_C:OFF_CONV_V], pc[..., OFF_CONV_V:OFF_NA_Q], conv_w)
    na_qc = rms_norm(heads(pc[..., OFF_NA_Q:OFF_NA_K]), na_q_g)
    yc_na = attend(na_qc[:, :, :, None, :], na_kc, na_vc).reshape(bc, lc, GROUP_WIDTH)
    gqc = rms_norm(heads(pc[..., OFF_GQA_Q:OFF_GQA_K]), gqa_q_g).reshape(bc, lc, N_KV_HEADS, g, HEAD_DIM)
    yc_gqa = attend(gqc, gqa_kc, gqa_vc).reshape(bc, lc, GROUP_WIDTH)
    yc = jnp.concatenate([yc_four, yc_conv, yc_na, yc_gqa], axis=-1) @ w_out
    return y, yc


def swiglu(h, w1, w3, w2):
    return (jax.nn.silu(h @ w1) * (h @ w3)) @ w2


def moe_swiglu(h, w_router, w1, w3, w2):
    logits = jnp.einsum('bld,de->ble', h, w_router, preferred_element_type=jnp.float32)
    top_val, top_idx = lax.top_k(logits, TOP_K)
    top_w = jax.nn.softmax(top_val, axis=-1)
    combine = jnp.sum(jax.nn.one_hot(top_idx, N_EXPERTS, dtype=jnp.float32) * top_w[..., None], axis=-2).astype(h.dtype)
    y = jnp.zeros_like(h)
    for e in range(N_EXPERTS):
        y = y + combine[..., e:e + 1] * swiglu(h, w1[e], w3[e], w2[e])
    return y


def channel_mixer(t, layer, ffn_w1, ffn_w3, ffn_w2, moe_router, moe_w1, moe_w3, moe_w2):
    i = layer // 2
    if layer % 2 == 0:
        return swiglu(t, ffn_w1[i], ffn_w3[i], ffn_w2[i])
    return moe_swiglu(t, moe_router[i], moe_w1[i], moe_w3[i], moe_w2[i])


def setup_inputs(seed: int = 0) -> dict:
    key = jax.random.key(seed)
    ks = jax.random.split(key, 24)
    f32 = jnp.float32
    D = D_MODEL

    def nrm(k, shape, scale):
        return jax.random.normal(k, shape, f32) * scale

    return {
        'x': nrm(ks[0], (BATCH, SEQ, D), 1.0),
        'c': nrm(ks[1], (BATCH, D), 1.0),
        'ctx': nrm(ks[2], (BATCH, CTX_LEN, D), 1.0),
        'c_ctx': nrm(ks[3], (D,), 1.0),
        'norm1_g': 1.0 + nrm(ks[4], (DEPTH, D), 0.1),
        'norm2_g': 1.0 + nrm(ks[5], (DEPTH, D), 0.1),
        'w_ada': nrm(ks[6], (DEPTH, D, 6 * D), 0.5 * D ** -0.5),
        'b_ada': nrm(ks[7], (DEPTH, 6 * D), 0.02),
        'w_in': nrm(ks[8], (DEPTH, D, IN_WIDTH), D ** -0.5),
        'w_out': nrm(ks[9], (DEPTH, D, D), D ** -0.5),
        'w_fourier': nrm(ks[10], (DEPTH, N_GROUP_HEADS, HEAD_DIM, HEAD_DIM), HEAD_DIM ** -0.5),
        'conv_w': nrm(ks[11], (DEPTH, 3, GROUP_WIDTH), 3 ** -0.5),
        'na_rpb': nrm(ks[12], (DEPTH, N_GROUP_HEADS, 2 * NA_ROWS - 1, 2 * NA_COLS - 1), 0.5),
        'na_q_g': 1.0 + nrm(ks[13], (DEPTH, HEAD_DIM), 0.1),
        'na_k_g': 1.0 + nrm(ks[14], (DEPTH, HEAD_DIM), 0.1),
        'gqa_q_g': 1.0 + nrm(ks[15], (DEPTH, HEAD_DIM), 0.1),
        'gqa_k_g': 1.0 + nrm(ks[16], (DEPTH, HEAD_DIM), 0.1),
        'ffn_w1': nrm(ks[17], (N_DENSE_LAYERS, D, D_FF_DENSE), D ** -0.5),
        'ffn_w3': nrm(ks[18], (N_DENSE_LAYERS, D, D_FF_DENSE), D ** -0.5),
        'ffn_w2': nrm(ks[19], (N_DENSE_LAYERS, D_FF_DENSE, D), D_FF_DENSE ** -0.5),
        'moe_router': nrm(ks[20], (N_MOE_LAYERS, D, N_EXPERTS), D ** -0.5),
        'moe_w1': nrm(ks[21], (N_MOE_LAYERS, N_EXPERTS, D, D_FF_EXPERT), D ** -0.5),
        'moe_w3': nrm(ks[22], (N_MOE_LAYERS, N_EXPERTS, D, D_FF_EXPERT), D ** -0.5),
        'moe_w2': nrm(ks[23], (N_MOE_LAYERS, N_EXPERTS, D_FF_EXPERT, D), D_FF_EXPERT ** -0.5),
    }


def reference(x, c, ctx, c_ctx, norm1_g, norm2_g, w_ada, b_ada, w_in, w_out, w_fourier, conv_w, na_rpb, na_q_g, na_k_g, gqa_q_g, gqa_k_g, ffn_w1, ffn_w3, ffn_w2, moe_router, moe_w1, moe_w3, moe_w2):
    rope = rope_tables(x.shape[1])
    cond = jax.nn.silu(c)
    cond_ctx = jax.nn.silu(c_ctx)
    ctx_s = ctx
    for layer in range(DEPTH):
        last = layer == DEPTH - 1
        mod = cond @ w_ada[layer] + b_ada[layer]
        mod_c = cond_ctx @ w_ada[layer] + b_ada[layer]
        sh1, sc1, g1, sh2, sc2, g2 = jnp.split(mod[:, None, :], 6, axis=-1)
        sh1c, sc1c, g1c, sh2c, sc2c, g2c = jnp.split(mod_c, 6, axis=-1)
        h = modulate(rms_norm(x, norm1_g[layer]), sh1, sc1)
        hc = modulate(rms_norm(ctx_s, norm1_g[layer]), sh1c, sc1c)
        y, yc = hybrid_mixer(h, hc, w_in[layer], w_out[layer], w_fourier[layer], conv_w[layer], na_rpb[layer],
                             na_q_g[layer], na_k_g[layer], gqa_q_g[layer], gqa_k_g[layer], rope, not last)
        x = x + g1 * y
        h2 = modulate(rms_norm(x, norm2_g[layer]), sh2, sc2)
        x = x + g2 * channel_mixer(h2, layer, ffn_w1, ffn_w3, ffn_w2, moe_router, moe_w1, moe_w3, moe_w2)
        if not last:
            ctx_s = ctx_s + g1c * yc
            h2c = modulate(rms_norm(ctx_s, norm2_g[layer]), sh2c, sc2c)
            ctx_s = ctx_s + g2c * channel_mixer(h2c, layer, ffn_w1, ffn_w3, ffn_w2, moe_router, moe_w1, moe_w3, moe_w2)
    return x
```

```cpp
#include <hip/hip_runtime.h>
#include <hip/hip_bf16.h>
#include <cstdio>
#include <cstdint>

#ifndef PROBE_DUP
#define PROBE_DUP 0u
#endif
#ifndef PROBE_SUB
#define PROBE_SUB 0u
#endif
#define SUBDUP(k) for (int _q = 0; _q < 1 + (int)((PROBE_SUB >> (k)) & 1u); ++_q)
#define DUP(k) for (int _r = 0; _r < 1 + (int)((PROBE_DUP >> (k)) & 1u); ++_r)
#define EN(k) (((PM) >> (k)) & 1u)
#define MX(k) (((MM) >> (k)) & 1u)
#ifndef MK_ONE_LAUNCH
#define MK_ONE_LAUNCH 1
#endif

#define LAS __attribute__((address_space(3)))
typedef unsigned short bf16_t;
typedef short bf16x8 __attribute__((ext_vector_type(8)));
typedef short s16x4 __attribute__((ext_vector_type(4)));
typedef float f32x4 __attribute__((ext_vector_type(4)));
typedef float f32x2 __attribute__((ext_vector_type(2)));
typedef float f32x16 __attribute__((ext_vector_type(16)));
typedef unsigned u32x4 __attribute__((ext_vector_type(4)));
typedef unsigned u32x2 __attribute__((ext_vector_type(2)));

constexpr int DM = 2048, NB = 4, SEQ = 4096, CTXL = 256;
constexpr int RL = NB * SEQ, RC = NB * CTXL, RT = RL + RC;
constexpr int NP = 4608;
constexpr int INW = 4608;
constexpr int KVL = CTXL + SEQ;
constexpr int DFF = 5632, NEXP = 8, DFE = 7168;
constexpr int MOE_TILES_MAX = 2 * RL / 256 + NEXP;
constexpr int MOE_ROWS_MAX = MOE_TILES_MAX * 256;
constexpr float NORM_EPS = 1e-6f;
constexpr int PC_V = 0, PC_CB = 512, PC_CC = 1024, PC_CV = 1536, PC_NQ = 2048, PC_NK = 2560, PC_NV = 3072, PC_GQ = 3584, PC_GK = 4096, PC_GV = 4352;
constexpr int PFW = 1024;

constexpr size_t MiB = 1u << 20;
constexpr size_t WS_CTL = 0, CTL_ZERO_BYTES = 1 * MiB;
constexpr size_t WS_MOD = 1 * MiB;
constexpr size_t WS_ROPE = 1 * MiB + 512 * 1024;
constexpr size_t WS_ROUTE = 2 * MiB;
constexpr size_t WS_T = 3 * MiB;
constexpr size_t WS_MB = 37 * MiB;
constexpr size_t WS_FFT = 1 * MiB + 768 * 1024;
constexpr size_t WS_TC = 67 * MiB;
constexpr size_t WS_WIN = 68 * MiB;
constexpr size_t WS_WOUT = 108 * MiB;
constexpr size_t WS_WUP = 124 * MiB;
constexpr size_t WS_WDN = 168 * MiB;
constexpr size_t WS_MUP = 190 * MiB;
constexpr size_t WS_MDN = 638 * MiB;
constexpr size_t WS_X1 = 862 * MiB;
constexpr size_t WS_X2 = 998 * MiB;
constexpr size_t WS_HB = 1134 * MiB;
constexpr size_t WS_S = 1202 * MiB;
constexpr size_t WS_P = WS_S;
constexpr size_t WS_NQ = WS_S + 170 * MiB;
constexpr size_t WS_NK = WS_NQ + 17 * MiB;
constexpr size_t WS_NV = WS_NK + 17 * MiB;
constexpr size_t WS_GQ = WS_NV + 17 * MiB;
constexpr size_t WS_GK = WS_GQ + 17 * MiB;
constexpr size_t WS_GV = WS_GK + 9 * MiB;
constexpr size_t WS_PF = WS_GV + 9 * MiB;
constexpr size_t WS_PTC = WS_PF + 34 * MiB;
constexpr size_t WS_Y = WS_PTC + 2 * MiB;
constexpr size_t WS_ACT = WS_S;
constexpr size_t WS_APERM = WS_S;
constexpr size_t WS_ACTM = WS_S + 136 * MiB;
constexpr size_t WS_OPERM = WS_X2;
constexpr size_t WS_END = WS_ACTM + 240 * MiB;
static_assert(WS_Y + 68 * MiB <= WS_END && WS_ACT + 187 * MiB <= WS_Y, "ws map");

constexpr int CW_BAR = 4096;
constexpr int CW_CNT = 8192;
constexpr int CW_POOL = 9344;
constexpr int CW_KS = 11264;
constexpr int CW_CDF = 9408;
constexpr int CW_TILE = 10240;

constexpr int LDS_BYTES = 147456;
constexpr int MISC_OFF = 131072;
constexpr int TL_OFF = MISC_OFF + 12288;
constexpr int RPB_OFF = MISC_OFF + 1024 + 512;
constexpr int ROUTER_LDS = 0;

#define GAS __attribute__((address_space(1)))
#define RLX_AGENT __ATOMIC_RELAXED, __HIP_MEMORY_SCOPE_AGENT
#define LDS_WAIT() asm volatile("s_waitcnt lgkmcnt(0)" ::: "memory")
#define VM_WAIT() asm volatile("s_waitcnt vmcnt(0)" ::: "memory")

__device__ __forceinline__ unsigned cvt_pk_bf16(float lo, float hi) { unsigned r; asm volatile("v_cvt_pk_bf16_f32 %0, %1, %2" : "=v"(r) : "v"(lo), "v"(hi)); return r; }
__device__ __forceinline__ float bf_lo(unsigned w) { return __uint_as_float(w << 16); }
__device__ __forceinline__ float bf_hi(unsigned w) { return __uint_as_float(w & 0xffff0000u); }
__device__ __forceinline__ f32x4 bf4(u32x2 w) { f32x4 r; r[0] = bf_lo(w.x); r[1] = bf_hi(w.x); r[2] = bf_lo(w.y); r[3] = bf_hi(w.y); return r; }
__device__ __forceinline__ float wave_sum(float v) {
#pragma unroll
    for (int o = 1; o < 64; o <<= 1) v += __shfl_xor(v, o);
    return v;
}
constexpr float F8_SW = 64.0f, F8_SH = 2.0f, F8_SA = 4.0f;
__device__ __forceinline__ float clamp448(float x) { return __builtin_amdgcn_fmed3f(x, -448.0f, 448.0f); }
__device__ __forceinline__ unsigned pk4_fp8(float a, float b, float c, float d) { int w = 0; w = __builtin_amdgcn_cvt_pk_fp8_f32(clamp448(a), clamp448(b), w, false); w = __builtin_amdgcn_cvt_pk_fp8_f32(clamp448(c), clamp448(d), w, true); return (unsigned)w; }
__device__ __forceinline__ float silu_f(float a) { return a / (1.0f + __expf(-a)); }

namespace pg8 {
constexpr int BM = 256, BK = 64, HALF = 128, HTB = HALF * BK * 2, STAGE_BYTES = 8 * HTB, NXCD = 8, WGM = 8;
__host__ __device__ __forceinline__ int lds_byte(int r, int c) { const int st = (r >> 4) * 2 + (c >> 5), rr = r & 15, cc = c & 31, ob = rr * 64 + cc * 2; return st * 1024 + (ob ^ (((ob >> 9) & 1) << 5)); }
__host__ __device__ __forceinline__ void stage_rc(int b, int& R, int& C) { const int st = b / 1024, sb = b % 1024, swz = sb ^ (((sb >> 9) & 1) << 5); R = (st >> 1) * 16 + swz / 64; C = (st & 1) * 32 + (swz % 64) / 2; }
__host__ __device__ __forceinline__ int perm32(int rho) { const int n = rho >> 4, i = rho & 15; return 8 * (i >> 2) + 4 * n + (i & 3); }

typedef int i32x4 __attribute__((ext_vector_type(4)));
typedef int i32x8 __attribute__((ext_vector_type(8)));
__device__ __forceinline__ i32x8 cat8(bf16x8 a, bf16x8 b) { const i32x4 x = __builtin_bit_cast(i32x4, a), y = __builtin_bit_cast(i32x4, b); return __builtin_shufflevector(x, y, 0, 1, 2, 3, 4, 5, 6, 7); }
struct Unit { int arow, brow, orow, ocol; };
struct Gemm { const void* A; const void* Bt; int rb; int kb = 0; };

struct GridOrder {
    int nM, nN, nwg, G, c, arow0, brow0, orow0, ocol0, ocstep;
    __device__ void init(int nM_, int nN_, int G_, int c_, int arow0_, int brow0_, int orow0_, int ocol0_, int ocstep_) { nM = nM_; nN = nN_; nwg = nM * nN; G = G_; c = c_; asm volatile("" : "+s"(c)); arow0 = arow0_; brow0 = brow0_; orow0 = orow0_; ocol0 = ocol0_; ocstep = ocstep_; }
    __device__ __forceinline__ bool next(int i, Unit& u) const {
        const long L = (long)i * G + c; if (L >= nwg) return false;
        int wgid = (int)L; { const int q = nwg / NXCD, r = nwg % NXCD, xcd = wgid % NXCD, off = wgid / NXCD; wgid = (xcd < r ? xcd * (q + 1) : r * (q + 1) + (xcd - r) * q) + off; }
        const int nig = WGM * nN, gid = wgid / nig, fm = gid * WGM, gsz = (nM - fm) < WGM ? (nM - fm) : WGM;
        const int pm = __builtin_amdgcn_readfirstlane(fm + ((wgid % nig) % gsz)), pn = __builtin_amdgcn_readfirstlane((wgid % nig) / gsz);
        u.arow = arow0 + 256 * pm; u.brow = brow0 + 256 * pn; u.orow = orow0 + 256 * pm; u.ocol = ocol0 + ocstep * pn; return true;
    }
};
struct InProjOrder {
    GridOrder go; int nctxcols;
    __device__ void init(int G_, int c_, int kv_only) { go.init(RL / 256, NP / 256, G_, c_, 0, 0, 0, 0, 256); nctxcols = kv_only ? 6 : NP / 256; }
    __device__ __forceinline__ bool next(int i, Unit& u) const {
        const int L = i * go.G + go.c, nlat = (RL / 256) * (NP / 256);
        if (L < nlat) return go.next(i, u);
        const int q = L - nlat; if (q >= 4 * nctxcols) return false;
        const int pm = RL / 256 + q / nctxcols, j = q % nctxcols; const int pn = nctxcols == 6 ? (j < 4 ? 10 + j : 12 + j) : j;
        u.arow = 256 * pm; u.brow = 256 * pn; u.orow = 256 * pm; u.ocol = 256 * pn; return true;
    }
};
struct DftOrder {
    int c, ctx;
    __device__ __forceinline__ bool next(int i, Unit& u) const {
        if (i > 0) return false;
        if (!ctx) { if (c >= 128) return false; const int b = c >> 5, pm = (c & 31) >> 1, pn = c & 1; u.arow = 256 * pm; u.brow = b * 512 + 256 * pn; u.orow = b * SEQ + 256 * pm; u.ocol = 256 * pn; return true; }
        if (c >= 8) return false; const int b = c >> 1, pn = c & 1; u.arow = 0; u.brow = b * 512 + 256 * pn; u.orow = RL + b * CTXL; u.ocol = 256 * pn; return true;
    }
};
struct MoeOrder {
    int G, c, nN, ocstep, brow_per_exp; const volatile LAS int* tb; const volatile LAS int* tl; int lmax = 0x7fffffff;
    __device__ __forceinline__ bool next(int i, Unit& u) const { const int L = i * G + c; if (L >= lmax) return false; return unit(L, u); }
    __device__ __forceinline__ bool unit(int L, Unit& u) const {
        const int total = tb[8] * nN; if (L >= total) return false;
        int w; { const int q = total / NXCD, r = total % NXCD, xcd = L % NXCD, off = L / NXCD; w = (xcd < r ? xcd * (q + 1) : r * (q + 1) + (xcd - r) * q) + off; }
        int e = 0;
#pragma unroll
        for (int j = 1; j < 8; ++j) if (w >= tb[j] * nN) e = j;
        const int t0 = tb[e], nt = tb[e + 1] - t0, q2 = w - t0 * nN;
        const int nig = WGM * nN, gid = q2 / nig, fm = gid * WGM, gsz = (nt - fm) < WGM ? (nt - fm) : WGM;
        const int pml = fm + ((q2 % nig) % gsz), pn = (q2 % nig) / gsz;
        u.arow = __builtin_amdgcn_readfirstlane(tl[t0 + pml] * 256); u.brow = __builtin_amdgcn_readfirstlane(e * brow_per_exp + pn * 256); u.orow = u.arow; u.ocol = __builtin_amdgcn_readfirstlane(pn * ocstep); return true;
    }
};

struct MoeTailOrder { MoeOrder mo; int L; __device__ __forceinline__ bool next(int i, Unit& u) const { if (i > 0 || L < 0) return false; return mo.unit(L, u); } };

struct EpiStoreBf16 {
    static constexpr bool PERM = true;
    bf16_t* O; int ldc; int bjstep = HALF;
    __device__ __forceinline__ void operator()(const f32x4 (&acc)[2][2][4][2], const Unit& u, int wr, int wc, int fr, int fq) const {
        const int row0 = u.orow + wr * 64 + fr, col0 = u.ocol + wc * 32 + 8 * fq;
#pragma unroll
        for (int ai = 0; ai < 2; ++ai)
#pragma unroll
            for (int m = 0; m < 4; ++m) { bf16_t* rowp = O + (size_t)(row0 + ai * HALF + m * 16) * ldc + col0;
#pragma unroll
                for (int bj = 0; bj < 2; ++bj) { const f32x4 v0 = acc[ai][bj][m][0], v1 = acc[ai][bj][m][1];
                    u32x4 w; w.x = cvt_pk_bf16(v0[0], v0[1]); w.y = cvt_pk_bf16(v0[2], v0[3]); w.z = cvt_pk_bf16(v1[0], v1[1]); w.w = cvt_pk_bf16(v1[2], v1[3]);
                    *(u32x4*)(rowp + bj * bjstep) = w; } }
    }
};
struct EpiInProj {
    static constexpr bool PERM = true;
    bf16_t* P; bf16_t* NV; bf16_t* GV;
    __device__ __forceinline__ void operator()(const f32x4 (&acc)[2][2][4][2], const Unit& u, int wr, int wc, int fr, int fq) const {
        bf16_t* O = P; int ldc = NP, orow = u.orow, ocol = u.ocol;
        const int kvr = u.orow < RL ? (u.orow >> 12) * KVL + CTXL + (u.orow & 4095) : ((u.orow - RL) >> 8) * KVL;
        if (ocol >= PC_NV && ocol < PC_NV + 512) { O = NV; ldc = 512; orow = kvr; ocol -= PC_NV; }
        else if (ocol >= PC_GV) { O = GV; ldc = 256; orow = kvr; ocol -= PC_GV; }
        const int row0 = orow + wr * 64 + fr, col0 = ocol + wc * 32 + 8 * fq;
#pragma unroll
        for (int ai = 0; ai < 2; ++ai)
#pragma unroll
            for (int m = 0; m < 4; ++m) { bf16_t* rowp = O + (size_t)(row0 + ai * HALF + m * 16) * ldc + col0;
#pragma unroll
                for (int bj = 0; bj < 2; ++bj) { const f32x4 v0 = acc[ai][bj][m][0], v1 = acc[ai][bj][m][1];
                    u32x4 w; w.x = cvt_pk_bf16(v0[0], v0[1]); w.y = cvt_pk_bf16(v0[2], v0[3]); w.z = cvt_pk_bf16(v1[0], v1[1]); w.w = cvt_pk_bf16(v1[2], v1[3]);
                    *(u32x4*)(rowp + bj * HALF) = w; } }
    }
};
struct EpiResid {
    static constexpr bool PERM = true;
    const float* res_lat; const float* res_ctx; const bf16_t* res_b; bf16_t* out; const float* gate; float sc;
    __device__ __forceinline__ void operator()(const f32x4 (&acc)[2][2][4][2], const Unit& u, int wr, int wc, int fr, int fq) const {
        const int col0 = u.ocol + wc * 32 + 8 * fq; const int mrow = u.orow < RL ? (u.orow >> 12) : 4;
        const float* rf = u.orow < RL ? res_lat + (size_t)u.orow * DM : res_ctx + (size_t)(u.orow - RL) * DM;
        const bool rbf = res_b != nullptr;
        f32x4 gv[2][2];
#pragma unroll
        for (int bj = 0; bj < 2; ++bj)
#pragma unroll
            for (int n = 0; n < 2; ++n) gv[bj][n] = *(const f32x4*)(gate + (size_t)mrow * 12288 + col0 + bj * HALF + n * 4);
#pragma unroll
        for (int ai = 0; ai < 2; ++ai)
#pragma unroll
            for (int m = 0; m < 4; ++m) { const size_t off = (size_t)(wr * 64 + fr + ai * HALF + m * 16) * DM + col0;
#pragma unroll
                for (int bj = 0; bj < 2; ++bj) { f32x4 r0, r1;
                    if (rbf) { const u32x4 rr = *(const u32x4*)(res_b + (size_t)u.orow * DM + off + bj * HALF);
                        r0[0] = bf_lo(rr.x); r0[1] = bf_hi(rr.x); r0[2] = bf_lo(rr.y); r0[3] = bf_hi(rr.y); r1[0] = bf_lo(rr.z); r1[1] = bf_hi(rr.z); r1[2] = bf_lo(rr.w); r1[3] = bf_hi(rr.w); }
                    else { r0 = *(const f32x4*)(rf + off + bj * HALF); r1 = *(const f32x4*)(rf + off + bj * HALF + 4); }
                    const f32x4 v0 = r0 + gv[bj][0] * (acc[ai][bj][m][0] * sc), v1 = r1 + gv[bj][1] * (acc[ai][bj][m][1] * sc);
                    u32x4 w; w.x = cvt_pk_bf16(v0[0], v0[1]); w.y = cvt_pk_bf16(v0[2], v0[3]); w.z = cvt_pk_bf16(v1[0], v1[1]); w.w = cvt_pk_bf16(v1[2], v1[3]);
                    *(u32x4*)(out + (size_t)u.orow * DM + off + bj * HALF) = w; } }
    }
};
struct EpiSwiglu8 {
    static constexpr bool PERM = true;
    unsigned char* O; int ldc; float inv, osc;
    __device__ __forceinline__ void operator()(const f32x4 (&acc)[2][2][4][2], const Unit& u, int wr, int wc, int fr, int fq) const {
        const int row0 = u.orow + wr * 64 + fr, col0 = u.ocol + wc * 32 + 8 * fq;
        const float io = inv * osc, c1 = -1.4426950408889634f * inv, kk = 1.0f / (inv * io);
#pragma unroll
        for (int ai = 0; ai < 2; ++ai)
#pragma unroll
            for (int m = 0; m < 4; ++m) { unsigned char* rowp = O + (size_t)(row0 + ai * HALF + m * 16) * ldc + col0;
                float v[8];
#pragma unroll
                for (int n = 0; n < 2; ++n)
#pragma unroll
                    for (int j = 0; j < 4; ++j) { const float x0 = acc[ai][0][m][n][j], x1 = acc[ai][1][m][n][j];
                        const float t = __builtin_amdgcn_exp2f(x0 * c1); v[n * 4 + j] = (x0 * x1) * __builtin_amdgcn_rcpf(__builtin_fmaf(t, kk, kk)); }
                u32x2 w; w.x = pk4_fp8(v[0], v[1], v[2], v[3]); w.y = pk4_fp8(v[4], v[5], v[6], v[7]);
                *(u32x2*)rowp = w; }
    }
};
struct EpiMoeDown {
    static constexpr bool PERM = true;
    bf16_t* O; const float* roww; float sc;
    __device__ __forceinline__ void operator()(const f32x4 (&acc)[2][2][4][2], const Unit& u, int wr, int wc, int fr, int fq) const {
        const int row0 = u.orow + wr * 64 + fr, col0 = u.ocol + wc * 32 + 8 * fq;
#pragma unroll
        for (int ai = 0; ai < 2; ++ai)
#pragma unroll
            for (int m = 0; m < 4; ++m) { const int row = row0 + ai * HALF + m * 16; const float rw = roww[row] * sc; bf16_t* rowp = O + (size_t)row * DM + col0;
#pragma unroll
                for (int bj = 0; bj < 2; ++bj) { const f32x4 v0 = acc[ai][bj][m][0] * rw, v1 = acc[ai][bj][m][1] * rw;
                    u32x4 w; w.x = cvt_pk_bf16(v0[0], v0[1]); w.y = cvt_pk_bf16(v0[2], v0[3]); w.z = cvt_pk_bf16(v1[0], v1[1]); w.w = cvt_pk_bf16(v1[2], v1[3]);
                    *(u32x4*)(rowp + bj * HALF) = w; } }
    }
};

struct EpiPartial {
    static constexpr bool PERM = true;
    float* slab;
    __device__ __forceinline__ void operator()(const f32x4 (&acc)[2][2][4][2], const Unit&, int wr, int wc, int fr, int fq) const {
        const int row0 = wr * 64 + fr, col0 = wc * 32 + 8 * fq;
#pragma unroll
        for (int ai = 0; ai < 2; ++ai)
#pragma unroll
            for (int m = 0; m < 4; ++m) { float* rowp = slab + (size_t)(row0 + ai * HALF + m * 16) * 256 + col0;
#pragma unroll
                for (int bj = 0; bj < 2; ++bj) { *(f32x4*)(rowp + bj * HALF) = acc[ai][bj][m][0]; *(f32x4*)(rowp + bj * HALF + 4) = acc[ai][bj][m][1]; } }
    }
};

template <class Epi, class Sched, bool F8 = false, bool ALIGN_EPI = true, bool SP2 = true>
__device__ __forceinline__ void gemm_phase(LAS unsigned char* lds, const Gemm g, const Sched& S, const Epi& E) {
    int tid = threadIdx.x; asm volatile("" : "+v"(tid));
    const int wid = __builtin_amdgcn_readfirstlane(tid >> 6), lane = tid & 63, wr = wid >> 2, wc = wid & 3, fr = lane & 15, fq = lane >> 4;
    int RB = g.rb; asm volatile("" : "+s"(RB)); int KB_ = g.kb ? g.kb : g.rb; asm volatile("" : "+s"(KB_)); const int nt = KB_ / (2 * BK);
    unsigned voffA[2], voffB[2];
#pragma unroll
    for (int i = 0; i < 2; ++i) { int R, C; stage_rc(tid * 16 + i * 8192, R, C); const int Rb = Epi::PERM ? ((R & ~31) + perm32(R & 31)) : R;
        voffA[i] = (unsigned)(R * RB + C * 2); voffB[i] = (unsigned)(Rb * RB + C * 2); }
    const size_t kstep = (size_t)(BK * 2);
    const size_t hstep = (size_t)HALF * RB;
    const size_t rstep = (size_t)RB;
    const unsigned ldsw = (unsigned)wid * 1024u;
    const int aoff = lds_byte(wr * 64 + fr, fq * 8), boff = lds_byte(wc * 32 + fr, fq * 8);
#define PG8_SA(b, h) (((b) * 2 + (h)) * HTB)
#define PG8_SB(b, h) ((4 + (b) * 2 + (h)) * HTB)
#define PG8_STAGE(bufoff, gbase, voff) do { _Pragma("unroll") for (int _i = 0; _i < 2; ++_i) \
        __builtin_amdgcn_global_load_lds((const unsigned*)((const char*)(gbase) + (voff)[_i]), (LAS unsigned*)(lds + (bufoff) + ldsw + _i * 8192), 16, 0, 0); } while (0)
#define PG8_LDA(dst, b, h) do { _Pragma("unroll") for (int m = 0; m < 4; ++m) _Pragma("unroll") for (int k = 0; k < 2; ++k) dst[m][k] = *(const LAS bf16x8*)(lds + PG8_SA(b, h) + aoff + m * 2048 + k * 1024); } while (0)
#define PG8_LDB(dst, b, h) do { _Pragma("unroll") for (int n = 0; n < 2; ++n) _Pragma("unroll") for (int k = 0; k < 2; ++k) dst[n][k] = *(const LAS bf16x8*)(lds + PG8_SB(b, h) + boff + n * 2048 + k * 1024); } while (0)
#define PG8_MMA(ai, bj, At, Bt) do { __builtin_amdgcn_s_setprio(1); _Pragma("unroll") for (int m = 0; m < 4; ++m) _Pragma("unroll") for (int n = 0; n < 2; ++n) { \
        if constexpr (F8) { asm volatile("v_mfma_scale_f32_16x16x128_f8f6f4 %0, %1, %2, %0, %3, %3 op_sel_hi:[0,0,0]" : "+v"(acc[ai][bj][m][n]) : "v"(cat8(Bt[n][0], Bt[n][1])), "v"(cat8(At[m][0], At[m][1])), "v"(f8scale)); } \
        else { _Pragma("unroll") for (int k = 0; k < 2; ++k) acc[ai][bj][m][n] = __builtin_amdgcn_mfma_f32_16x16x32_bf16(Bt[n][k], At[m][k], acc[ai][bj][m][n], 0, 0, 0); } } __builtin_amdgcn_s_setprio(0); } while (0)
#define PG8_WAIT_V(n) asm volatile("s_waitcnt vmcnt(" #n ")" ::: "memory")
#define PG8_WAIT_L(n) asm volatile("s_waitcnt lgkmcnt(" #n ")" ::: "memory")
#define PG8_BAR __builtin_amdgcn_s_barrier()
#define PG8_SCHED __builtin_amdgcn_sched_barrier(0)
    Unit cur, nxt; int ui = 0;
    if (!S.next(0, cur)) return;
    f32x4 acc[2][2][4][2];
#pragma unroll
    for (int a = 0; a < 2; ++a)
#pragma unroll
        for (int b = 0; b < 2; ++b)
#pragma unroll
            for (int m = 0; m < 4; ++m)
#pragma unroll
                for (int n = 0; n < 2; ++n) acc[a][b][m][n] = (f32x4){0.f, 0.f, 0.f, 0.f};
    bf16x8 At[4][2], B0[2][2], B1[2][2];
    int f8scale = 0x7f7f7f7f; asm volatile("" : "+v"(f8scale));
    const char* cA = (const char*)g.A + (size_t)cur.arow * rstep; const char* cB = (const char*)g.Bt + (size_t)cur.brow * rstep;
    if constexpr (SP2) {
        PG8_STAGE(PG8_SB(0, 0), cB, voffB); PG8_STAGE(PG8_SB(0, 1), cB + hstep, voffB); PG8_STAGE(PG8_SA(0, 0), cA, voffA); PG8_STAGE(PG8_SA(0, 1), cA + hstep, voffA);
        if (wr == 1) PG8_BAR;
        PG8_WAIT_V(2); PG8_BAR;
        PG8_STAGE(PG8_SB(1, 0), cB + kstep, voffB); PG8_STAGE(PG8_SA(1, 0), cA + kstep, voffA); PG8_STAGE(PG8_SB(1, 1), cB + hstep + kstep, voffB);
        PG8_WAIT_V(6); PG8_BAR;
    } else {
        PG8_STAGE(PG8_SB(0, 0), cB, voffB); PG8_STAGE(PG8_SA(0, 0), cA, voffA); PG8_STAGE(PG8_SB(0, 1), cB + hstep, voffB); PG8_STAGE(PG8_SA(0, 1), cA + hstep, voffA);
        if (wr == 1) PG8_BAR;
        PG8_WAIT_V(4); PG8_BAR;
        PG8_STAGE(PG8_SB(1, 0), cB + kstep, voffB); PG8_STAGE(PG8_SA(1, 0), cA + kstep, voffA); PG8_STAGE(PG8_SB(1, 1), cB + hstep + kstep, voffB);
        PG8_WAIT_V(6); PG8_BAR;
    }
    for (;;) {
        const bool has_next = S.next(ui + 1, nxt);
        const char* nA = has_next ? (const char*)g.A + (size_t)nxt.arow * rstep : cA; const char* nB = has_next ? (const char*)g.Bt + (size_t)nxt.brow * rstep : cB;
        for (int t = 0; t < nt; t += 2) {
            const bool last = (t == nt - 2);
            const char* a1 = cA + (size_t)(t + 1) * kstep;
            const char* a2 = last ? nA : cA + (size_t)(t + 2) * kstep; const char* b2 = last ? nB : cB + (size_t)(t + 2) * kstep;
            const char* a3 = a2 + kstep; const char* b3 = b2 + kstep;
            if constexpr (SP2) {
            PG8_LDB(B0, 0, 0); PG8_LDB(B1, 0, 1); PG8_SCHED; PG8_LDA(At, 0, 0); PG8_STAGE(PG8_SA(1, 1), a1 + hstep, voffA);
            PG8_WAIT_V(8); PG8_WAIT_L(0); PG8_BAR; PG8_MMA(0, 0, At, B0); PG8_MMA(0, 1, At, B1); PG8_BAR; PG8_SCHED;
            PG8_LDA(At, 0, 1); PG8_STAGE(PG8_SB(0, 0), b2, voffB); PG8_STAGE(PG8_SB(0, 1), b2 + hstep, voffB); PG8_STAGE(PG8_SA(0, 0), a2, voffA);
            PG8_WAIT_V(8); PG8_WAIT_L(0); PG8_BAR; PG8_MMA(1, 0, At, B0); PG8_MMA(1, 1, At, B1); PG8_BAR; PG8_SCHED;
            PG8_LDB(B0, 1, 0); PG8_LDB(B1, 1, 1); PG8_SCHED; PG8_LDA(At, 1, 0); PG8_STAGE(PG8_SA(0, 1), a2 + hstep, voffA);
            PG8_WAIT_V(8); PG8_WAIT_L(0); PG8_BAR; PG8_MMA(0, 0, At, B0); PG8_MMA(0, 1, At, B1); PG8_BAR; PG8_SCHED;
            PG8_LDA(At, 1, 1); PG8_STAGE(PG8_SB(1, 0), b3, voffB); PG8_STAGE(PG8_SB(1, 1), b3 + hstep, voffB); PG8_STAGE(PG8_SA(1, 0), a3, voffA);
            PG8_WAIT_V(8); PG8_WAIT_L(0); PG8_BAR; PG8_MMA(1, 0, At, B0); PG8_MMA(1, 1, At, B1); PG8_BAR; PG8_SCHED;
            } else {
            PG8_LDB(B0, 0, 0); PG8_SCHED; PG8_LDA(At, 0, 0); PG8_STAGE(PG8_SA(1, 1), a1 + hstep, voffA);
            PG8_WAIT_L(8); PG8_BAR; PG8_WAIT_L(0); PG8_MMA(0, 0, At, B0); PG8_BAR; PG8_SCHED;
            PG8_LDB(B1, 0, 1); PG8_STAGE(PG8_SB(0, 0), b2, voffB);
            PG8_BAR; PG8_WAIT_L(0); PG8_MMA(0, 1, At, B1); PG8_BAR;
            PG8_LDA(At, 0, 1); PG8_STAGE(PG8_SA(0, 0), a2, voffA);
            PG8_BAR; PG8_WAIT_L(0); PG8_MMA(1, 0, At, B0); PG8_BAR; PG8_SCHED;
            PG8_STAGE(PG8_SB(0, 1), b2 + hstep, voffB);
            PG8_WAIT_V(6); PG8_BAR; PG8_MMA(1, 1, At, B1); PG8_BAR;
            PG8_LDB(B0, 1, 0); PG8_SCHED; PG8_LDA(At, 1, 0); PG8_STAGE(PG8_SA(0, 1), a2 + hstep, voffA);
            PG8_WAIT_L(8); PG8_BAR; PG8_WAIT_L(0); PG8_MMA(0, 0, At, B0); PG8_BAR; PG8_SCHED;
            PG8_LDB(B1, 1, 1); PG8_STAGE(PG8_SB(1, 0), b3, voffB);
            PG8_BAR; PG8_WAIT_L(0); PG8_MMA(0, 1, At, B1); PG8_BAR;
            PG8_LDA(At, 1, 1); PG8_STAGE(PG8_SA(1, 0), a3, voffA);
            PG8_BAR; PG8_WAIT_L(0); PG8_MMA(1, 0, At, B0); PG8_BAR; PG8_SCHED;
            PG8_STAGE(PG8_SB(1, 1), b3 + hstep, voffB);
            PG8_WAIT_V(6); PG8_BAR; PG8_MMA(1, 1, At, B1); PG8_BAR;
            }
        }
        if constexpr (F8) { asm volatile("s_nop 15\n\ts_nop 15" ::: "memory"); }
        else { asm volatile("s_nop 15\n\ts_nop 15" : "+v"(acc[1][1][3][1]) :: "memory"); }
        if constexpr (ALIGN_EPI) { if (wr == 0) PG8_BAR; }
        E(acc, cur, wr, wc, fr, fq);
        if (!has_next) break;
#pragma unroll
        for (int a = 0; a < 2; ++a)
#pragma unroll
            for (int b = 0; b < 2; ++b)
#pragma unroll
                for (int m = 0; m < 4; ++m)
#pragma unroll
                    for (int n = 0; n < 2; ++n) acc[a][b][m][n] = (f32x4){0.f, 0.f, 0.f, 0.f};
        cur = nxt; cA = nA; cB = nB; ++ui;
        if constexpr (ALIGN_EPI) { if (wr == 1) PG8_BAR; }
    }
    PG8_WAIT_V(0);
    if constexpr (!ALIGN_EPI) { if (wr == 0) PG8_BAR; }
    PG8_BAR;
#undef PG8_SA
#undef PG8_SB
#undef PG8_STAGE
#undef PG8_LDA
#undef PG8_LDB
#undef PG8_MMA
#undef PG8_WAIT_V
#undef PG8_WAIT_L
#undef PG8_BAR
#undef PG8_SCHED
}
}

namespace att {
constexpr int D = 128, NW = 8, QBLK = 32, KVBLK = 64;
constexpr float SCALE = 0.088388347648318440f;
constexpr float THR = 8.f;
constexpr float LOG2E = 1.4426950408889634f;
constexpr size_t SHM_V = KVBLK * D * 2, SHM_K = KVBLK * D * 2, SHM_ATTN = 2 * SHM_V + 2 * SHM_K + NW * 64 * 4;
#define KSWZ(row, colB) ((row) * 256 + ((colB) ^ (((row) & 7) << 4)))
#define SBAR() __builtin_amdgcn_sched_barrier(0)
__device__ __forceinline__ int crow(int r, int hi) { return (r & 3) + 8 * (r >> 2) + 4 * hi; }
__device__ __forceinline__ unsigned cvtpk(float lo, float hi) { unsigned r; asm volatile("v_cvt_pk_bf16_f32 %0, %1, %2" : "=v"(r) : "v"(lo), "v"(hi)); return r; }

struct NaInfo { const LAS float* rpb; int qrow, rs, c, cs, rlo; };

__device__ __forceinline__ void partialSM(f32x16& p0, f32x16& p1, float& m_reg, float& mn, float& alpha) {
  constexpr float C = SCALE * LOG2E;
  float pmax = p0[0];
#pragma unroll
  for (int r = 1; r < 16; ++r) pmax = fmaxf(pmax, p0[r]);
#pragma unroll
  for (int r = 0; r < 16; ++r) pmax = fmaxf(pmax, p1[r]);
  { auto rr = __builtin_amdgcn_permlane32_swap(__float_as_uint(pmax), __float_as_uint(pmax), false, false);
    pmax = fmaxf(__uint_as_float(rr[0]), __uint_as_float(rr[1])); }
  if (__builtin_expect(__all(pmax - m_reg <= THR / SCALE), 1)) { mn = m_reg; alpha = 1.f; }
  else { mn = fmaxf(m_reg, pmax); alpha = __builtin_amdgcn_exp2f((m_reg - mn) * C); m_reg = mn; }
  float mnC = -mn * C;
#pragma unroll
  for (int r = 0; r < 16; ++r) p0[r] = fmaf(p0[r], C, mnC);
#pragma unroll
  for (int r = 0; r < 16; ++r) p1[r] = fmaf(p1[r], C, mnC);
#pragma unroll
  for (int r = 0; r < 16; ++r) p0[r] = __builtin_amdgcn_exp2f(p0[r]);
}
__device__ __forceinline__ void partialSM_na(f32x16& p0, f32x16& p1, float& m_reg, float& mn, float& alpha, int tile, const NaInfo& na, int hi) {
  constexpr float C = SCALE * LOG2E;
  if (tile < 4) {
#pragma unroll
    for (int r = 0; r < 16; ++r) { p0[r] *= C; p1[r] *= C; }
  } else {
    const int krow = na.rlo + tile - 4;
    const bool rowvalid = (krow >= na.rs) && (krow < na.rs + 8);
    if (rowvalid) {
      const int dr = krow - na.qrow + 7;
      const LAS float* bp = na.rpb + dr * 31 + (15 - na.c + 4 * hi);
      const int kc0 = 4 * hi;
#pragma unroll
      for (int r = 0; r < 16; ++r) { const int ko = (r & 3) + 8 * (r >> 2);
        const int kcA = kc0 + ko, kcB = kcA + 32;
        const float bA = bp[ko], bB = bp[ko + 32];
        const bool vA = (kcA >= na.cs) && (kcA < na.cs + 16), vB = (kcB >= na.cs) && (kcB < na.cs + 16);
        p0[r] = vA ? fmaf(p0[r], C, bA) : -1e30f; p1[r] = vB ? fmaf(p1[r], C, bB) : -1e30f; }
    } else {
#pragma unroll
      for (int r = 0; r < 16; ++r) { p0[r] = -1e30f; p1[r] = -1e30f; }
    }
  }
  float pmax = p0[0];
#pragma unroll
  for (int r = 1; r < 16; ++r) pmax = fmaxf(pmax, p0[r]);
#pragma unroll
  for (int r = 0; r < 16; ++r) pmax = fmaxf(pmax, p1[r]);
  { auto rr = __builtin_amdgcn_permlane32_swap(__float_as_uint(pmax), __float_as_uint(pmax), false, false);
    pmax = fmaxf(__uint_as_float(rr[0]), __uint_as_float(rr[1])); }
  if (__builtin_expect(__all(pmax - m_reg <= THR * LOG2E), 1)) { mn = m_reg; alpha = 1.f; }
  else { mn = fmaxf(m_reg, pmax); alpha = __builtin_amdgcn_exp2f(m_reg - mn); m_reg = mn; }
#pragma unroll
  for (int r = 0; r < 16; ++r) p0[r] = __builtin_amdgcn_exp2f(p0[r] - mn);
#pragma unroll
  for (int r = 0; r < 16; ++r) p1[r] = p1[r] - mn;
}
__device__ __forceinline__ void finishSM(f32x16& p0, f32x16& p1, float alpha, float& l_reg, bf16x8& pa0, bf16x8& pa1, bf16x8& pa2, bf16x8& pa3) {
#pragma unroll
  for (int r = 0; r < 16; ++r) p1[r] = __builtin_amdgcn_exp2f(p1[r]);
  float ps = 0;
#pragma unroll
  for (int r = 0; r < 16; ++r) ps += p0[r];
#pragma unroll
  for (int r = 0; r < 16; ++r) ps += p1[r];
  { auto rr = __builtin_amdgcn_permlane32_swap(__float_as_uint(ps), __float_as_uint(ps), false, false);
    ps = __uint_as_float(rr[0]) + __uint_as_float(rr[1]); }
  l_reg = l_reg * alpha + ps;
#define PK4(P, BASE, OUT) do { unsigned a0 = cvtpk(P[BASE + 0], P[BASE + 1]), a1 = cvtpk(P[BASE + 2], P[BASE + 3]);   \
    unsigned b0 = cvtpk(P[BASE + 4], P[BASE + 5]), b1 = cvtpk(P[BASE + 6], P[BASE + 7]);                              \
    auto r0 = __builtin_amdgcn_permlane32_swap(a0, b0, false, false); auto r1 = __builtin_amdgcn_permlane32_swap(a1, b1, false, false); \
    u32x4 w = {r0[0], r1[0], r0[1], r1[1]}; OUT = *reinterpret_cast<bf16x8*>(&w); } while (0)
  PK4(p0, 0, pa0); PK4(p0, 8, pa1); PK4(p1, 0, pa2); PK4(p1, 8, pa3);
#undef PK4
}
__device__ __forceinline__ void qkt(f32x16& p0, f32x16& p1, const bf16_t* Ks, const bf16x8* qr, int r32, int hi) {
  p0 = f32x16{}; p1 = f32x16{};
#pragma unroll
  for (int d0 = 0; d0 < 8; ++d0) { int cb = (d0 * 16 + hi * 8) * 2;
    bf16x8 b0 = *reinterpret_cast<const bf16x8*>((const char*)Ks + KSWZ(r32, cb));
    bf16x8 b1 = *reinterpret_cast<const bf16x8*>((const char*)Ks + KSWZ(32 + r32, cb));
    p0 = __builtin_amdgcn_mfma_f32_32x32x16_bf16(b0, qr[d0], p0, 0, 0, 0);
    p1 = __builtin_amdgcn_mfma_f32_32x32x16_bf16(b1, qr[d0], p1, 0, 0, 0); }
}
__device__ __forceinline__ int v_st(int k, int c) { const int kk = (k & ~0xC) | ((k & 4) << 1) | ((k & 8) >> 1); return ((kk >> 3) * 4 + (c >> 5)) * 512 + ((kk & 7) * 32 + (c & 31)) * 2; }
__device__ __forceinline__ int v_rd_base(int lane) { return ((lane & 3) << 3) | (((lane >> 2) & 3) << 6) | (((lane >> 4) & 1) << 5) | (((lane >> 5) & 1) << 8); }
constexpr int v_rd_off(int d0, int ks, int half) { return d0 * 512 + ks * 4096 + half * 2048; }
template <int OFF> __device__ __forceinline__ s16x4 tr_read(int vb) {
  s16x4 r; asm volatile("ds_read_b64_tr_b16 %0, %1 offset:%2" : "=&v"(r) : "v"(vb), "i"(OFF) : "memory"); return r;
}
template <int D0> __device__ __forceinline__ void pv_one(f32x16& od, int vb, bf16x8 pa0, bf16x8 pa1, bf16x8 pa2, bf16x8 pa3) {
  const s16x4 l0 = tr_read<v_rd_off(D0, 0, 0)>(vb), h0 = tr_read<v_rd_off(D0, 0, 1)>(vb), l1 = tr_read<v_rd_off(D0, 1, 0)>(vb), h1 = tr_read<v_rd_off(D0, 1, 1)>(vb);
  const s16x4 l2 = tr_read<v_rd_off(D0, 2, 0)>(vb), h2 = tr_read<v_rd_off(D0, 2, 1)>(vb), l3 = tr_read<v_rd_off(D0, 3, 0)>(vb), h3 = tr_read<v_rd_off(D0, 3, 1)>(vb);
  asm volatile("s_waitcnt lgkmcnt(0)" ::: "memory"); SBAR();
#define PK(L, H) (bf16x8){L[0], L[1], L[2], L[3], H[0], H[1], H[2], H[3]}
  od = __builtin_amdgcn_mfma_f32_32x32x16_bf16(pa0, PK(l0, h0), od, 0, 0, 0);
  od = __builtin_amdgcn_mfma_f32_32x32x16_bf16(pa1, PK(l1, h1), od, 0, 0, 0);
  od = __builtin_amdgcn_mfma_f32_32x32x16_bf16(pa2, PK(l2, h2), od, 0, 0, 0);
  od = __builtin_amdgcn_mfma_f32_32x32x16_bf16(pa3, PK(l3, h3), od, 0, 0, 0);
#undef PK
}
__device__ __forceinline__ void pv_d0(f32x16* o, int vb, bf16x8 pa0, bf16x8 pa1, bf16x8 pa2, bf16x8 pa3) {
  pv_one<0>(o[0], vb, pa0, pa1, pa2, pa3); pv_one<1>(o[1], vb, pa0, pa1, pa2, pa3); pv_one<2>(o[2], vb, pa0, pa1, pa2, pa3); pv_one<3>(o[3], vb, pa0, pa1, pa2, pa3);
}

template <int LDQ, int LDO, bool NA, int SDEPTH>
__device__ __forceinline__ void attn_body(const bf16_t* __restrict__ Qb, const bf16_t* __restrict__ Kh, const bf16_t* __restrict__ Vh, bf16_t* __restrict__ Ob, int NT, const int LDK, char* lds, const NaInfo& na) {
  int tid = threadIdx.x; asm volatile("" : "+v"(tid));
  const int wid = tid >> 6, lane = tid & 63, r32 = lane & 31, hi = lane >> 5;
  bf16_t* V_lds = (bf16_t*)lds; bf16_t* K_lds = (bf16_t*)(lds + 2 * SHM_V);
  float* ws = (float*)(lds + 2 * SHM_V + 2 * SHM_K) + wid * 64; float* li_l = ws; float* al_l = ws + 32;
  float m_reg = -1e30f, l_reg = 0; f32x16 o[4] = {}; bf16x8 qr[8];
  const bf16_t* Qw = Qb + (long)(wid * QBLK + r32) * LDQ + hi * 8;
#pragma unroll
  for (int d0 = 0; d0 < 8; ++d0) qr[d0] = *reinterpret_cast<const bf16x8*>(Qw + d0 * 16);
  const int sr = tid >> 4, sc = (tid & 15) * 8, vst0 = v_st(sr, sc), vst1 = v_st(32 + sr, sc);
  const int vb0 = (int)(uintptr_t)V_lds + v_rd_base(lane);
  const int koff = NA ? na.rlo * 64 : 0;
  struct { bf16x8 vs0, vs1, ks0, ks1; } sr_[SDEPTH];
#define KROW(t) ((t) * KVBLK + ((NA && (t) >= 4) ? koff : 0))
#define SLOAD(i, t) do { const long _k0 = KROW(t); sr_[i].vs0 = *reinterpret_cast<const bf16x8*>(&Vh[(_k0 + sr) * LDK + sc]); sr_[i].vs1 = *reinterpret_cast<const bf16x8*>(&Vh[(_k0 + 32 + sr) * LDK + sc]); \
    sr_[i].ks0 = *reinterpret_cast<const bf16x8*>(&Kh[(_k0 + sr) * LDK + sc]); sr_[i].ks1 = *reinterpret_cast<const bf16x8*>(&Kh[(_k0 + 32 + sr) * LDK + sc]); } while (0)
#define SWRITE(b, i) do { *(bf16x8*)((char*)V_lds + (b) * SHM_V + vst0) = sr_[i].vs0;          \
    *(bf16x8*)((char*)V_lds + (b) * SHM_V + vst1) = sr_[i].vs1; int kc = sc * 2;               \
    *(bf16x8*)((char*)K_lds + (b) * SHM_K + KSWZ(sr, kc)) = sr_[i].ks0;                       \
    *(bf16x8*)((char*)K_lds + (b) * SHM_K + KSWZ(32 + sr, kc)) = sr_[i].ks1; } while (0)
#define SWAIT() do { if constexpr (SDEPTH == 2) asm volatile("s_waitcnt vmcnt(4)" ::: "memory"); else asm volatile("s_waitcnt vmcnt(0)" ::: "memory"); } while (0)
#define RESC(a) do { if (__any((a) < 1.f)) { if (hi == 0) al_l[r32] = (a); asm volatile("s_waitcnt lgkmcnt(0)" ::: "memory"); \
    _Pragma("unroll") for (int d = 0; d < 4; ++d) _Pragma("unroll") for (int r = 0; r < 16; ++r) o[d][r] *= al_l[crow(r, hi)]; } } while (0)
#define PSM(P0, P1, MN, AL, T) do { if constexpr (NA) partialSM_na(P0, P1, m_reg, MN, AL, (T), na, hi); else partialSM(P0, P1, m_reg, MN, AL); } while (0)
  f32x16 pA0, pA1, pB0, pB1; float mnA, mnB, alA, alB; bf16x8 pa0, pa1, pa2, pa3;
  constexpr int SE = 0, SO = SDEPTH - 1;
  asm volatile("" : "+s"(NT));
  SLOAD(SE, 0); asm volatile("s_waitcnt vmcnt(0)" ::: "memory"); SWRITE(0, SE); __syncthreads();
  qkt(pA0, pA1, K_lds, qr, r32, hi); PSM(pA0, pA1, mnA, alA, 0);
  SLOAD(SO, 1); if constexpr (SDEPTH == 2) { if (2 < NT) SLOAD(SE, 2); }
  SWAIT(); SWRITE(1, SO); __syncthreads();
  for (int j = 1; j + 1 < NT; j += 2) {
    SBAR(); qkt(pB0, pB1, (bf16_t*)((char*)K_lds + SHM_K), qr, r32, hi);
    finishSM(pA0, pA1, alA, l_reg, pa0, pa1, pa2, pa3); SBAR();
    SLOAD(SO, j + SDEPTH); SBAR();
    pv_d0(o, vb0, pa0, pa1, pa2, pa3); PSM(pB0, pB1, mnB, alB, j);
    __syncthreads(); SWAIT(); SWRITE(0, SE);
    RESC(alB); __syncthreads();
    SBAR(); qkt(pA0, pA1, K_lds, qr, r32, hi);
    finishSM(pB0, pB1, alB, l_reg, pa0, pa1, pa2, pa3); SBAR();
    if (SDEPTH == 1 || j + 3 < NT) SLOAD(SE, j + 1 + SDEPTH); SBAR();
    pv_d0(o, vb0 + (int)SHM_V, pa0, pa1, pa2, pa3); PSM(pA0, pA1, mnA, alA, j + 1);
    __syncthreads(); SWAIT(); SWRITE(1, SO);
    RESC(alA); __syncthreads();
  }
  SBAR(); qkt(pB0, pB1, (bf16_t*)((char*)K_lds + SHM_K), qr, r32, hi);
  finishSM(pA0, pA1, alA, l_reg, pa0, pa1, pa2, pa3); SBAR();
  pv_d0(o, vb0, pa0, pa1, pa2, pa3); PSM(pB0, pB1, mnB, alB, NT - 1);
  __syncthreads(); RESC(alB);
  finishSM(pB0, pB1, alB, l_reg, pa0, pa1, pa2, pa3); SBAR();
  pv_d0(o, vb0 + (int)SHM_V, pa0, pa1, pa2, pa3);
  if (hi == 0) li_l[r32] = l_reg; asm volatile("s_waitcnt lgkmcnt(0)" ::: "memory");
  float rli[16];
#pragma unroll
  for (int r = 0; r < 16; ++r) rli[r] = __builtin_amdgcn_rcpf(li_l[crow(r, hi)]);
  bf16_t* Ow = Ob + (long)(wid * QBLK) * LDO;
#pragma unroll
  for (int r = 0; r < 16; ++r) { int orow = crow(r, hi);
#pragma unroll
    for (int d0 = 0; d0 < 4; ++d0) { const float v = o[d0][r] * rli[r]; Ow[(long)orow * LDO + d0 * 32 + r32] = (bf16_t)(cvtpk(v, v) & 0xffffu); } }
  __syncthreads();
#undef KROW
#undef SLOAD
#undef SWRITE
#undef SWAIT
#undef RESC
#undef PSM
}
#undef KSWZ
}

template <class T> __device__ __forceinline__ T* uni_ptr(T* p) { const unsigned long long v = (unsigned long long)p; const unsigned lo = __builtin_amdgcn_readfirstlane((unsigned)v), hi = __builtin_amdgcn_readfirstlane((unsigned)(v >> 32)); return (T*)(GAS T*)(((unsigned long long)hi << 32) | lo); }
__device__ __forceinline__ void attn_dense_call(const bf16_t* q, const bf16_t* k, const bf16_t* v, bf16_t* o, int nt, int ldk) {
    extern __shared__ __attribute__((aligned(16))) unsigned char lds_raw_[];
    q = uni_ptr(q); k = uni_ptr(k); v = uni_ptr(v); o = uni_ptr(o); nt = __builtin_amdgcn_readfirstlane(nt); ldk = __builtin_amdgcn_readfirstlane(ldk);
    att::NaInfo na0; na0.rpb = (const LAS float*)(LAS unsigned char*)lds_raw_; na0.qrow = 0; na0.rs = 0; na0.c = 0; na0.cs = 0; na0.rlo = 0;
    att::attn_body<512, DM, false, 2>(q, k, v, o, nt, ldk, (char*)lds_raw_, na0);
}
__device__ __forceinline__ void attn_na_call(const bf16_t* q, const bf16_t* k, const bf16_t* v, bf16_t* o, int nt, int r0, int rlo) {
    extern __shared__ __attribute__((aligned(16))) unsigned char lds_raw_[];
    q = uni_ptr(q); k = uni_ptr(k); v = uni_ptr(v); o = uni_ptr(o); nt = __builtin_amdgcn_readfirstlane(nt); r0 = __builtin_amdgcn_readfirstlane(r0); rlo = __builtin_amdgcn_readfirstlane(rlo);
    int tidn = threadIdx.x; asm volatile("" : "+v"(tidn)); const int wave = tidn >> 6, lane = tidn & 63;
    att::NaInfo na; na.rpb = (const LAS float*)((LAS unsigned char*)lds_raw_ + RPB_OFF); na.qrow = r0 + (wave >> 1); na.rs = min(max(na.qrow - 4, 0), 56); na.c = (wave & 1) * 32 + (lane & 31); na.cs = min(max(na.c - 8, 0), 48); na.rlo = rlo;
    att::attn_body<512, DM, true, 1>(q, k, v, o, nt, 512, (char*)lds_raw_, na);
}

__device__ __forceinline__ void cdft_to_slab(LAS unsigned char* lds, const bf16_t* __restrict__ Pv, size_t vstride, const bf16_t* __restrict__ MBl, int mpitch) {
  int tid = threadIdx.x; asm volatile("" : "+v"(tid));
  const int wid = tid >> 6, lane = tid & 63, r32 = lane & 31, hi = lane >> 5, h = wid >> 1, cs = wid & 1;
  const bf16_t* ap = Pv + (size_t)r32 * vstride + h * 128 + hi * 8;
  const bf16_t* bp = MBl + (size_t)(h * 256 + cs * 128 + r32) * mpitch + hi * 8;
  LAS bf16_t* sl = (LAS bf16_t*)lds + (64 * cs) * 512 + h * 128 + r32;
  bf16x8 a[2][8];
#pragma unroll
  for (int i = 0; i < 2; ++i)
#pragma unroll
    for (int k = 0; k < 8; ++k) a[i][k] = *reinterpret_cast<const bf16x8*>(ap + (size_t)(32 * i) * vstride + 16 * k);
#pragma unroll 1
  for (int i = 0; i < 2; ++i) {
    f32x16 acc[4];
#pragma unroll
    for (int j = 0; j < 4; ++j) { acc[j] = f32x16{}; asm volatile("" : "+v"(acc[j])); }
#pragma unroll
    for (int k = 0; k < 8; ++k) {
      bf16x8 bq[4];
#pragma unroll
      for (int j = 0; j < 4; ++j) bq[j] = *reinterpret_cast<const bf16x8*>(bp + (size_t)(32 * j) * mpitch + 16 * k);
      const bf16x8 av = i ? a[1][k] : a[0][k];
#pragma unroll
      for (int j = 0; j < 4; ++j) acc[j] = __builtin_amdgcn_mfma_f32_32x32x16_bf16(av, bq[j], acc[j], 0, 0, 0);
    }
#pragma unroll
    for (int j = 0; j < 4; ++j) asm volatile("s_nop 15\n\ts_nop 15" : "+v"(acc[j]));
#pragma unroll
    for (int r = 0; r < 16; ++r) { const int row = 32 * i + att::crow(r, hi);
#pragma unroll
      for (int j = 0; j < 4; ++j) { const float v = acc[j][r]; sl[row * 512 + 32 * j] = (bf16_t)(cvt_pk_bf16(v, v) & 0xffffu); } }
  }
}
template <int NPASS, bool STAGE = true, class RowPtr, class Epi>
__device__ __forceinline__ void fft_stage(LAS unsigned char* lds, const bf16_t* __restrict__ Mmat, const RowPtr& rowp, const Epi& epi) {
  int tid = threadIdx.x; asm volatile("" : "+v"(tid));
  const int wid = tid >> 6, lane = tid & 63, r32 = lane & 31, hi = lane >> 5;
  if constexpr (STAGE) {
    const int sr = tid >> 6, sc = (tid & 63) * 8;
    bf16x8 st[16];
#pragma unroll
    for (int i = 0; i < 16; ++i) st[i] = *reinterpret_cast<const bf16x8*>(rowp(sr + 8 * i) + sc);
#pragma unroll
    for (int i = 0; i < 16; ++i) *(LAS bf16x8*)(lds + ((sr + 8 * i) * 512 + sc) * 2) = st[i];
  }
  __syncthreads();
  const LAS bf16_t* tb = (const LAS bf16_t*)lds + (8 * hi) * 512 + 64 * wid + r32;
  const bf16_t* Ml = Mmat + r32 * 128 + hi * 8;
#pragma unroll
  for (int p = 0; p < NPASS; ++p) {
    f32x16 acc[2][2];
#pragma unroll
    for (int j = 0; j < 2; ++j) { acc[j][0] = f32x16{}; acc[j][1] = f32x16{}; asm volatile("" : "+v"(acc[j][0]), "+v"(acc[j][1])); }
#pragma unroll 2
    for (int k = 0; k < 8; ++k) {
      bf16x8 b0, b1;
#pragma unroll
      for (int j = 0; j < 8; ++j) { b0[j] = (short)tb[(16 * k + j) * 512]; b1[j] = (short)tb[(16 * k + j) * 512 + 32]; }
      const bf16x8 a0 = *reinterpret_cast<const bf16x8*>(Ml + p * 32 * 128 + k * 16), a1 = *reinterpret_cast<const bf16x8*>(Ml + (p + NPASS) * 32 * 128 + k * 16);
      acc[0][0] = __builtin_amdgcn_mfma_f32_32x32x16_bf16(a0, b0, acc[0][0], 0, 0, 0); acc[0][1] = __builtin_amdgcn_mfma_f32_32x32x16_bf16(a0, b1, acc[0][1], 0, 0, 0);
      acc[1][0] = __builtin_amdgcn_mfma_f32_32x32x16_bf16(a1, b0, acc[1][0], 0, 0, 0); acc[1][1] = __builtin_amdgcn_mfma_f32_32x32x16_bf16(a1, b1, acc[1][1], 0, 0, 0);
    }
#pragma unroll
    for (int j = 0; j < 2; ++j) asm volatile("s_nop 15\n\ts_nop 15" : "+v"(acc[j][0]), "+v"(acc[j][1]));
    epi(p, acc, wid, r32, hi);
  }
  __syncthreads();
}

#define XB_TMO      128
#define XB_XCNT(j)  (256  + 64 * (j))
#define XB_XSUB(j)  (1280 + 64 * (j))
#define XB_XGEN(j)  (2304 + 64 * (j))
#define XB_TOP      3328
#define XB_TOPGEN   3392
#define XCD_BAR_WORDS 3456
#define XB_SPIN_CAP (1u << 18)
__device__ __forceinline__ unsigned xb_ld(unsigned* p)              { return __hip_atomic_load(p, __ATOMIC_RELAXED, __HIP_MEMORY_SCOPE_AGENT); }
__device__ __forceinline__ unsigned xb_add(unsigned* p, unsigned v) { return __hip_atomic_fetch_add(p, v, __ATOMIC_RELAXED, __HIP_MEMORY_SCOPE_AGENT); }
__device__ __forceinline__ unsigned xb_xcc_id() { return (unsigned)__builtin_amdgcn_s_getreg((3 << 11) | 20) & 0xFu; }
#define XB_SPIN(cond, bar) do { unsigned _sp = 0; while (cond) { __builtin_amdgcn_s_sleep(1); \
    if ((++_sp & 255u) == 0u) { if (xb_ld(&(bar)[XB_TMO])) break; if (_sp > XB_SPIN_CAP) { atomicAdd(&(bar)[XB_TMO], 1u); break; } } } } while (0)
struct XcdBarrier { unsigned* bar; unsigned x; volatile LAS unsigned* st; };
__device__ __forceinline__ XcdBarrier xcd_barrier_post(unsigned* bar, volatile LAS unsigned* st) {
    XcdBarrier b; b.bar = bar; b.x = xb_xcc_id(); b.st = st;
    if (threadIdx.x == 0) (void)xb_add(&bar[XB_XCNT(b.x)], 1u);
    return b;
}
__device__ __forceinline__ void xcd_barrier_complete(unsigned* bar, unsigned x, unsigned& nloc, unsigned& nx) {
    const unsigned G = gridDim.x * gridDim.y * gridDim.z;
    unsigned sum, cnt, mine, sp = 0u;
    for (;;) {
        sum = 0u; cnt = 0u; mine = 0u;
#pragma unroll 1
        for (unsigned j = 0; j < 16; ++j) { const unsigned c = xb_ld(&bar[XB_XCNT(j)]); sum += c; cnt += (c > 0u) ? 1u : 0u; mine = (j == x) ? c : mine; }
        if (sum == G) break;
        __builtin_amdgcn_s_sleep(1);
        if ((++sp & 255u) == 0u) { if (xb_ld(&bar[XB_TMO])) break; if (sp > XB_SPIN_CAP) { atomicAdd(&bar[XB_TMO], 1u); break; } }
    }
    nloc = mine > 0u ? mine : 1u; nx = cnt > 0u ? cnt : 1u;
}
__device__ __forceinline__ void xcd_barrier(const XcdBarrier& b) {
    asm volatile("s_waitcnt vmcnt(0)" ::: "memory");
    __syncthreads();
    if (threadIdx.x == 0) {
        unsigned* bar = b.bar;
        __builtin_amdgcn_s_waitcnt(0);
        unsigned nloc = b.st[0], nx = b.st[1];
        if (nloc == 0u) { xcd_barrier_complete(bar, b.x, nloc, nx); b.st[0] = nloc; b.st[1] = nx; }
        const unsigned old = xb_add(&bar[XB_XSUB(b.x)], 1u);
        const unsigned gen = old / nloc;
        if (old + 1u == (gen + 1u) * nloc) {
            __builtin_amdgcn_fence(__ATOMIC_RELEASE, "agent");
            asm volatile("s_waitcnt vmcnt(0)" ::: "memory");
            const unsigned og = xb_add(&bar[XB_TOP], 1u);
            const unsigned tg = og / nx;
            if (og + 1u == (tg + 1u) * nx) xb_add(&bar[XB_TOPGEN], 1u);
            else XB_SPIN(xb_ld(&bar[XB_TOPGEN]) == tg, bar);
            __builtin_amdgcn_fence(__ATOMIC_ACQUIRE, "agent");
            xb_add(&bar[XB_XGEN(b.x)], 1u);
            asm volatile("s_waitcnt vmcnt(0)" ::: "memory");
        } else {
            XB_SPIN(xb_ld(&bar[XB_XGEN(b.x)]) == gen, bar);
            __builtin_amdgcn_fence(__ATOMIC_ACQUIRE, "agent");
            asm volatile("s_waitcnt vmcnt(0)" ::: "memory");
        }
    }
    __syncthreads();
}

struct Args { const float* in[24]; float* out; unsigned char* ws; int ph_lo, ph_hi; };
enum { I_X = 0, I_C, I_CTX, I_CCTX, I_N1G, I_N2G, I_WADA, I_BADA, I_WIN, I_WOUT, I_WFOUR, I_CONVW, I_RPB, I_NAQG, I_NAKG, I_GQG, I_GKG, I_FW1, I_FW3, I_FW2, I_ROUTER, I_MW1, I_MW3, I_MW2 };

__device__ __forceinline__ void transpose_tile(const float* __restrict__ src, int ldw, bf16_t* __restrict__ dst, int ldb, LAS unsigned* scr) {
    const int tid = threadIdx.x;
    const int n4 = (tid & 31) * 4, kq = tid >> 5;
    f32x4 a[4], b[4];
#pragma unroll
    for (int i = 0; i < 4; ++i) { const int kp = kq + 16 * i; a[i] = *(const f32x4*)(src + (size_t)(2 * kp) * ldw + n4); b[i] = *(const f32x4*)(src + (size_t)(2 * kp + 1) * ldw + n4); }
#pragma unroll
    for (int i = 0; i < 4; ++i) { const int kp = kq + 16 * i;
#pragma unroll
        for (int j = 0; j < 4; ++j) scr[(n4 + j) * 65 + kp] = cvt_pk_bf16(a[i][j], b[i][j]); }
    __syncthreads();
    const int n = tid >> 2, q = tid & 3;
#pragma unroll
    for (int i = 0; i < 4; ++i) { u32x4 w; const LAS unsigned* s = scr + n * 65 + q * 16 + i * 4; w.x = s[0]; w.y = s[1]; w.z = s[2]; w.w = s[3];
        *(u32x4*)(dst + (size_t)n * ldb + (q * 16 + i * 4) * 2) = w; }
    __syncthreads();
}

struct T16Regs { f32x4 a[4], b[4]; };
__device__ __forceinline__ void t16_load(const float* __restrict__ src, int ldw, T16Regs& t) {
    const int tid = threadIdx.x; const int n4 = (tid & 31) * 4, kq = tid >> 5;
#pragma unroll
    for (int i = 0; i < 4; ++i) { const int kp = kq + 16 * i; t.a[i] = __builtin_nontemporal_load((const f32x4*)(src + (size_t)(2 * kp) * ldw + n4)); t.b[i] = __builtin_nontemporal_load((const f32x4*)(src + (size_t)(2 * kp + 1) * ldw + n4)); }
}
__device__ __forceinline__ void t16_store(const T16Regs& t, bf16_t* __restrict__ dst, int ldb, LAS unsigned* scr) {
    const int tid = threadIdx.x; const int n4 = (tid & 31) * 4, kq = tid >> 5;
#pragma unroll
    for (int i = 0; i < 4; ++i) { const int kp = kq + 16 * i;
#pragma unroll
        for (int j = 0; j < 4; ++j) scr[(n4 + j) * 65 + kp] = cvt_pk_bf16(t.a[i][j], t.b[i][j]); }
    asm volatile("s_waitcnt lgkmcnt(0)" ::: "memory"); __builtin_amdgcn_s_barrier(); asm volatile("" ::: "memory");
    const int n = tid >> 2, q = tid & 3;
#pragma unroll
    for (int i = 0; i < 4; ++i) { u32x4 w; const LAS unsigned* s = scr + n * 65 + q * 16 + i * 4; w.x = s[0]; w.y = s[1]; w.z = s[2]; w.w = s[3];
        *(u32x4*)(dst + (size_t)n * ldb + (q * 16 + i * 4) * 2) = w; }
    asm volatile("s_waitcnt lgkmcnt(0)" ::: "memory"); __builtin_amdgcn_s_barrier(); asm volatile("" ::: "memory");
}
struct T8Regs { f32x4 r[2][4]; };
__device__ __forceinline__ void t8_load(const float* __restrict__ src, int ldw, T8Regs& t, int tid = threadIdx.x) {
    const int n4 = (tid & 31) * 4, kq = tid >> 5;
#pragma unroll
    for (int i = 0; i < 2; ++i)
#pragma unroll
        for (int q = 0; q < 4; ++q) t.r[i][q] = __builtin_nontemporal_load((const f32x4*)(src + (size_t)(4 * (kq + 16 * i) + q) * ldw + n4));
}
__device__ __forceinline__ void t8_store(const T8Regs& t, unsigned char* __restrict__ dst, int ldb, LAS unsigned* scr, float sc, int tid = threadIdx.x) {
    const int n4 = (tid & 31) * 4, kq = tid >> 5;
#pragma unroll
    for (int i = 0; i < 2; ++i)
#pragma unroll
        for (int j = 0; j < 4; ++j) scr[(n4 + j) * 33 + kq + 16 * i] = pk4_fp8(t.r[i][0][j] * sc, t.r[i][1][j] * sc, t.r[i][2][j] * sc, t.r[i][3][j] * sc);
    asm volatile("s_waitcnt lgkmcnt(0)" ::: "memory"); __builtin_amdgcn_s_barrier(); asm volatile("" ::: "memory");
    const int n = tid >> 2, q = tid & 3;
#pragma unroll
    for (int i = 0; i < 2; ++i) { u32x4 w; const LAS unsigned* s = scr + n * 33 + q * 8 + i * 4; w.x = s[0]; w.y = s[1]; w.z = s[2]; w.w = s[3];
        *(u32x4*)(dst + (size_t)n * ldb + q * 32 + i * 16) = w; }
    asm volatile("s_waitcnt lgkmcnt(0)" ::: "memory"); __builtin_amdgcn_s_barrier(); asm volatile("" ::: "memory");
}

__device__ __forceinline__ const unsigned char* ldptr(volatile LAS unsigned long long* T, int i) {
    const unsigned long long v = T[i]; const unsigned lo = __builtin_amdgcn_readfirstlane((unsigned)v), hi = __builtin_amdgcn_readfirstlane((unsigned)(v >> 32));
    return (const unsigned char*)(const GAS unsigned char*)(((unsigned long long)hi << 32) | lo);
}
constexpr int NT_ME = 16 * 56, NT_MUP = 2 * 8 * NT_ME, NT_MDN = 8 * NT_ME, NT_M = NT_MUP + NT_MDN;
constexpr int CW_QUP = 8192 + 1024, CW_QDN = 8192 + 1088;
__device__ __forceinline__ void moe_tile_decode(int t, volatile LAS unsigned long long* PTRS, const float*& src, int& ldw, unsigned char*& dst, int& ldb) {
    unsigned char* wsb = (unsigned char*)ldptr(PTRS, 25);
    if (t < NT_MUP) { const int which = t / (8 * NT_ME), q2 = t % (8 * NT_ME), e = q2 / NT_ME, r = q2 % NT_ME, kb = r / 56, nb = r % 56;
        src = (const float*)ldptr(PTRS, which ? I_MW3 : I_MW1) + (size_t)e * DM * DFE + (size_t)(kb * 128) * DFE + nb * 128; ldw = DFE; dst = wsb + WS_MUP + (size_t)e * 2 * DFE * DM + (size_t)(nb * 256 + which * 128) * DM + kb * 128; ldb = DM; }
    else { const int q = t - NT_MUP, e = q / NT_ME, r = q % NT_ME, kb = r / 16, nb = r % 16;
        src = (const float*)ldptr(PTRS, I_MW2) + (size_t)e * DFE * DM + (size_t)(kb * 128) * DM + nb * 128; ldw = DM; dst = wsb + WS_MDN + (size_t)e * DM * DFE + (size_t)(nb * 128) * DFE + kb * 128; ldb = DFE; }
}
__device__ __forceinline__ void moe_convert(volatile LAS unsigned long long* PTRS, LAS unsigned* scr, int t, int tend, int step) {
    if (t >= tend) return;
    const int tlast = t + ((tend - 1 - t) / step) * step;
    int tid = threadIdx.x; asm volatile("" : "+v"(tid));
    T8Regs t0, t1, t2; const float* src = nullptr; int ldw = 0; unsigned char *d0 = nullptr, *d1 = nullptr, *d2 = nullptr; int b0 = 0, b1 = 0, b2 = 0;
    moe_tile_decode(t, PTRS, src, ldw, d0, b0); t8_load(src, ldw, t0, tid);
    moe_tile_decode(min(t + step, tlast), PTRS, src, ldw, d1, b1); t8_load(src, ldw, t1, tid);
#define MT8_STEP(TL, DL, BL, TS, DS, BS) { if (t >= tend) break; moe_tile_decode(min(t + 2 * step, tlast), PTRS, src, ldw, DL, BL); t8_load(src, ldw, TL, tid); t8_store(TS, DS, BS, scr, F8_SW, tid); t += step; }
    for (;;) {
        MT8_STEP(t2, d2, b2, t0, d0, b0)
        MT8_STEP(t0, d0, b0, t1, d1, b1)
        MT8_STEP(t1, d1, b1, t2, d2, b2)
    }
#undef MT8_STEP
    asm volatile("s_waitcnt vmcnt(0)" ::: "memory");
}
template <unsigned PM, unsigned MM>
__global__ void __launch_bounds__(512, 2) mk_fwd(Args args) {
    extern __shared__ __attribute__((aligned(16))) unsigned char lds_raw[];
    LAS unsigned char* lds = (LAS unsigned char*)lds_raw;
    volatile LAS unsigned* MISC = (volatile LAS unsigned*)(lds + MISC_OFF);
    const int tid = threadIdx.x, lane = tid & 63, wave = __builtin_amdgcn_readfirstlane(tid >> 6);
    const int G = gridDim.x, wg = blockIdx.x;
    const int NGW = G * 8;
    unsigned* ctl = (unsigned*)(args.ws + WS_CTL);
    if (tid < 64) MISC[tid] = 0u;
    __syncthreads();
    XcdBarrier bar; bar.bar = ctl + CW_BAR; bar.x = 0; bar.st = MISC;
    const bool one_launch = (args.ph_hi - args.ph_lo) > 1;
    if (one_launch) bar = xcd_barrier_post(ctl + CW_BAR, MISC);
    const int lo = args.ph_lo, hi = args.ph_hi;
#define IN(k) (lo <= (k) && (k) < hi)
#define SEAM(k) do { if (IN(k) && IN((k) + 1)) xcd_barrier(bar); } while (0)

    volatile LAS unsigned long long* PTRS = (volatile LAS unsigned long long*)(lds + MISC_OFF + 512);
    if (tid < 24) PTRS[tid] = (unsigned long long)args.in[tid];
    if (tid == 24) PTRS[24] = (unsigned long long)args.out;
    if (tid == 25) PTRS[25] = (unsigned long long)args.ws;
    __syncthreads();
#define PHASE_IDS() int tid = threadIdx.x; asm volatile("" : "+v"(tid)); const int lane = tid & 63, wave = __builtin_amdgcn_readfirstlane(tid >> 6), gw = wg * 8 + wave; (void)lane; (void)gw
#define MOE_GRAB(budget) do { __syncthreads(); if (threadIdx.x == 0) { int t_ = (int)atomicAdd(ctl + CW_QUP, (unsigned)(budget)); if (t_ >= NT_MUP) t_ = NT_MUP + (int)atomicAdd(ctl + CW_QDN, (unsigned)(budget)); MISC[40] = (unsigned)t_; } __syncthreads(); \
    const int t0_ = __builtin_amdgcn_readfirstlane((int)MISC[40]); const int te_ = min(t0_ + (budget), t0_ < NT_MUP ? NT_MUP : NT_M); moe_convert(PTRS, (LAS unsigned*)lds, t0_, te_, 1); } while (0)
#define MOE_DRAIN(cw, base, count) do { __syncthreads(); if (threadIdx.x == 0) MISC[40] = __hip_atomic_load(ctl + (cw), RLX_AGENT); __syncthreads(); \
    const int s0_ = min(__builtin_amdgcn_readfirstlane((int)MISC[40]), (count)); moe_convert(PTRS, (LAS unsigned*)lds, (base) + s0_ + wg, (base) + (count), G); } while (0)
#define DEFICIT(nwg_) ((((nwg_) + G - 1) / G) - (wg < (nwg_) ? ((nwg_) - wg + G - 1) / G : 0))
#define INP(i) ((const float*)ldptr(PTRS, (i)))
#define OUTP() ((float*)ldptr(PTRS, 24))
#define WSB() ((unsigned char*)ldptr(PTRS, 25))

    DUP(10) if (EN(10) && IN(0)) {
            PHASE_IDS();
        constexpr int TR_WIN = 16 * 36, TR_WOUT = 16 * 16, TR_F13 = 16 * 44, TR_F2 = 44 * 16, TR_M13 = 16 * 56, TR_M2 = 56 * 16;
        constexpr int O_WIN = 0, O_WOUT = O_WIN + 2 * TR_WIN, O_F1 = O_WOUT + 2 * TR_WOUT, O_F3 = O_F1 + TR_F13, O_F2 = O_F3 + TR_F13, O_M1 = O_F2 + TR_F2, O_M3 = O_M1 + 8 * TR_M13, O_M2 = O_M3 + 8 * TR_M13, NTR = O_M2 + 8 * TR_M2;
        constexpr int O_T = NTR, N_T = 4096 / 8, O_TC = O_T + N_T, N_TC = 256 / 8, O_FOLD = O_TC + N_TC, N_FOLD = 2 * 4 * 2 * 32, O_MOD = O_FOLD + N_FOLD, N_MOD = 2 * 96, O_ROPE = O_MOD + N_MOD, NITEMS = O_ROPE + 1;
        LAS unsigned* scr = (LAS unsigned*)lds;
        LAS float* cosT = (LAS float*)(lds + 40960);
        LAS float* condL = (LAS float*)(lds + 57344);
        bool have_cond = false;
        unsigned char* wsb = WSB();
        float* mod = (float*)(wsb + WS_MOD); float* ropeT = (float*)(wsb + WS_ROPE); bf16_t* Tc = (bf16_t*)(wsb + WS_TC);
        bf16_t* Win_t = (bf16_t*)(wsb + WS_WIN); bf16_t* Wout_t = (bf16_t*)(wsb + WS_WOUT);
#define T16_DECODE(it_, src_, ldw_, dst_, ldb_) do { \
            if ((it_) < O_WOUT) { const int l = (it_) / TR_WIN, r = (it_) % TR_WIN, kb = r / 36, nb = r % 36; \
                src_ = INP(I_WIN) + (size_t)l * DM * INW + (size_t)(kb * 128) * INW + nb * 128; ldw_ = INW; dst_ = Win_t + (size_t)l * NP * DM + (size_t)(nb * 128) * DM + kb * 128; ldb_ = DM; } \
            else { const int q = (it_) - O_WOUT, l = q / TR_WOUT, r = q % TR_WOUT, kb = r / 16, nb = r % 16; \
                src_ = INP(I_WOUT) + (size_t)l * DM * DM + (size_t)(kb * 128) * DM + nb * 128; ldw_ = DM; dst_ = Wout_t + (size_t)l * DM * DM + (size_t)(nb * 128) * DM + kb * 128; ldb_ = DM; } } while (0)
        SUBDUP(0) {
            int it = wg; T16Regs t0, t1, t2; const float* src = nullptr; int ldw = 0; bf16_t *d0 = nullptr, *d1 = nullptr, *d2 = nullptr; int b0 = 0, b1 = 0, b2 = 0;
            if (it < O_F1) { T16_DECODE(it, src, ldw, d0, b0); t16_load(src, ldw, t0); }
            { const int itn_ = min(it + G, O_F1 - 1); T16_DECODE(itn_, src, ldw, d1, b1); t16_load(src, ldw, t1); }
#define T16_STEP(TL, DL, BL, TS, DS, BS) { if (it >= O_F1) break; { const int itn_ = min(it + 2 * G, O_F1 - 1); T16_DECODE(itn_, src, ldw, DL, BL); t16_load(src, ldw, TL); } t16_store(TS, DS, BS, scr); it += G; }
            for (;;) {
                T16_STEP(t2, d2, b2, t0, d0, b0)
                T16_STEP(t0, d0, b0, t1, d1, b1)
                T16_STEP(t1, d1, b1, t2, d2, b2)
            }
#undef T16_STEP
            asm volatile("s_waitcnt vmcnt(0)" ::: "memory"); __syncthreads();
        }
#undef T16_DECODE
#define T8_DECODE(it_, src_, ldw_, dst_, ldb_) do { \
            if ((it_) < O_F2) { const int q = (it_) - O_F1, which = q / TR_F13, r = q % TR_F13, kb = r / 44, nb = r % 44; \
                src_ = INP(which ? I_FW3 : I_FW1) + (size_t)(kb * 128) * DFF + nb * 128; ldw_ = DFF; dst_ = wsb + WS_WUP + (size_t)(nb * 256 + which * 128) * DM + kb * 128; ldb_ = DM; } \
            else if ((it_) < O_M1) { const int r = (it_) - O_F2, kb = r / 16, nb = r % 16; \
                src_ = INP(I_FW2) + (size_t)(kb * 128) * DM + nb * 128; ldw_ = DM; dst_ = wsb + WS_WDN + (size_t)(nb * 128) * DFF + kb * 128; ldb_ = DFF; } \
            else if ((it_) < O_M2) { const int q = (it_) - O_M1, which = q / (8 * TR_M13), q2 = q % (8 * TR_M13), e = q2 / TR_M13, r = q2 % TR_M13, kb = r / 56, nb = r % 56; \
                src_ = INP(which ? I_MW3 : I_MW1) + (size_t)e * DM * DFE + (size_t)(kb * 128) * DFE + nb * 128; ldw_ = DFE; dst_ = wsb + WS_MUP + (size_t)e * 2 * DFE * DM + (size_t)(nb * 256 + which * 128) * DM + kb * 128; ldb_ = DM; } \
            else { const int q = (it_) - O_M2, e = q / TR_M2, r = q % TR_M2, kb = r / 16, nb = r % 16; \
                src_ = INP(I_MW2) + (size_t)e * DFE * DM + (size_t)(kb * 128) * DM + nb * 128; ldw_ = DM; dst_ = wsb + WS_MDN + (size_t)e * DM * DFE + (size_t)(nb * 128) * DFE + kb * 128; ldb_ = DFE; } } while (0)
        SUBDUP(1) {
            int it = O_F1 + wg; T8Regs t0, t1, t2; const float* src = nullptr; int ldw = 0; unsigned char *d0 = nullptr, *d1 = nullptr, *d2 = nullptr; int b0 = 0, b1 = 0, b2 = 0;
            if (it < O_M1) { T8_DECODE(it, src, ldw, d0, b0); t8_load(src, ldw, t0); }
            { const int itn_ = min(it + G, O_M1 - 1); T8_DECODE(itn_, src, ldw, d1, b1); t8_load(src, ldw, t1); }
#define T8_STEP(TL, DL, BL, TS, DS, BS) { if (it >= O_M1) break; { const int itn_ = min(it + 2 * G, O_M1 - 1); T8_DECODE(itn_, src, ldw, DL, BL); t8_load(src, ldw, TL); } t8_store(TS, DS, BS, scr, F8_SW); it += G; }
            for (;;) {
                T8_STEP(t2, d2, b2, t0, d0, b0)
                T8_STEP(t0, d0, b0, t1, d1, b1)
                T8_STEP(t1, d1, b1, t2, d2, b2)
            }
#undef T8_STEP
        }
#undef T8_DECODE
        if (wg == (G >= 128 ? 125 : G - 2)) {
            for (int i = tid; i < 4096; i += 512) cosT[i] = cosf((float)i * (6.283185307179586f / 4096.0f));
            __syncthreads();
            for (int k = wave; k < 256; k += 8) { const int c8 = lane * 8; float v[8];
#pragma unroll
                for (int q = 0; q < 8; ++q) { const int col = c8 + q, l = col & 255; const int idx = ((k * l) & 255) * 16; v[q] = (col < 256 ? cosT[idx] : -cosT[(idx - 1024) & 4095]) * (1.0f / 16.0f); }
                u32x4 w; w.x = cvt_pk_bf16(v[0], v[1]); w.y = cvt_pk_bf16(v[2], v[3]); w.z = cvt_pk_bf16(v[4], v[5]); w.w = cvt_pk_bf16(v[6], v[7]);
                *(u32x4*)(Tc + (size_t)k * 512 + c8) = w; }
            __syncthreads();
        }
        if (wg == (G >= 128 ? 126 : G - 3)) {
            for (int i = tid; i < 4096; i += 512) cosT[i] = cosf((float)i * (6.283185307179586f / 4096.0f));
            __syncthreads();
            bf16_t* M1 = (bf16_t*)(wsb + WS_FFT); bf16_t* M2 = M1 + 128 * 128; float* TW = (float*)(wsb + WS_FFT + 49152);
            for (int i = tid; i < 128 * 128; i += 512) { const int m = i >> 7, kk = i & 127, k1 = m & 63, l1 = kk & 63; const int idx = ((k1 * l1) & 63) * 64; const float c = cosT[idx], sn = cosT[(idx - 1024) & 4095];
                const float v = (m < 64) ? (kk < 64 ? c : -sn) : (kk < 64 ? -sn : -c); M1[i] = (bf16_t)(cvt_pk_bf16(v, v) & 0xffffu); }
            for (int i = tid; i < 64 * 128; i += 512) { const int k2 = i >> 7, kk = i & 127, l2 = kk & 63; const int idx = ((k2 * l2) & 63) * 64; const float c = cosT[idx], sn = cosT[(idx - 1024) & 4095];
                const float v = (kk < 64 ? c : sn) * (1.0f / 64.0f); M2[i] = (bf16_t)(cvt_pk_bf16(v, v) & 0xffffu); }
            for (int i = tid; i < 4096; i += 512) { TW[2 * i] = cosT[i]; TW[2 * i + 1] = cosT[(i - 1024) & 4095]; }
            __syncthreads();
        }
        SUBDUP(3) for (int it4 = wg - 64; it4 >= 0 && it4 < 64; it4 += G) {
                const int it = it4 >> 2, dq = it4 & 3;
                const int cs = it & 1, h = (it >> 1) & 3, l = it >> 3;
                LAS float* trig = (LAS float*)(lds + MISC_OFF + 8192);
                LAS float* wfL = (LAS float*)lds;
                __syncthreads();
                if (tid < 128) trig[tid] = cs ? sinf((float)tid * (6.283185307179586f / 128.0f)) : cosf((float)tid * (6.283185307179586f / 128.0f));
                { const int r = tid >> 5, c4 = (tid & 31) * 4; const float* wf = INP(I_WFOUR) + (size_t)(l * 4 + h) * 128 * 128;
                  f32x4 v[8];
#pragma unroll
                  for (int i = 0; i < 8; ++i) v[i] = *(const f32x4*)(wf + (size_t)(r + 16 * i) * 128 + c4);
#pragma unroll
                  for (int i = 0; i < 8; ++i) *(LAS f32x4*)(wfL + (r + 16 * i) * 128 + c4) = v[i]; }
                __syncthreads();
                { const int e = tid & 127, dg = tid >> 7; float a[8];
#pragma unroll
                  for (int i = 0; i < 8; ++i) a[i] = 0.f;
                  const int d0 = dq * 32 + dg * 8;
#pragma unroll 4
                  for (int m = 0; m < 128; ++m) { const float wv = wfL[m * 128 + e];
#pragma unroll
                    for (int i = 0; i < 8; ++i) a[i] += trig[(m * (d0 + i)) & 127] * wv; }
                  bf16_t* MBr = (bf16_t*)(wsb + WS_MB) + ((size_t)l * PFW + h * 256 + cs * 128 + e) * NP;
#pragma unroll
                  for (int i = 0; i < 8; ++i) a[i] *= 0.08838834764831845f;
                  u32x4 w; w.x = cvt_pk_bf16(a[0], a[1]); w.y = cvt_pk_bf16(a[2], a[3]); w.z = cvt_pk_bf16(a[4], a[5]); w.w = cvt_pk_bf16(a[6], a[7]);
                  *(u32x4*)(MBr + d0) = w; }
                __syncthreads();
                have_cond = false;
        }
        SUBDUP(4) for (int it = O_MOD + ((wg + 128) % G); it < O_ROPE; it += G) {
                const int q = it - O_MOD, l = q / 96, n0 = (q % 96) * 128;
                if (!have_cond) { __syncthreads();
                    for (int i = tid; i < 5 * 2048; i += 512) { const int j = i >> 11, k = i & 2047; const float c = j < 4 ? INP(I_C)[j * 2048 + k] : INP(I_CCTX)[k]; condL[i] = silu_f(c); }
                    have_cond = true; __syncthreads(); }
                const int c4 = (tid & 31) * 4, kg = tid >> 5; f32x4 a[5];
#pragma unroll
                for (int j = 0; j < 5; ++j) a[j] = (f32x4){0.f, 0.f, 0.f, 0.f};
                const float* wp = INP(I_WADA) + (size_t)l * DM * 12288 + (size_t)(kg * 128) * 12288 + n0 + c4;
#pragma unroll 8
                for (int k = 0; k < 128; ++k) { const f32x4 wv = __builtin_nontemporal_load((const f32x4*)(wp + (size_t)k * 12288));
#pragma unroll
                    for (int j = 0; j < 5; ++j) a[j] += wv * condL[j * 2048 + kg * 128 + k]; }
                LAS float* red = (LAS float*)lds;
                __syncthreads();
#pragma unroll
                for (int j = 0; j < 5; ++j) *(LAS f32x4*)(red + (kg * 5 + j) * 128 + c4) = a[j];
                __syncthreads();
                if (tid < 128) {
#pragma unroll
                    for (int j = 0; j < 5; ++j) { float sacc = 0.f;
#pragma unroll
                        for (int g2 = 0; g2 < 16; ++g2) sacc += red[(g2 * 5 + j) * 128 + tid];
                        mod[(size_t)(l * 5 + j) * 12288 + n0 + tid] = sacc + INP(I_BADA)[l * 12288 + n0 + tid]; } }
                __syncthreads();
        }
        if (wg == (G >= 128 ? 127 : G - 1)) {
                for (int i = tid; i < 64 * 32; i += 512) { const int p = i >> 5, f = i & 31; const float inv = 1.0f / powf(10000.0f, (float)f / 32.0f); const float ang = (float)p * inv;
                    ropeT[2 * i] = cosf(ang); ropeT[2 * i + 1] = sinf(ang); }
        }
        __syncthreads();
    }
    SEAM(0);

    for (int layer = 0; layer < 2; ++layer) {
        const int pb = 1 + 10 * layer;
#define LAYER_PTRS() unsigned char* wsb = WSB(); const float* modl = (const float*)(wsb + WS_MOD) + (size_t)layer * 5 * 12288; (void)modl
#define XIN_PTRS() const float* xin_lat = INP(I_X); const float* xin_ctx = INP(I_CTX); const bf16_t* xin_b = layer == 0 ? (const bf16_t*)nullptr : (const bf16_t*)(wsb + WS_X2)

        DUP(0) if (EN(0) && IN(pb + 0)) {
            PHASE_IDS();
            LAYER_PTRS(); XIN_PTRS(); bf16_t* HB = (bf16_t*)(wsb + WS_HB);
            const float* gn = INP(I_N1G) + layer * DM;
            f32x4 gv[8];
#pragma unroll
            for (int j = 0; j < 8; ++j) gv[j] = *(const f32x4*)(gn + lane * 4 + 256 * j);
#define NORM1_ROW(ROW, V) do { const int row_ = (ROW); const int mr = row_ < RL ? (row_ >> 12) : 4; const float* sh = modl + (size_t)mr * 12288; const float* sc = sh + 2048; float ss = 0.f; \
                _Pragma("unroll") for (int j = 0; j < 8; ++j) ss += (V[j][0] * V[j][0] + V[j][1] * V[j][1]) + (V[j][2] * V[j][2] + V[j][3] * V[j][3]); \
                const float rinv = rsqrtf(wave_sum(ss) * (1.0f / DM) + NORM_EPS); \
                _Pragma("unroll") for (int j = 0; j < 8; ++j) { const int c = lane * 4 + 256 * j; const f32x4 s1 = *(const f32x4*)(sc + c), s0 = *(const f32x4*)(sh + c); \
                    const f32x4 h = V[j] * rinv * gv[j] * (s1 + 1.0f) + s0; u32x2 w; w.x = cvt_pk_bf16(h[0], h[1]); w.y = cvt_pk_bf16(h[2], h[3]); \
                    *(u32x2*)(HB + (size_t)row_ * DM + c) = w; } } while (0)
            for (int row = gw; row < RT; row += 2 * NGW) {
                const int rowB = row + NGW; const bool hasB = rowB < RT; const int rb_ = hasB ? rowB : row;
                const float* xa = row < RL ? xin_lat + (size_t)row * DM : xin_ctx + (size_t)(row - RL) * DM;
                const float* xb = rb_ < RL ? xin_lat + (size_t)rb_ * DM : xin_ctx + (size_t)(rb_ - RL) * DM;
                f32x4 va[8], vb[8];
                if (layer == 0) {
#pragma unroll
                    for (int j = 0; j < 8; ++j) va[j] = *(const f32x4*)(xa + lane * 4 + 256 * j);
#pragma unroll
                    for (int j = 0; j < 8; ++j) vb[j] = *(const f32x4*)(xb + lane * 4 + 256 * j);
                } else { u32x2 qa[8], qb[8];
#pragma unroll
                    for (int j = 0; j < 8; ++j) qa[j] = *(const u32x2*)(xin_b + (size_t)row * DM + lane * 4 + 256 * j);
#pragma unroll
                    for (int j = 0; j < 8; ++j) qb[j] = *(const u32x2*)(xin_b + (size_t)rb_ * DM + lane * 4 + 256 * j);
#pragma unroll
                    for (int j = 0; j < 8; ++j) { va[j] = bf4(qa[j]); vb[j] = bf4(qb[j]); } }
                NORM1_ROW(row, va);
                if (hasB) NORM1_ROW(rowB, vb);
            }
#undef NORM1_ROW
        }
        SEAM(pb + 0);

        DUP(1) if (EN(1) && IN(pb + 1)) {
            unsigned char* wsb = WSB(); bf16_t* HB = (bf16_t*)(wsb + WS_HB); bf16_t* Win_t = (bf16_t*)(wsb + WS_WIN); bf16_t* P = (bf16_t*)(wsb + WS_P);
            pg8::Gemm g{HB, Win_t + (size_t)layer * NP * DM, 2 * DM};
            pg8::InProjOrder S; S.init(G, wg, layer == 1);
            pg8::EpiInProj E{P, (bf16_t*)(wsb + WS_NV), (bf16_t*)(wsb + WS_GV)};
            pg8::gemm_phase<pg8::EpiInProj, pg8::InProjOrder>(lds, g, S, E);
            { const int def_ = DEFICIT((RL / 256) * (NP / 256) + 4 * (layer == 1 ? 6 : NP / 256)); if (def_ > 0) MOE_GRAB(def_ * 14); }
        }
        SEAM(pb + 1);

        DUP(2) if (EN(2) && IN(pb + 2)) {
            PHASE_IDS();
            unsigned char* wsb = WSB(); const float* ropeT = (const float*)(wsb + WS_ROPE); const bf16_t* P = (const bf16_t*)(wsb + WS_P); bf16_t* Y = (bf16_t*)(wsb + WS_Y);
            bf16_t* NQ = (bf16_t*)(wsb + WS_NQ); bf16_t* NK = (bf16_t*)(wsb + WS_NK); bf16_t* NV = (bf16_t*)(wsb + WS_NV); bf16_t* GQ = (bf16_t*)(wsb + WS_GQ); bf16_t* GK = (bf16_t*)(wsb + WS_GK); bf16_t* GV = (bf16_t*)(wsb + WS_GV);
            bf16_t* PTC = (bf16_t*)(wsb + WS_PTC);
            const float* convw = INP(I_CONVW) + layer * 3 * 512;
            const float* g_nq = INP(I_NAQG) + layer * 128; const float* g_nk = INP(I_NAKG) + layer * 128;
            const float* g_gq = INP(I_GQG) + layer * 128; const float* g_gk = INP(I_GKG) + layer * 128;
            bf16_t* PF = (bf16_t*)(wsb + WS_PF);
            { const int nctx = layer == 0 ? 16 : 0; const int hh = wg & 3;
              struct CdftOrder { int G, c, nctx; __device__ __forceinline__ bool next(int i, pg8::Unit& u) const { const int L = i * G + c; if (L >= nctx) return false;
                  const int pm = RL / 256 + (L >> 2);
                  u.arow = 256 * pm; u.brow = 256 * (c & 3); u.orow = 256 * pm; u.ocol = 128 * (c & 3); return true; } };
              pg8::Gemm g{P + hh * 128, (const bf16_t*)(wsb + WS_MB) + (size_t)layer * PFW * NP, 2 * NP, 2 * 128};
              CdftOrder S{G, wg, nctx}; pg8::EpiStoreBf16 E{PF, PFW, 512};
              pg8::gemm_phase<pg8::EpiStoreBf16, CdftOrder>(lds, g, S, E);
              if (threadIdx.x == 0) { __builtin_amdgcn_fence(__ATOMIC_RELEASE, "agent"); asm volatile("s_waitcnt vmcnt(0)" ::: "memory");
                  for (int L = wg; L < nctx; L += G) xb_add(ctl + CW_CDF + 64 * (layer * 5 + 4), 1u); }
            }
            const int l16 = lane & 15;
            f32x4 cw[3][2], gq_[2], gk_[2], hq_[2], hk_[2];
#pragma unroll
            for (int k = 0; k < 3; ++k) { cw[k][0] = *(const f32x4*)(convw + k * 512 + lane * 8); cw[k][1] = *(const f32x4*)(convw + k * 512 + lane * 8 + 4); }
            gq_[0] = *(const f32x4*)(g_nq + l16 * 8); gq_[1] = *(const f32x4*)(g_nq + l16 * 8 + 4); gk_[0] = *(const f32x4*)(g_nk + l16 * 8); gk_[1] = *(const f32x4*)(g_nk + l16 * 8 + 4);
            hq_[0] = *(const f32x4*)(g_gq + l16 * 8); hq_[1] = *(const f32x4*)(g_gq + l16 * 8 + 4); hk_[0] = *(const f32x4*)(g_gk + l16 * 8); hk_[1] = *(const f32x4*)(g_gk + l16 * 8 + 4);
#define CDF_WAIT(f, n) do { __syncthreads(); if (threadIdx.x == 0) { while (__hip_atomic_load(ctl + CW_CDF + 64 * (layer * 5 + (f)), RLX_AGENT) < (unsigned)(n)) __builtin_amdgcn_s_sleep(2); \
                __builtin_amdgcn_fence(__ATOMIC_ACQUIRE, "agent"); asm volatile("s_waitcnt vmcnt(0)" ::: "memory"); } __syncthreads(); } while (0)
            struct PrepRaw { u32x4 gb, zc, zv, pc, pv, nc, nv, nq, nk, gq, gk; f32x4 rcs[4]; };
#define PREP_LOAD(ROW, R) do { const int row_ = (ROW); int t_, Ls_; if (row_ < RL) { t_ = row_ & 4095; Ls_ = SEQ; } else { t_ = (row_ - RL) & 255; Ls_ = CTXL; } \
                const bf16_t* Pr = P + (size_t)row_ * NP; const int ch = lane * 8; const u32x4 z4 = {0u, 0u, 0u, 0u}; \
                R.gb = *(const u32x4*)(Pr + PC_CB + ch); R.zc = *(const u32x4*)(Pr + PC_CC + ch); R.zv = *(const u32x4*)(Pr + PC_CV + ch); \
                R.pc = z4; R.pv = z4; R.nc = z4; R.nv = z4; \
                if (t_ > 0) { R.pc = *(const u32x4*)(Pr - NP + PC_CC + ch); R.pv = *(const u32x4*)(Pr - NP + PC_CV + ch); } \
                if (t_ < Ls_ - 1) { R.nc = *(const u32x4*)(Pr + NP + PC_CC + ch); R.nv = *(const u32x4*)(Pr + NP + PC_CV + ch); } \
                R.nq = *(const u32x4*)(Pr + PC_NQ + ch); R.nk = *(const u32x4*)(Pr + PC_NK + ch); R.gq = *(const u32x4*)(Pr + PC_GQ + ch); R.gk = *(const u32x4*)(Pr + PC_GK + (lane & 31) * 8); \
                { const int seg = l16 >> 2; const int p64 = (seg < 2) ? (t_ >> 6) : (t_ & 63); const float* cs_ = ropeT + (size_t)(p64 * 32 + (l16 & 3) * 8) * 2; \
                  _Pragma("unroll") for (int i = 0; i < 4; ++i) R.rcs[i] = *(const f32x4*)(cs_ + 4 * i); } } while (0)
#define HEADNORM(raw, gain, out) do { float _x[8]; _Pragma("unroll") for (int i = 0; i < 4; ++i) { _x[2 * i] = bf_lo(raw[i]); _x[2 * i + 1] = bf_hi(raw[i]); } \
                    float _ss = 0.f; _Pragma("unroll") for (int i = 0; i < 8; ++i) _ss += _x[i] * _x[i]; \
                    _ss += __shfl_xor(_ss, 1); _ss += __shfl_xor(_ss, 2); _ss += __shfl_xor(_ss, 4); _ss += __shfl_xor(_ss, 8); \
                    const float _ri = rsqrtf(_ss * (1.0f / 128.0f) + NORM_EPS); \
                    _Pragma("unroll") for (int i = 0; i < 8; ++i) out[i] = _x[i] * _ri * gain[i >> 2][i & 3]; } while (0)
#define ROPE8(v, R) do { const int seg = l16 >> 2; \
                    _Pragma("unroll") for (int i = 0; i < 8; ++i) { const float pvv = __shfl_xor(v[i], 4); const float c_ = R.rcs[i >> 1][(2 * i) & 3], s_ = R.rcs[i >> 1][(2 * i + 1) & 3]; v[i] = (seg & 1) ? (v[i] * c_ + pvv * s_) : (v[i] * c_ - pvv * s_); } } while (0)
#define PACK8(v, w) do { w.x = cvt_pk_bf16(v[0], v[1]); w.y = cvt_pk_bf16(v[2], v[3]); w.z = cvt_pk_bf16(v[4], v[5]); w.w = cvt_pk_bf16(v[6], v[7]); } while (0)
#define PREP_ROW(ROW, R) do { const int row_ = (ROW); int b, kvrow; bool lat; if (row_ < RL) { b = row_ >> 12; kvrow = CTXL + (row_ & 4095); lat = true; } else { const int rc = row_ - RL; b = rc >> 8; kvrow = rc & 255; lat = false; } \
                const int ch = lane * 8; \
                { float y[8]; \
                  _Pragma("unroll") for (int i = 0; i < 4; ++i) { \
                      const float w0a = cw[0][i >> 1][(2 * i) & 3], w1a = cw[1][i >> 1][(2 * i) & 3], w2a = cw[2][i >> 1][(2 * i) & 3]; \
                      const float w0b = cw[0][i >> 1][(2 * i + 1) & 3], w1b = cw[1][i >> 1][(2 * i + 1) & 3], w2b = cw[2][i >> 1][(2 * i + 1) & 3]; \
                      y[2 * i] = bf_lo(R.gb[i]) * (w0a * (bf_lo(R.pc[i]) * bf_lo(R.pv[i])) + w1a * (bf_lo(R.zc[i]) * bf_lo(R.zv[i])) + w2a * (bf_lo(R.nc[i]) * bf_lo(R.nv[i]))); \
                      y[2 * i + 1] = bf_hi(R.gb[i]) * (w0b * (bf_hi(R.pc[i]) * bf_hi(R.pv[i])) + w1b * (bf_hi(R.zc[i]) * bf_hi(R.zv[i])) + w2b * (bf_hi(R.nc[i]) * bf_hi(R.nv[i]))); } \
                  u32x4 w; PACK8(y, w); *(u32x4*)(Y + (size_t)row_ * DM + 512 + ch) = w; } \
                { float o[8]; HEADNORM(R.nq, gq_, o); u32x4 w; PACK8(o, w); *(u32x4*)(NQ + (size_t)row_ * 512 + ch) = w; } \
                { float o[8]; HEADNORM(R.nk, gk_, o); u32x4 w; PACK8(o, w); *(u32x4*)(NK + ((size_t)b * KVL + kvrow) * 512 + ch) = w; } \
                { float o[8]; HEADNORM(R.gq, hq_, o); if (lat) ROPE8(o, R); u32x4 w; PACK8(o, w); *(u32x4*)(GQ + (size_t)row_ * 512 + ch) = w; } \
                { float o[8]; HEADNORM(R.gk, hk_, o); if (lat) ROPE8(o, R); u32x4 w; PACK8(o, w); \
                  if (lane < 32) *(u32x4*)(GK + ((size_t)b * KVL + kvrow) * 256 + ch) = w; } } while (0)
            for (int row = gw; row < RT; row += 2 * NGW) {
                const int rowB = row + NGW; const bool hasB = rowB < RT;
                PrepRaw ra, rb;
                PREP_LOAD(row, ra); PREP_LOAD(hasB ? rowB : row, rb);
                PREP_ROW(row, ra);
                if (hasB) PREP_ROW(rowB, rb);
            }
#undef PREP_LOAD
#undef PREP_ROW
#undef HEADNORM
#undef ROPE8
#undef PACK8
            if (layer == 0) { LAS bf16_t* tscr = (LAS bf16_t*)(lds + wave * 8704);
              CDF_WAIT(4, 16);
              for (int item = (RL / 64) * 16 + gw; item < (RT / 64) * 16; item += NGW) {
                  const int rb = item >> 4, cb = item & 15, r0 = rb * 64, c0 = cb * 64;
#pragma unroll
                  for (int i = 0; i < 8; ++i) { const int rr = 8 * i + (lane >> 3), c8 = (lane & 7) * 8; const u32x4 v = *(const u32x4*)(PF + (size_t)(r0 + rr) * PFW + c0 + c8);
#pragma unroll
                      for (int k = 0; k < 4; ++k) { tscr[(c8 + 2 * k) * 66 + rr] = (bf16_t)(v[k] & 0xffffu); tscr[(c8 + 2 * k + 1) * 66 + rr] = (bf16_t)(v[k] >> 16); } }
                  LDS_WAIT();
#pragma unroll
                  for (int i = 0; i < 8; ++i) { const int cc = 8 * i + (lane >> 3), l8 = (lane & 7) * 8; const LAS unsigned* s = (const LAS unsigned*)(tscr + cc * 66 + l8);
                      u32x4 w; w.x = s[0]; w.y = s[1]; w.z = s[2]; w.w = s[3];
                      const int cg = c0 + cc; const int cm = cg & 511, sn = cg >> 9;
                      const int rc0 = r0 - RL, b = rc0 >> 8, l0 = rc0 & 255; *(u32x4*)(PTC + ((size_t)b * 512 + cm) * 512 + sn * 256 + l0 + l8) = w; }
                  LDS_WAIT();
              } }
            __syncthreads();
            for (int u = wg; u < NB * 64; u += G) {
                const int b = u >> 6, l2 = u & 63;
                const bf16_t* M1 = (const bf16_t*)(wsb + WS_FFT); const float* TW = (const float*)(wsb + WS_FFT + 49152); bf16_t* O1 = (bf16_t*)(wsb + WS_T);
                __syncthreads();
                cdft_to_slab(lds, P + ((size_t)b * SEQ + l2) * NP, (size_t)64 * NP, (const bf16_t*)(wsb + WS_MB) + (size_t)layer * PFW * NP, NP);
                auto rowp = [=](int) -> const bf16_t* { return nullptr; };
                auto epi = [=](int mbp, const f32x16 (&acc)[2][2], int wid, int r32, int hi) {
#pragma unroll
                        for (int r = 0; r < 16; ++r) { const int k1 = 32 * mbp + att::crow(r, hi); const f32x2 tw = *(const f32x2*)(TW + 2 * ((k1 * l2) & 4095));
                            bf16_t* o = O1 + ((((size_t)b * 64 + k1) * 2) * 64 + l2) * 512 + 64 * wid + r32;
#pragma unroll
                            for (int nb = 0; nb < 2; ++nb) { const float ur = acc[0][nb][r], ui = acc[1][nb][r]; const float vr = ur * tw.x + ui * tw.y, vi = ui * tw.x - ur * tw.y;
                                o[32 * nb] = (bf16_t)(cvt_pk_bf16(vr, vr) & 0xffffu); o[64 * 512 + 32 * nb] = (bf16_t)(cvt_pk_bf16(vi, vi) & 0xffffu); } } };
                fft_stage<2, false>(lds, M1, rowp, epi);
            }
#undef CDF_WAIT
        }
        SEAM(pb + 2);

        DUP(3) if (EN(3) && IN(pb + 3)) {
            PHASE_IDS();
            unsigned char* wsb = WSB(); bf16_t* Y = (bf16_t*)(wsb + WS_Y);
            const bf16_t* NQ = (const bf16_t*)(wsb + WS_NQ); const bf16_t* NK = (const bf16_t*)(wsb + WS_NK); const bf16_t* NV = (const bf16_t*)(wsb + WS_NV); const bf16_t* GQ = (const bf16_t*)(wsb + WS_GQ); const bf16_t* GK = (const bf16_t*)(wsb + WS_GK); const bf16_t* GV = (const bf16_t*)(wsb + WS_GV);
            const bf16_t* PTC = (const bf16_t*)(wsb + WS_PTC); const bf16_t* Tc = (const bf16_t*)(wsb + WS_TC);
            LAS float* rpbL = (LAS float*)(lds + RPB_OFF);
            if (MX(0)) for (int u = wg; u < NB * 64; u += G) {
                const int b = u >> 6, k1 = u & 63;
                const bf16_t* M2 = (const bf16_t*)(wsb + WS_FFT) + 128 * 128; const bf16_t* O1 = (const bf16_t*)(wsb + WS_T) + ((size_t)b * 64 + k1) * 2 * 64 * 512;
                auto rowp = [=](int kk) -> const bf16_t* { return O1 + (size_t)kk * 512; };
                auto epi = [=](int, const f32x16 (&acc)[2][2], int wid, int r32, int hi) {
#pragma unroll
                    for (int mb = 0; mb < 2; ++mb)
#pragma unroll
                        for (int r = 0; r < 16; ++r) { const int k2 = 32 * mb + att::crow(r, hi); bf16_t* o = Y + ((size_t)b * SEQ + k1 + 64 * k2) * DM + 64 * wid + r32;
#pragma unroll
                            for (int nb = 0; nb < 2; ++nb) { const float v = acc[mb][nb][r]; o[32 * nb] = (bf16_t)(cvt_pk_bf16(v, v) & 0xffffu); } } };
                fft_stage<1>(lds, M2, rowp, epi);
            }
            if (MX(5) && layer == 0) { pg8::Gemm g{Tc, PTC, 2 * 512}; pg8::DftOrder S{wg, 1}; pg8::EpiStoreBf16 E{Y, DM}; pg8::gemm_phase<pg8::EpiStoreBf16, pg8::DftOrder>(lds, g, S, E); }
            __syncthreads();
            if (MX(1)) for (int uu = wg; uu < 256; uu += G) {
                const int qb = uu & 15, h = (uu >> 4) & 3, b = uu >> 6;
                __syncthreads();
                for (int i = tid; i < 465; i += 512) rpbL[i] = INP(I_RPB)[(size_t)(layer * 4 + h) * 465 + i] * att::LOG2E;
                __syncthreads();
                const int r0 = qb * 4;
                const int rs_lo = min(max(r0 - 4, 0), 56), rs_hi = min(max(r0 + 3 - 4, 0), 56);
                int rlo = rs_lo, rhi = rs_hi + 7; if (((rhi - rlo + 1) & 1) != 0) { if (rhi < 63) ++rhi; else --rlo; }
                const int NT = 4 + (rhi - rlo + 1);
                attn_na_call(NQ + ((size_t)b * SEQ + qb * 256) * 512 + h * 128, NK + (size_t)b * KVL * 512 + h * 128, NV + (size_t)b * KVL * 512 + h * 128, Y + ((size_t)b * SEQ + qb * 256) * DM + 1024 + h * 128, NT, r0, rlo);
            }
            if (MX(2)) {
                const int w2 = (wg & 15) == 0 ? 2 * (wg >> 4) : (wg & 15) == 15 ? 2 * (wg >> 4) + 1 : -1;
                const int nun = 1 + ((layer == 0 && w2 >= 0) ? 1 : 0);
                for (int i = 0; i < nun; ++i) {
                    const bf16_t *qp, *kp, *vp; bf16_t* op; int ldk, nt;
                    if (i < 1) { const int uu = wg & 255, qb = uu & 15, h = (uu >> 4) & 3, b = uu >> 6, kvh = h >> 1;
                        qp = GQ + ((size_t)b * SEQ + qb * 256) * 512 + h * 128; kp = GK + (size_t)b * KVL * 256 + kvh * 128; vp = GV + (size_t)b * KVL * 256 + kvh * 128;
                        op = Y + ((size_t)b * SEQ + qb * 256) * DM + 1536 + h * 128; ldk = 256; nt = KVL / 64; }
                    else if (w2 < 16) { const int h = w2 & 3, b = w2 >> 2, kvh = h >> 1;
                        qp = GQ + ((size_t)RL + b * CTXL) * 512 + h * 128; kp = GK + (size_t)b * KVL * 256 + kvh * 128; vp = GV + (size_t)b * KVL * 256 + kvh * 128;
                        op = Y + ((size_t)RL + b * CTXL) * DM + 1536 + h * 128; ldk = 256; nt = CTXL / 64; }
                    else { const int h = w2 & 3, b = (w2 - 16) >> 2;
                        qp = NQ + ((size_t)RL + b * CTXL) * 512 + h * 128; kp = NK + (size_t)b * KVL * 512 + h * 128; vp = NV + (size_t)b * KVL * 512 + h * 128;
                        op = Y + ((size_t)RL + b * CTXL) * DM + 1024 + h * 128; ldk = 512; nt = CTXL / 64; }
                    attn_dense_call(qp, kp, vp, op, nt, ldk);
                }
            }
        }
        SEAM(pb + 3);

        DUP(4) if (EN(4) && IN(pb + 4)) {
            LAYER_PTRS(); XIN_PTRS(); const bf16_t* Y = (const bf16_t*)(wsb + WS_Y); const bf16_t* Wout_t = (const bf16_t*)(wsb + WS_WOUT); bf16_t* Xmid = (bf16_t*)(wsb + WS_X1);
            pg8::Gemm g{Y, Wout_t + (size_t)layer * DM * DM, 2 * DM};
            pg8::GridOrder S; S.init((layer == 0 ? RT : RL) / 256, DM / 256, G, wg, 0, 0, 0, 0, 256);
            pg8::EpiResid E{xin_lat, xin_ctx, xin_b, Xmid, modl + 2 * 2048, 1.0f};
            pg8::gemm_phase<pg8::EpiResid, pg8::GridOrder>(lds, g, S, E);
            { const int def_ = DEFICIT(((layer == 0 ? RT : RL) / 256) * (DM / 256)); if (def_ > 0) MOE_GRAB(def_ * 14); }
        }
        SEAM(pb + 4);

        if (EN(5) && IN(pb + 5)) {
            PHASE_IDS();
            LAYER_PTRS(); const bf16_t* Xmid = (const bf16_t*)(wsb + WS_X1); unsigned char* HB8 = (unsigned char*)(wsb + WS_HB);
            int* route_pos = (int*)(wsb + WS_ROUTE + 256 * 1024);
            const float* gn = INP(I_N2G) + layer * DM;
            LAS float* wrL = (LAS float*)(lds + ROUTER_LDS);
            if (layer == 1) { for (int i = tid; i < 2048 * 8; i += 512) wrL[i] = INP(I_ROUTER)[i]; __syncthreads(); }
            const int nrows = layer == 0 ? RT : RL;
            f32x4 gv[8];
#pragma unroll
            for (int j = 0; j < 8; ++j) gv[j] = *(const f32x4*)(gn + lane * 4 + 256 * j);
            for (int row0 = gw; row0 < nrows; row0 += 2 * NGW) {
                const int rowB = row0 + NGW; const bool hasB = rowB < nrows; const int rb_ = hasB ? rowB : row0;
                u32x2 va[8], vb[8];
#pragma unroll
                for (int j = 0; j < 8; ++j) va[j] = *(const u32x2*)(Xmid + (size_t)row0 * DM + lane * 4 + 256 * j);
#pragma unroll
                for (int j = 0; j < 8; ++j) vb[j] = *(const u32x2*)(Xmid + (size_t)rb_ * DM + lane * 4 + 256 * j);
#pragma unroll 1
                for (int half = 0; half < 2; ++half) {
                if (half == 1 && !hasB) break;
                const int row = half ? rowB : row0;
                f32x4 v[8];
#pragma unroll
                for (int j = 0; j < 8; ++j) v[j] = bf4(half ? vb[j] : va[j]);
                const int mr = row < RL ? (row >> 12) : 4;
                const float* sh = modl + (size_t)mr * 12288 + 3 * 2048; const float* sc = sh + 2048;
                float ss = 0.f;
#pragma unroll
                for (int j = 0; j < 8; ++j) ss += (v[j][0] * v[j][0] + v[j][1] * v[j][1]) + (v[j][2] * v[j][2] + v[j][3] * v[j][3]);
                const float rinv = rsqrtf(wave_sum(ss) * (1.0f / DM) + NORM_EPS);
                float lg[8] = {0.f, 0.f, 0.f, 0.f, 0.f, 0.f, 0.f, 0.f};
                unsigned hq[8];
#pragma unroll
                for (int j = 0; j < 8; ++j) { const int c = lane * 4 + 256 * j; const f32x4 g = gv[j], s1 = *(const f32x4*)(sc + c), s0 = *(const f32x4*)(sh + c);
                    const f32x4 h = v[j] * rinv * g * (s1 + 1.0f) + s0;
                    hq[j] = pk4_fp8(h[0] * F8_SH, h[1] * F8_SH, h[2] * F8_SH, h[3] * F8_SH);
                    if (layer == 0) *(unsigned*)(HB8 + (size_t)row * DM + c) = hq[j];
                    if (layer == 1) {
#pragma unroll
                        for (int k = 0; k < 4; ++k) { const f32x4 wa = *(const LAS f32x4*)(wrL + (c + k) * 8), wb = *(const LAS f32x4*)(wrL + (c + k) * 8 + 4);
                            lg[0] += h[k] * wa[0]; lg[1] += h[k] * wa[1]; lg[2] += h[k] * wa[2]; lg[3] += h[k] * wa[3]; lg[4] += h[k] * wb[0]; lg[5] += h[k] * wb[1]; lg[6] += h[k] * wb[2]; lg[7] += h[k] * wb[3]; } } }
                if (layer == 1) {
#pragma unroll
                    for (int e = 0; e < 8; ++e) lg[e] = wave_sum(lg[e]);
                    int i0 = 0; float v0 = lg[0];
#pragma unroll
                    for (int e = 1; e < 8; ++e) if (lg[e] > v0) { v0 = lg[e]; i0 = e; }
                    int i1 = -1; float v1 = -3.0e38f;
#pragma unroll
                    for (int e = 0; e < 8; ++e) if (e != i0 && lg[e] > v1) { v1 = lg[e]; i1 = e; }
                    const float w0 = 1.0f / (1.0f + __expf(v1 - v0)), w1 = 1.0f - w0;
                    int d0 = 0, d1 = 0;
                    if (lane == 0) {
                        const unsigned p0 = atomicAdd(ctl + CW_CNT + 64 * i0, 1u), p1 = atomicAdd(ctl + CW_CNT + 64 * i1, 1u);
                        unsigned* t0w = ctl + CW_TILE + 64 * i0 + (p0 >> 8); unsigned* t1w = ctl + CW_TILE + 64 * i1 + (p1 >> 8);
                        unsigned q0 = 0, q1 = 0;
                        if ((p0 & 255u) == 0u) { q0 = atomicAdd(ctl + CW_POOL, 1u) + 1u; __hip_atomic_store(t0w, q0, RLX_AGENT); }
                        if ((p1 & 255u) == 0u) { q1 = atomicAdd(ctl + CW_POOL, 1u) + 1u; __hip_atomic_store(t1w, q1, RLX_AGENT); }
                        while (q0 == 0u) { q0 = __hip_atomic_load(t0w, RLX_AGENT); if (q0 == 0u) __builtin_amdgcn_s_sleep(1); }
                        while (q1 == 0u) { q1 = __hip_atomic_load(t1w, RLX_AGENT); if (q1 == 0u) __builtin_amdgcn_s_sleep(1); }
                        d0 = (int)((q0 - 1u) * 256u + (p0 & 255u)); d1 = (int)((q1 - 1u) * 256u + (p1 & 255u));
                        route_pos[2 * row] = d0; route_pos[2 * row + 1] = d1; }
                    d0 = __builtin_amdgcn_readfirstlane(d0); d1 = __builtin_amdgcn_readfirstlane(d1);
                    unsigned char* APERM8 = wsb + WS_APERM; float* roww = (float*)(wsb + WS_ROUTE + 384 * 1024);
                    { const size_t d = (size_t)d0;
#pragma unroll
                        for (int j = 0; j < 8; ++j) *(unsigned*)(APERM8 + d * DM + lane * 4 + 256 * j) = hq[j];
                        if (lane == 0) roww[d] = w0; }
                    { const size_t d = (size_t)d1;
#pragma unroll
                        for (int j = 0; j < 8; ++j) *(unsigned*)(APERM8 + d * DM + lane * 4 + 256 * j) = hq[j];
                        if (lane == 0) roww[d] = w1; }
                }
                }
            }
            if (layer == 1) MOE_DRAIN(CW_QUP, 0, NT_MUP);
            __syncthreads();
        }
        SEAM(pb + 5);

        if (layer == 0) {
            DUP(7) if (EN(7) && IN(pb + 7)) {
                unsigned char* wsb = WSB(); const unsigned char* HB8 = wsb + WS_HB; const unsigned char* Wup8 = wsb + WS_WUP; unsigned char* ACT8 = wsb + WS_ACT;
                pg8::Gemm g{HB8, Wup8, DM};
                pg8::GridOrder S; S.init(RT / 256, 2 * DFF / 256, G, wg, 0, 0, 0, 0, 128);
                pg8::EpiSwiglu8 E{ACT8, DFF, 1.0f / (F8_SW * F8_SH), F8_SA};
                pg8::gemm_phase<pg8::EpiSwiglu8, pg8::GridOrder, true>(lds, g, S, E);
                { const int def_ = DEFICIT((RT / 256) * (2 * DFF / 256)); if (def_ > 0) MOE_GRAB(def_ * 7); }
            }
            SEAM(pb + 7);
            DUP(8) if (EN(8) && IN(pb + 8)) {
                LAYER_PTRS(); const unsigned char* ACT8 = wsb + WS_ACT; const unsigned char* Wdn8 = wsb + WS_WDN; const bf16_t* Xmid = (const bf16_t*)(wsb + WS_X1); bf16_t* X2 = (bf16_t*)(wsb + WS_X2);
                pg8::Gemm g{ACT8, Wdn8, DFF};
                pg8::GridOrder S; S.init(RT / 256, DM / 256, G, wg, 0, 0, 0, 0, 256);
                pg8::EpiResid E{nullptr, nullptr, Xmid, X2, modl + 5 * 2048, 1.0f / (F8_SW * F8_SA)};
                pg8::gemm_phase<pg8::EpiResid, pg8::GridOrder, true>(lds, g, S, E);
                { const int def_ = DEFICIT((RT / 256) * (DM / 256)); if (def_ > 0) MOE_GRAB(def_ * 20); }
            }
            SEAM(pb + 8);
        } else {
            volatile LAS int* tb = (volatile LAS int*)(MISC + 16); volatile LAS int* tl = (volatile LAS int*)(lds + TL_OFF);
            if (IN(pb + 7) || IN(pb + 8) || IN(pb + 9)) {
                __syncthreads();
                if (tid == 0) { int acc = 0; for (int e = 0; e < 8; ++e) { tb[e] = acc; const int c = (int)__hip_atomic_load(ctl + CW_CNT + 64 * e, RLX_AGENT); acc += (c + 255) >> 8; } tb[8] = acc; }
                __syncthreads();
                { int t_ = (int)threadIdx.x; asm volatile("" : "+v"(t_)); const int e = t_ >> 6, j = t_ & 63; if (j < tb[e + 1] - tb[e]) tl[tb[e] + j] = (int)__hip_atomic_load(ctl + CW_TILE + 64 * e + j, RLX_AGENT) - 1; }
                __syncthreads();
            }
            DUP(11) if (EN(11) && IN(pb + 7)) {
                unsigned char* wsb = WSB(); const unsigned char* APERM8 = wsb + WS_APERM; const unsigned char* Mup8 = wsb + WS_MUP; unsigned char* ACTM8 = wsb + WS_ACTM;
                pg8::Gemm g{APERM8, Mup8, DM};
                pg8::MoeOrder S{G, wg, 2 * DFE / 256, 128, 2 * DFE, tb, tl};
                pg8::EpiSwiglu8 E{ACTM8, DFE, 1.0f / (F8_SW * F8_SH), F8_SA};
                pg8::gemm_phase<pg8::EpiSwiglu8, pg8::MoeOrder, true>(lds, g, S, E);
                MOE_DRAIN(CW_QDN, NT_MUP, NT_MDN);
            }
            SEAM(pb + 7);
            DUP(12) if (EN(12) && IN(pb + 8)) {
                unsigned char* wsb = WSB(); const unsigned char* ACTM8 = wsb + WS_ACTM; const unsigned char* Mdn8 = wsb + WS_MDN; bf16_t* OPERM = (bf16_t*)(wsb + WS_OPERM); const float* roww = (const float*)(wsb + WS_ROUTE + 384 * 1024);
                pg8::Gemm g{ACTM8, Mdn8, DFE};
                const int T_ = tb[8] * (DM / 256), F_ = T_ / G, rem_ = T_ % G;
                const int KS = (rem_ > 0 && rem_ * 4 <= G) ? 4 : (rem_ > 0 && rem_ * 2 <= G) ? 2 : 1;
                pg8::MoeOrder S{G, wg, DM / 256, 256, DM, tb, tl, KS > 1 ? F_ * G : 0x7fffffff};
                pg8::EpiMoeDown E{OPERM, roww, 1.0f / (F8_SW * F8_SA)};
                pg8::gemm_phase<pg8::EpiMoeDown, pg8::MoeOrder, true>(lds, g, S, E);
                if (KS > 1) {
                    const int j = wg / KS, q = wg % KS; const bool mine = j < rem_;
                    float* slab = (float*)(wsb + WS_APERM) + (size_t)(j * KS + q) * 65536;
                    pg8::MoeTailOrder TS{S, mine ? F_ * G + j : -1};
                    pg8::Gemm g2{ACTM8 + q * (DFE / KS), Mdn8 + q * (DFE / KS), DFE, DFE / KS};
                    pg8::EpiPartial E2{slab};
                    pg8::gemm_phase<pg8::EpiPartial, pg8::MoeTailOrder, true>(lds, g2, TS, E2);
                    if (mine) {
                        if (threadIdx.x == 0) { __builtin_amdgcn_fence(__ATOMIC_RELEASE, "agent"); asm volatile("s_waitcnt vmcnt(0)" ::: "memory");
                            (void)xb_add(ctl + CW_KS + j, 1u);
                            while (xb_ld(ctl + CW_KS + j) < (unsigned)KS) __builtin_amdgcn_s_sleep(1);
                            __builtin_amdgcn_fence(__ATOMIC_ACQUIRE, "agent"); asm volatile("s_waitcnt vmcnt(0)" ::: "memory"); }
                        __syncthreads();
                        {   pg8::Unit u; (void)S.unit(F_ * G + j, u);
                            int t_ = (int)threadIdx.x; asm volatile("" : "+v"(t_));
                            const int rpw = 256 / KS;
                            const int r = q * rpw + t_ / (512 / rpw), ncol = 256 / (512 / rpw), hc = (t_ % (512 / rpw)) * ncol;
                            const float rw = roww[u.orow + r] * (1.0f / (F8_SW * F8_SA));
                            const float* sp = (const float*)(wsb + WS_APERM) + (size_t)(j * KS) * 65536 + (size_t)r * 256 + hc; bf16_t* op = OPERM + (size_t)(u.orow + r) * DM + u.ocol + hc;
#pragma unroll 4
                            for (int c8 = 0; c8 < ncol / 8; ++c8) { f32x4 a0 = {0.f, 0.f, 0.f, 0.f}, a1 = {0.f, 0.f, 0.f, 0.f};
                                for (int qq = 0; qq < KS; ++qq) { a0 += *(const f32x4*)(sp + (size_t)qq * 65536 + c8 * 8); a1 += *(const f32x4*)(sp + (size_t)qq * 65536 + c8 * 8 + 4); }
                                a0 *= rw; a1 *= rw;
                                u32x4 w; w.x = cvt_pk_bf16(a0[0], a0[1]); w.y = cvt_pk_bf16(a0[2], a0[3]); w.z = cvt_pk_bf16(a1[0], a1[1]); w.w = cvt_pk_bf16(a1[2], a1[3]);
                                *(u32x4*)(op + c8 * 8) = w; }
                        }
                        __syncthreads();
                    }
                }
            }
            SEAM(pb + 8);
            DUP(9) if (EN(9) && IN(pb + 9)) {
            PHASE_IDS();
                LAYER_PTRS(); const bf16_t* Xmid = (const bf16_t*)(wsb + WS_X1); const bf16_t* OPERM = (const bf16_t*)(wsb + WS_OPERM); float* outp = OUTP();
                const int* route_pos = (const int*)(wsb + WS_ROUTE + 256 * 1024);
                for (int t = gw; t < RL; t += 2 * NGW) {
                    const int tB = t + NGW; const bool hasB = tB < RL; const int tb_ = hasB ? tB : t;
                    const int a0 = route_pos[2 * t], a1 = route_pos[2 * t + 1];
                    const int c0 = route_pos[2 * tb_], c1 = route_pos[2 * tb_ + 1];
                    u32x2 xa[8], xb[8]; u32x2 pa0[8], pa1[8], pb0[8], pb1[8];
#pragma unroll
                    for (int j = 0; j < 8; ++j) { const int c = lane * 4 + 256 * j; xa[j] = *(const u32x2*)(Xmid + (size_t)t * DM + c); pa0[j] = *(const u32x2*)(OPERM + (size_t)a0 * DM + c); pa1[j] = *(const u32x2*)(OPERM + (size_t)a1 * DM + c); }
#pragma unroll
                    for (int j = 0; j < 8; ++j) { const int c = lane * 4 + 256 * j; xb[j] = *(const u32x2*)(Xmid + (size_t)tb_ * DM + c); pb0[j] = *(const u32x2*)(OPERM + (size_t)c0 * DM + c); pb1[j] = *(const u32x2*)(OPERM + (size_t)c1 * DM + c); }
                    { const float* g2 = modl + (size_t)(t >> 12) * 12288 + 5 * 2048;
#pragma unroll
                      for (int j = 0; j < 8; ++j) { const int c = lane * 4 + 256 * j; const f32x4 gg = *(const f32x4*)(g2 + c); const u32x2 a = pa0[j], b = pa1[j]; const f32x4 x = bf4(xa[j]);
                        f32x4 o; o[0] = x[0] + gg[0] * (bf_lo(a.x) + bf_lo(b.x)); o[1] = x[1] + gg[1] * (bf_hi(a.x) + bf_hi(b.x)); o[2] = x[2] + gg[2] * (bf_lo(a.y) + bf_lo(b.y)); o[3] = x[3] + gg[3] * (bf_hi(a.y) + bf_hi(b.y));
                        *(f32x4*)(outp + (size_t)t * DM + c) = o; } }
                    if (hasB) { const float* g2 = modl + (size_t)(tB >> 12) * 12288 + 5 * 2048;
#pragma unroll
                      for (int j = 0; j < 8; ++j) { const int c = lane * 4 + 256 * j; const f32x4 gg = *(const f32x4*)(g2 + c); const u32x2 a = pb0[j], b = pb1[j]; const f32x4 x = bf4(xb[j]);
                        f32x4 o; o[0] = x[0] + gg[0] * (bf_lo(a.x) + bf_lo(b.x)); o[1] = x[1] + gg[1] * (bf_hi(a.x) + bf_hi(b.x)); o[2] = x[2] + gg[2] * (bf_lo(a.y) + bf_lo(b.y)); o[3] = x[3] + gg[3] * (bf_hi(a.y) + bf_hi(b.y));
                        *(f32x4*)(outp + (size_t)tB * DM + c) = o; } }
                }
            }
        }
    }
#undef IN
#undef SEAM
}

template <unsigned PM, unsigned MM> static int prep_kernel() {
    if (hipFuncSetAttribute((const void*)mk_fwd<PM, MM>, hipFuncAttributeMaxDynamicSharedMemorySize, LDS_BYTES) != hipSuccess) { fprintf(stderr, "kernel_launch: hipFuncSetAttribute failed\n"); return -1; }
    return 0;
}
template <unsigned PM, unsigned MM> static void launch_ph(int grid, Args a, int lo, int hi, hipStream_t stream) {
    static int ok = 0; if (ok == 0) ok = prep_kernel<PM, MM>() == 0 ? 1 : -1; if (ok < 0) return;
    a.ph_lo = lo; a.ph_hi = hi;
    hipLaunchKernelGGL((mk_fwd<PM, MM>), dim3(grid), dim3(512), LDS_BYTES, stream, a);
}
extern "C" void kernel_launch(void* const* d_in, const int* in_sizes, int n_in, void* d_out, int out_size, void* d_ws, size_t ws_size, hipStream_t stream) {
    static int grid = 0;
    if (grid == 0) {
        if (n_in != 24 || out_size != RL * DM || ws_size < WS_END) { fprintf(stderr, "kernel_launch: unexpected shapes (n_in %d out %d ws %zu need %zu)\n", n_in, out_size, ws_size, (size_t)WS_END); grid = -1; return; }
        int dev = 0, cus = 0;
        if (hipGetDevice(&dev) != hipSuccess || hipDeviceGetAttribute(&cus, hipDeviceAttributeMultiprocessorCount, dev) != hipSuccess) { grid = -1; return; }
        grid = cus;
    }
    if (grid < 0) return;
    (void)hipMemsetAsync((char*)d_ws + WS_CTL, 0, CTL_ZERO_BYTES, stream);
    Args a{};
    for (int i = 0; i < 24; ++i) a.in[i] = (const float*)d_in[i];
    a.out = (float*)d_out; a.ws = (unsigned char*)d_ws;
#if MK_ONE_LAUNCH
    launch_ph<0xFFFFFFFFu, 0xFFu>(grid, a, 0, 21, stream);
#else
    launch_ph<1u << 10, 0>(grid, a, 0, 1, stream);
    for (int l = 0; l < 2; ++l) { const int pb = 1 + 10 * l;
        launch_ph<1u << 0, 0>(grid, a, pb + 0, pb + 1, stream);
        launch_ph<1u << 1, 0>(grid, a, pb + 1, pb + 2, stream);
        launch_ph<1u << 2, 0>(grid, a, pb + 2, pb + 3, stream);
        launch_ph<1u << 3, 1u>(grid, a, pb + 3, pb + 4, stream);
        if (l == 0) launch_ph<1u << 3, 32u>(grid, a, pb + 3, pb + 4, stream);
        launch_ph<1u << 3, 2u>(grid, a, pb + 3, pb + 4, stream);
        launch_ph<1u << 3, 4u>(grid, a, pb + 3, pb + 4, stream);
        launch_ph<1u << 4, 0>(grid, a, pb + 4, pb + 5, stream);
        launch_ph<1u << 5, 0>(grid, a, pb + 5, pb + 6, stream);
        if (l == 0) { launch_ph<1u << 7, 0>(grid, a, pb + 7, pb + 8, stream); launch_ph<1u << 8, 0>(grid, a, pb + 8, pb + 9, stream); }
        else { launch_ph<1u << 11, 0>(grid, a, pb + 7, pb + 8, stream); launch_ph<1u << 12, 0>(grid, a, pb + 8, pb + 9, stream); launch_ph<1u << 9, 0>(grid, a, pb + 9, pb + 10, stream); }
    }
#endif
}
```

```cpp
#include <hip/hip_runtime.h>
#include <hip/hip_bf16.h>
#include <cstdio>
#include <cstdint>

#ifndef PROBE_DUP
#define PROBE_DUP 0u
#endif
#ifndef PROBE_SUB
#define PROBE_SUB 0u
#endif
#define SUBDUP(k) for (int _q = 0; _q < 1 + (int)((PROBE_SUB >> (k)) & 1u); ++_q)
#define DUP(k) for (int _r = 0; _r < 1 + (int)((PROBE_DUP >> (k)) & 1u); ++_r)
#define EN(k) (((PM) >> (k)) & 1u)
#define MX(k) (((MM) >> (k)) & 1u)
#ifndef MK_ONE_LAUNCH
#define MK_ONE_LAUNCH 1
#endif

#define LAS __attribute__((address_space(3)))
typedef unsigned short bf16_t;
typedef short bf16x8 __attribute__((ext_vector_type(8)));
typedef short s16x4 __attribute__((ext_vector_type(4)));
typedef float f32x4 __attribute__((ext_vector_type(4)));
typedef float f32x2 __attribute__((ext_vector_type(2)));
typedef float f32x16 __attribute__((ext_vector_type(16)));
typedef unsigned u32x4 __attribute__((ext_vector_type(4)));
typedef unsigned u32x2 __attribute__((ext_vector_type(2)));

constexpr int DM = 2048, NB = 4, SEQ = 4096, CTXL = 256;
constexpr int RL = NB * SEQ, RC = NB * CTXL, RT = RL + RC;
constexpr int NP = 4608;
constexpr int INW = 4608;
constexpr int KVL = CTXL + SEQ;
constexpr int DFF = 5632, NEXP = 8, DFE = 7168;
constexpr int MOE_TILES_MAX = 2 * RL / 256 + NEXP;
constexpr int MOE_ROWS_MAX = MOE_TILES_MAX * 256;
constexpr float NORM_EPS = 1e-6f;
constexpr int PC_V = 0, PC_CB = 512, PC_CC = 1024, PC_CV = 1536, PC_NQ = 2048, PC_NK = 2560, PC_NV = 3072, PC_GQ = 3584, PC_GK = 4096, PC_GV = 4352;
constexpr int PFW = 1024;

constexpr size_t MiB = 1u << 20;
constexpr size_t WS_CTL = 0, CTL_ZERO_BYTES = 1 * MiB;
constexpr size_t WS_MOD = 1 * MiB;
constexpr size_t WS_ROPE = 1 * MiB + 512 * 1024;
constexpr size_t WS_ROUTE = 2 * MiB;
constexpr size_t WS_T = 3 * MiB;
constexpr size_t WS_MB = 37 * MiB;
constexpr size_t WS_FFT = 1 * MiB + 768 * 1024;
constexpr size_t WS_TC = 67 * MiB;
constexpr size_t WS_WIN = 68 * MiB;
constexpr size_t WS_WOUT = 108 * MiB;
constexpr size_t WS_WUP = 124 * MiB;
constexpr size_t WS_WDN = 168 * MiB;
constexpr size_t WS_MUP = 190 * MiB;
constexpr size_t WS_MDN = 638 * MiB;
constexpr size_t WS_X1 = 862 * MiB;
constexpr size_t WS_X2 = 998 * MiB;
constexpr size_t WS_HB = 1134 * MiB;
constexpr size_t WS_S = 1202 * MiB;
constexpr size_t WS_P = WS_S;
constexpr size_t WS_NQ = WS_S + 170 * MiB;
constexpr size_t WS_NK = WS_NQ + 17 * MiB;
constexpr size_t WS_NV = WS_NK + 17 * MiB;
constexpr size_t WS_GQ = WS_NV + 17 * MiB;
constexpr size_t WS_GK = WS_GQ + 17 * MiB;
constexpr size_t WS_GV = WS_GK + 9 * MiB;
constexpr size_t WS_PF = WS_GV + 9 * MiB;
constexpr size_t WS_PTC = WS_PF + 34 * MiB;
constexpr size_t WS_Y = WS_PTC + 2 * MiB;
constexpr size_t WS_ACT = WS_S;
constexpr size_t WS_APERM = WS_S;
constexpr size_t WS_ACTM = WS_S + 136 * MiB;
constexpr size_t WS_OPERM = WS_X2;
constexpr size_t WS_END = WS_ACTM + 240 * MiB;
static_assert(WS_Y + 68 * MiB <= WS_END && WS_ACT + 187 * MiB <= WS_Y, "ws map");

constexpr int CW_BAR = 4096;
constexpr int CW_CNT = 8192;
constexpr int CW_POOL = 9344;
constexpr int CW_KS = 11264;
constexpr int CW_CDF = 9408;
constexpr int CW_TILE = 10240;

constexpr int LDS_BYTES = 147456;
constexpr int MISC_OFF = 131072;
constexpr int TL_OFF = MISC_OFF + 12288;
constexpr int RPB_OFF = MISC_OFF + 1024 + 512;
constexpr int ROUTER_LDS = 0;

#define GAS __attribute__((address_space(1)))
#define RLX_AGENT __ATOMIC_RELAXED, __HIP_MEMORY_SCOPE_AGENT
#define LDS_WAIT() asm volatile("s_waitcnt lgkmcnt(0)" ::: "memory")
#define VM_WAIT() asm volatile("s_waitcnt vmcnt(0)" ::: "memory")

__device__ __forceinline__ unsigned cvt_pk_bf16(float lo, float hi) { unsigned r; asm volatile("v_cvt_pk_bf16_f32 %0, %1, %2" : "=v"(r) : "v"(lo), "v"(hi)); return r; }
__device__ __forceinline__ float bf_lo(unsigned w) { return __uint_as_float(w << 16); }
__device__ __forceinline__ float bf_hi(unsigned w) { return __uint_as_float(w & 0xffff0000u); }
__device__ __forceinline__ f32x4 bf4(u32x2 w) { f32x4 r; r[0] = bf_lo(w.x); r[1] = bf_hi(w.x); r[2] = bf_lo(w.y); r[3] = bf_hi(w.y); return r; }
__device__ __forceinline__ float wave_sum(float v) {
#pragma unroll
    for (int o = 1; o < 64; o <<= 1) v += __shfl_xor(v, o);
    return v;
}
constexpr float F8_SW = 64.0f, F8_SH = 2.0f, F8_SA = 4.0f;
__device__ __forceinline__ float clamp448(float x) { return __builtin_amdgcn_fmed3f(x, -448.0f, 448.0f); }
__device__ __forceinline__ unsigned pk4_fp8(float a, float b, float c, float d) { int w = 0; w = __builtin_amdgcn_cvt_pk_fp8_f32(clamp448(a), clamp448(b), w, false); w = __builtin_amdgcn_cvt_pk_fp8_f32(clamp448(c), clamp448(d), w, true); return (unsigned)w; }
__device__ __forceinline__ float silu_f(float a) { return a / (1.0f + __expf(-a)); }

namespace pg8 {
constexpr int BM = 256, BK = 64, HALF = 128, HTB = HALF * BK * 2, STAGE_BYTES = 8 * HTB, NXCD = 8, WGM = 8;
__host__ __device__ __forceinline__ int lds_byte(int r, int c) { const int st = (r >> 4) * 2 + (c >> 5), rr = r & 15, cc = c & 31, ob = rr * 64 + cc * 2; return st * 1024 + (ob ^ (((ob >> 9) & 1) << 5)); }
__host__ __device__ __forceinline__ void stage_rc(int b, int& R, int& C) { const int st = b / 1024, sb = b % 1024, swz = sb ^ (((sb >> 9) & 1) << 5); R = (st >> 1) * 16 + swz / 64; C = (st & 1) * 32 + (swz % 64) / 2; }
__host__ __device__ __forceinline__ int perm32(int rho) { const int n = rho >> 4, i = rho & 15; return 8 * (i >> 2) + 4 * n + (i & 3); }

typedef int i32x4 __attribute__((ext_vector_type(4)));
typedef int i32x8 __attribute__((ext_vector_type(8)));
__device__ __forceinline__ i32x8 cat8(bf16x8 a, bf16x8 b) { const i32x4 x = __builtin_bit_cast(i32x4, a), y = __builtin_bit_cast(i32x4, b); return __builtin_shufflevector(x, y, 0, 1, 2, 3, 4, 5, 6, 7); }
struct Unit { int arow, brow, orow, ocol; };
struct Gemm { const void* A; const void* Bt; int rb; int kb = 0; };

struct GridOrder {
    int nM, nN, nwg, G, c, arow0, brow0, orow0, ocol0, ocstep;
    __device__ void init(int nM_, int nN_, int G_, int c_, int arow0_, int brow0_, int orow0_, int ocol0_, int ocstep_) { nM = nM_; nN = nN_; nwg = nM * nN; G = G_; c = c_; asm volatile("" : "+s"(c)); arow0 = arow0_; brow0 = brow0_; orow0 = orow0_; ocol0 = ocol0_; ocstep = ocstep_; }
    __device__ __forceinline__ bool next(int i, Unit& u) const {
        const long L = (long)i * G + c; if (L >= nwg) return false;
        int wgid = (int)L; { const int q = nwg / NXCD, r = nwg % NXCD, xcd = wgid % NXCD, off = wgid / NXCD; wgid = (xcd < r ? xcd * (q + 1) : r * (q + 1) + (xcd - r) * q) + off; }
        const int nig = WGM * nN, gid = wgid / nig, fm = gid * WGM, gsz = (nM - fm) < WGM ? (nM - fm) : WGM;
        const int pm = __builtin_amdgcn_readfirstlane(fm + ((wgid % nig) % gsz)), pn = __builtin_amdgcn_readfirstlane((wgid % nig) / gsz);
        u.arow = arow0 + 256 * pm; u.brow = brow0 + 256 * pn; u.orow = orow0 + 256 * pm; u.ocol = ocol0 + ocstep * pn; return true;
    }
};
struct InProjOrder {
    GridOrder go; int nctxcols;
    __device__ void init(int G_, int c_, int kv_only) { go.init(RL / 256, NP / 256, G_, c_, 0, 0, 0, 0, 256); nctxcols = kv_only ? 6 : NP / 256; }
    __device__ __forceinline__ bool next(int i, Unit& u) const {
        const int L = i * go.G + go.c, nlat = (RL / 256) * (NP / 256);
        if (L < nlat) return go.next(i, u);
        const int q = L - nlat; if (q >= 4 * nctxcols) return false;
        const int pm = RL / 256 + q / nctxcols, j = q % nctxcols; const int pn = nctxcols == 6 ? (j < 4 ? 10 + j : 12 + j) : j;
        u.arow = 256 * pm; u.brow = 256 * pn; u.orow = 256 * pm; u.ocol = 256 * pn; return true;
    }
};
struct DftOrder {
    int c, ctx;
    __device__ __forceinline__ bool next(int i, Unit& u) const {
        if (i > 0) return false;
        if (!ctx) { if (c >= 128) return false; const int b = c >> 5, pm = (c & 31) >> 1, pn = c & 1; u.arow = 256 * pm; u.brow = b * 512 + 256 * pn; u.orow = b * SEQ + 256 * pm; u.ocol = 256 * pn; return true; }
        if (c >= 8) return false; const int b = c >> 1, pn = c & 1; u.arow = 0; u.brow = b * 512 + 256 * pn; u.orow = RL + b * CTXL; u.ocol = 256 * pn; return true;
    }
};
struct MoeOrder {
    int G, c, nN, ocstep, brow_per_exp; const volatile LAS int* tb; const volatile LAS int* tl; int lmax = 0x7fffffff;
    __device__ __forceinline__ bool next(int i, Unit& u) const { const int L = i * G + c; if (L >= lmax) return false; return unit(L, u); }
    __device__ __forceinline__ bool unit(int L, Unit& u) const {
        const int total = tb[8] * nN; if (L >= total) return false;
        int w; { const int q = total / NXCD, r = total % NXCD, xcd = L % NXCD, off = L / NXCD; w = (xcd < r ? xcd * (q + 1) : r * (q + 1) + (xcd - r) * q) + off; }
        int e = 0;
#pragma unroll
        for (int j = 1; j < 8; ++j) if (w >= tb[j] * nN) e = j;
        const int t0 = tb[e], nt = tb[e + 1] - t0, q2 = w - t0 * nN;
        const int nig = WGM * nN, gid = q2 / nig, fm = gid * WGM, gsz = (nt - fm) < WGM ? (nt - fm) : WGM;
        const int pml = fm + ((q2 % nig) % gsz), pn = (q2 % nig) / gsz;
        u.arow = __builtin_amdgcn_readfirstlane(tl[t0 + pml] * 256); u.brow = __builtin_amdgcn_readfirstlane(e * brow_per_exp + pn * 256); u.orow = u.arow; u.ocol = __builtin_amdgcn_readfirstlane(pn * ocstep); return true;
    }
};

struct MoeTailOrder { MoeOrder mo; int L; __device__ __forceinline__ bool next(int i, Unit& u) const { if (i > 0 || L < 0) return false; return mo.unit(L, u); } };

struct EpiStoreBf16 {
    static constexpr bool PERM = true;
    bf16_t* O; int ldc; int bjstep = HALF;
    __device__ __forceinline__ void operator()(const f32x4 (&acc)[2][2][4][2], const Unit& u, int wr, int wc, int fr, int fq) const {
        const int row0 = u.orow + wr * 64 + fr, col0 = u.ocol + wc * 32 + 8 * fq;
#pragma unroll
        for (int ai = 0; ai < 2; ++ai)
#pragma unroll
            for (int m = 0; m < 4; ++m) { bf16_t* rowp = O + (size_t)(row0 + ai * HALF + m * 16) * ldc + col0;
#pragma unroll
                for (int bj = 0; bj < 2; ++bj) { const f32x4 v0 = acc[ai][bj][m][0], v1 = acc[ai][bj][m][1];
                    u32x4 w; w.x = cvt_pk_bf16(v0[0], v0[1]); w.y = cvt_pk_bf16(v0[2], v0[3]); w.z = cvt_pk_bf16(v1[0], v1[1]); w.w = cvt_pk_bf16(v1[2], v1[3]);
                    *(u32x4*)(rowp + bj * bjstep) = w; } }
    }
};
struct EpiInProj {
    static constexpr bool PERM = true;
    bf16_t* P; bf16_t* NV; bf16_t* GV;
    __device__ __forceinline__ void operator()(const f32x4 (&acc)[2][2][4][2], const Unit& u, int wr, int wc, int fr, int fq) const {
        bf16_t* O = P; int ldc = NP, orow = u.orow, ocol = u.ocol;
        const int kvr = u.orow < RL ? (u.orow >> 12) * KVL + CTXL + (u.orow & 4095) : ((u.orow - RL) >> 8) * KVL;
        if (ocol >= PC_NV && ocol < PC_NV + 512) { O = NV; ldc = 512; orow = kvr; ocol -= PC_NV; }
        else if (ocol >= PC_GV) { O = GV; ldc = 256; orow = kvr; ocol -= PC_GV; }
        const int row0 = orow + wr * 64 + fr, col0 = ocol + wc * 32 + 8 * fq;
#pragma unroll
        for (int ai = 0; ai < 2; ++ai)
#pragma unroll
            for (int m = 0; m < 4; ++m) { bf16_t* rowp = O + (size_t)(row0 + ai * HALF + m * 16) * ldc + col0;
#pragma unroll
                for (int bj = 0; bj < 2; ++bj) { const f32x4 v0 = acc[ai][bj][m][0], v1 = acc[ai][bj][m][1];
                    u32x4 w; w.x = cvt_pk_bf16(v0[0], v0[1]); w.y = cvt_pk_bf16(v0[2], v0[3]); w.z = cvt_pk_bf16(v1[0], v1[1]); w.w = cvt_pk_bf16(v1[2], v1[3]);
                    *(u32x4*)(rowp + bj * HALF) = w; } }
    }
};
struct EpiResid {
    static constexpr bool PERM = true;
    const float* res_lat; const float* res_ctx; const bf16_t* res_b; bf16_t* out; const float* gate; float sc;
    __device__ __forceinline__ void operator()(const f32x4 (&acc)[2][2][4][2], const Unit& u, int wr, int wc, int fr, int fq) const {
        const int col0 = u.ocol + wc * 32 + 8 * fq; const int mrow = u.orow < RL ? (u.orow >> 12) : 4;
        const float* rf = u.orow < RL ? res_lat + (size_t)u.orow * DM : res_ctx + (size_t)(u.orow - RL) * DM;
        const bool rbf = res_b != nullptr;
        f32x4 gv[2][2];
#pragma unroll
        for (int bj = 0; bj < 2; ++bj)
#pragma unroll
            for (int n = 0; n < 2; ++n) gv[bj][n] = *(const f32x4*)(gate + (size_t)mrow * 12288 + col0 + bj * HALF + n * 4);
#pragma unroll
        for (int ai = 0; ai < 2; ++ai)
#pragma unroll
            for (int m = 0; m < 4; ++m) { const size_t off = (size_t)(wr * 64 + fr + ai * HALF + m * 16) * DM + col0;
#pragma unroll
                for (int bj = 0; bj < 2; ++bj) { f32x4 r0, r1;
                    if (rbf) { const u32x4 rr = *(const u32x4*)(res_b + (size_t)u.orow * DM + off + bj * HALF);
                        r0[0] = bf_lo(rr.x); r0[1] = bf_hi(rr.x); r0[2] = bf_lo(rr.y); r0[3] = bf_hi(rr.y); r1[0] = bf_lo(rr.z); r1[1] = bf_hi(rr.z); r1[2] = bf_lo(rr.w); r1[3] = bf_hi(rr.w); }
                    else { r0 = *(const f32x4*)(rf + off + bj * HALF); r1 = *(const f32x4*)(rf + off + bj * HALF + 4); }
                    const f32x4 v0 = r0 + gv[bj][0] * (acc[ai][bj][m][0] * sc), v1 = r1 + gv[bj][1] * (acc[ai][bj][m][1] * sc);
                    u32x4 w; w.x = cvt_pk_bf16(v0[0], v0[1]); w.y = cvt_pk_bf16(v0[2], v0[3]); w.z = cvt_pk_bf16(v1[0], v1[1]); w.w = cvt_pk_bf16(v1[2], v1[3]);
                    *(u32x4*)(out + (size_t)u.orow * DM + off + bj * HALF) = w; } }
    }
};
struct EpiSwiglu8 {
    static constexpr bool PERM = true;
    unsigned char* O; int ldc; float inv, osc;
    __device__ __forceinline__ void operator()(const f32x4 (&acc)[2][2][4][2], const Unit& u, int wr, int wc, int fr, int fq) const {
        const int row0 = u.orow + wr * 64 + fr, col0 = u.ocol + wc * 32 + 8 * fq;
        const float io = inv * osc, c1 = -1.4426950408889634f * inv, kk = 1.0f / (inv * io);
#pragma unroll
        for (int ai = 0; ai < 2; ++ai)
#pragma unroll
            for (int m = 0; m < 4; ++m) { unsigned char* rowp = O + (size_t)(row0 + ai * HALF + m * 16) * ldc + col0;
                float v[8];
#pragma unroll
                for (int n = 0; n < 2; ++n)
#pragma unroll
                    for (int j = 0; j < 4; ++j) { const float x0 = acc[ai][0][m][n][j], x1 = acc[ai][1][m][n][j];
                        const float t = __builtin_amdgcn_exp2f(x0 * c1); v[n * 4 + j] = (x0 * x1) * __builtin_amdgcn_rcpf(__builtin_fmaf(t, kk, kk)); }
                u32x2 w; w.x = pk4_fp8(v[0], v[1], v[2], v[3]); w.y = pk4_fp8(v[4], v[5], v[6], v[7]);
                *(u32x2*)rowp = w; }
    }
};
struct EpiMoeDown {
    static constexpr bool PERM = true;
    bf16_t* O; const float* roww; float sc;
    __device__ __forceinline__ void operator()(const f32x4 (&acc)[2][2][4][2], const Unit& u, int wr, int wc, int fr, int fq) const {
        const int row0 = u.orow + wr * 64 + fr, col0 = u.ocol + wc * 32 + 8 * fq;
#pragma unroll
        for (int ai = 0; ai < 2; ++ai)
#pragma unroll
            for (int m = 0; m < 4; ++m) { const int row = row0 + ai * HALF + m * 16; const float rw = roww[row] * sc; bf16_t* rowp = O + (size_t)row * DM + col0;
#pragma unroll
                for (int bj = 0; bj < 2; ++bj) { const f32x4 v0 = acc[ai][bj][m][0] * rw, v1 = acc[ai][bj][m][1] * rw;
                    u32x4 w; w.x = cvt_pk_bf16(v0[0], v0[1]); w.y = cvt_pk_bf16(v0[2], v0[3]); w.z = cvt_pk_bf16(v1[0], v1[1]); w.w = cvt_pk_bf16(v1[2], v1[3]);
                    *(u32x4*)(rowp + bj * HALF) = w; } }
    }
};

struct EpiPartial {
    static constexpr bool PERM = true;
    float* slab;
    __device__ __forceinline__ void operator()(const f32x4 (&acc)[2][2][4][2], const Unit&, int wr, int wc, int fr, int fq) const {
        const int row0 = wr * 64 + fr, col0 = wc * 32 + 8 * fq;
#pragma unroll
        for (int ai = 0; ai < 2; ++ai)
#pragma unroll
            for (int m = 0; m < 4; ++m) { float* rowp = slab + (size_t)(row0 + ai * HALF + m * 16) * 256 + col0;
#pragma unroll
                for (int bj = 0; bj < 2; ++bj) { *(f32x4*)(rowp + bj * HALF) = acc[ai][bj][m][0]; *(f32x4*)(rowp + bj * HALF + 4) = acc[ai][bj][m][1]; } }
    }
};

template <class Epi, class Sched, bool F8 = false, bool ALIGN_EPI = true, bool SP2 = true>
__device__ __forceinline__ void gemm_phase(LAS unsigned char* lds, const Gemm g, const Sched& S, const Epi& E) {
    int tid = threadIdx.x; asm volatile("" : "+v"(tid));
    const int wid = __builtin_amdgcn_readfirstlane(tid >> 6), lane = tid & 63, wr = wid >> 2, wc = wid & 3, fr = lane & 15, fq = lane >> 4;
    int RB = g.rb; asm volatile("" : "+s"(RB)); int KB_ = g.kb ? g.kb : g.rb; asm volatile("" : "+s"(KB_)); const int nt = KB_ / (2 * BK);
    unsigned voffA[2], voffB[2];
#pragma unroll
    for (int i = 0; i < 2; ++i) { int R, C; stage_rc(tid * 16 + i * 8192, R, C); const int Rb = Epi::PERM ? ((R & ~31) + perm32(R & 31)) : R;
        voffA[i] = (unsigned)(R * RB + C * 2); voffB[i] = (unsigned)(Rb * RB + C * 2); }
    const size_t kstep = (size_t)(BK * 2);
    const size_t hstep = (size_t)HALF * RB;
    const size_t rstep = (size_t)RB;
    const unsigned ldsw = (unsigned)wid * 1024u;
    const int aoff = lds_byte(wr * 64 + fr, fq * 8), boff = lds_byte(wc * 32 + fr, fq * 8);
#define PG8_SA(b, h) (((b) * 2 + (h)) * HTB)
#define PG8_SB(b, h) ((4 + (b) * 2 + (h)) * HTB)
#define PG8_STAGE(bufoff, gbase, voff) do { _Pragma("unroll") for (int _i = 0; _i < 2; ++_i) \
        __builtin_amdgcn_global_load_lds((const unsigned*)((const char*)(gbase) + (voff)[_i]), (LAS unsigned*)(lds + (bufoff) + ldsw + _i * 8192), 16, 0, 0); } while (0)
#define PG8_LDA(dst, b, h) do { _Pragma("unroll") for (int m = 0; m < 4; ++m) _Pragma("unroll") for (int k = 0; k < 2; ++k) dst[m][k] = *(const LAS bf16x8*)(lds + PG8_SA(b, h) + aoff + m * 2048 + k * 1024); } while (0)
#define PG8_LDB(dst, b, h) do { _Pragma("unroll") for (int n = 0; n < 2; ++n) _Pragma("unroll") for (int k = 0; k < 2; ++k) dst[n][k] = *(const LAS bf16x8*)(lds + PG8_SB(b, h) + boff + n * 2048 + k * 1024); } while (0)
#define PG8_MMA(ai, bj, At, Bt) do { __builtin_amdgcn_s_setprio(1); _Pragma("unroll") for (int m = 0; m < 4; ++m) _Pragma("unroll") for (int n = 0; n < 2; ++n) { \
        if constexpr (F8) { asm volatile("v_mfma_scale_f32_16x16x128_f8f6f4 %0, %1, %2, %0, %3, %3 op_sel_hi:[0,0,0]" : "+v"(acc[ai][bj][m][n]) : "v"(cat8(Bt[n][0], Bt[n][1])), "v"(cat8(At[m][0], At[m][1])), "v"(f8scale)); } \
        else { _Pragma("unroll") for (int k = 0; k < 2; ++k) acc[ai][bj][m][n] = __builtin_amdgcn_mfma_f32_16x16x32_bf16(Bt[n][k], At[m][k], acc[ai][bj][m][n], 0, 0, 0); } } __builtin_amdgcn_s_setprio(0); } while (0)
#define PG8_WAIT_V(n) asm volatile("s_waitcnt vmcnt(" #n ")" ::: "memory")
#define PG8_WAIT_L(n) asm volatile("s_waitcnt lgkmcnt(" #n ")" ::: "memory")
#define PG8_BAR __builtin_amdgcn_s_barrier()
#define PG8_SCHED __builtin_amdgcn_sched_barrier(0)
    Unit cur, nxt; int ui = 0;
    if (!S.next(0, cur)) return;
    f32x4 acc[2][2][4][2];
#pragma unroll
    for (int a = 0; a < 2; ++a)
#pragma unroll
        for (int b = 0; b < 2; ++b)
#pragma unroll
            for (int m = 0; m < 4; ++m)
#pragma unroll
                for (int n = 0; n < 2; ++n) acc[a][b][m][n] = (f32x4){0.f, 0.f, 0.f, 0.f};
    bf16x8 At[4][2], B0[2][2], B1[2][2];
    int f8scale = 0x7f7f7f7f; asm volatile("" : "+v"(f8scale));
    const char* cA = (const char*)g.A + (size_t)cur.arow * rstep; const char* cB = (const char*)g.Bt + (size_t)cur.brow * rstep;
    if constexpr (SP2) {
        PG8_STAGE(PG8_SB(0, 0), cB, voffB); PG8_STAGE(PG8_SB(0, 1), cB + hstep, voffB); PG8_STAGE(PG8_SA(0, 0), cA, voffA); PG8_STAGE(PG8_SA(0, 1), cA + hstep, voffA);
        if (wr == 1) PG8_BAR;
        PG8_WAIT_V(2); PG8_BAR;
        PG8_STAGE(PG8_SB(1, 0), cB + kstep, voffB); PG8_STAGE(PG8_SA(1, 0), cA + kstep, voffA); PG8_STAGE(PG8_SB(1, 1), cB + hstep + kstep, voffB);
        PG8_WAIT_V(6); PG8_BAR;
    } else {
        PG8_STAGE(PG8_SB(0, 0), cB, voffB); PG8_STAGE(PG8_SA(0, 0), cA, voffA); PG8_STAGE(PG8_SB(0, 1), cB + hstep, voffB); PG8_STAGE(PG8_SA(0, 1), cA + hstep, voffA);
        if (wr == 1) PG8_BAR;
        PG8_WAIT_V(4); PG8_BAR;
        PG8_STAGE(PG8_SB(1, 0), cB + kstep, voffB); PG8_STAGE(PG8_SA(1, 0), cA + kstep, voffA); PG8_STAGE(PG8_SB(1, 1), cB + hstep + kstep, voffB);
        PG8_WAIT_V(6); PG8_BAR;
    }
    for (;;) {
        const bool has_next = S.next(ui + 1, nxt);
        const char* nA = has_next ? (const char*)g.A + (size_t)nxt.arow * rstep : cA; const char* nB = has_next ? (const char*)g.Bt + (size_t)nxt.brow * rstep : cB;
        for (int t = 0; t < nt; t += 2) {
            const bool last = (t == nt - 2);
            const char* a1 = cA + (size_t)(t + 1) * kstep;
            const char* a2 = last ? nA : cA + (size_t)(t + 2) * kstep; const char* b2 = last ? nB : cB + (size_t)(t + 2) * kstep;
            const char* a3 = a2 + kstep; const char* b3 = b2 + kstep;
            if constexpr (SP2) {
            PG8_LDB(B0, 0, 0); PG8_LDB(B1, 0, 1); PG8_SCHED; PG8_LDA(At, 0, 0); PG8_STAGE(PG8_SA(1, 1), a1 + hstep, voffA);
            PG8_WAIT_V(8); PG8_WAIT_L(0); PG8_BAR; PG8_MMA(0, 0, At, B0); PG8_MMA(0, 1, At, B1); PG8_BAR; PG8_SCHED;
            PG8_LDA(At, 0, 1); PG8_STAGE(PG8_SB(0, 0), b2, voffB); PG8_STAGE(PG8_SB(0, 1), b2 + hstep, voffB); PG8_STAGE(PG8_SA(0, 0), a2, voffA);
            PG8_WAIT_V(8); PG8_WAIT_L(0); PG8_BAR; PG8_MMA(1, 0, At, B0); PG8_MMA(1, 1, At, B1); PG8_BAR; PG8_SCHED;
            PG8_LDB(B0, 1, 0); PG8_LDB(B1, 1, 1); PG8_SCHED; PG8_LDA(At, 1, 0); PG8_STAGE(PG8_SA(0, 1), a2 + hstep, voffA);
            PG8_WAIT_V(8); PG8_WAIT_L(0); PG8_BAR; PG8_MMA(0, 0, At, B0); PG8_MMA(0, 1, At, B1); PG8_BAR; PG8_SCHED;
            PG8_LDA(At, 1, 1); PG8_STAGE(PG8_SB(1, 0), b3, voffB); PG8_STAGE(PG8_SB(1, 1), b3 + hstep, voffB); PG8_STAGE(PG8_SA(1, 0), a3, voffA);
            PG8_WAIT_V(8); PG8_WAIT_L(0); PG8_BAR; PG8_MMA(1, 0, At, B0); PG8_MMA(1, 1, At, B1); PG8_BAR; PG8_SCHED;
            } else {
            PG8_LDB(B0, 0, 0); PG8_SCHED; PG8_LDA(At, 0, 0); PG8_STAGE(PG8_SA(1, 1), a1 + hstep, voffA);
            PG8_WAIT_L(8); PG8_BAR; PG8_WAIT_L(0); PG8_MMA(0, 0, At, B0); PG8_BAR; PG8_SCHED;
            PG8_LDB(B1, 0, 1); PG8_STAGE(PG8_SB(0, 0), b2, voffB);
            PG8_BAR; PG8_WAIT_L(0); PG8_MMA(0, 1, At, B1); PG8_BAR;
            PG8_LDA(At, 0, 1); PG8_STAGE(PG8_SA(0, 0), a2, voffA);
            PG8_BAR; PG8_WAIT_L(0); PG8_MMA(1, 0, At, B0); PG8_BAR; PG8_SCHED;
            PG8_STAGE(PG8_SB(0, 1), b2 + hstep, voffB);
            PG8_WAIT_V(6); PG8_BAR; PG8_MMA(1, 1, At, B1); PG8_BAR;
            PG8_LDB(B0, 1, 0); PG8_SCHED; PG8_LDA(At, 1, 0); PG8_STAGE(PG8_SA(0, 1), a2 + hstep, voffA);
            PG8_WAIT_L(8); PG8_BAR; PG8_WAIT_L(0); PG8_MMA(0, 0, At, B0); PG8_BAR; PG8_SCHED;
            PG8_LDB(B1, 1, 1); PG8_STAGE(PG8_SB(1, 0), b3, voffB);
            PG8_BAR; PG8_WAIT_L(0); PG8_MMA(0, 1, At, B1); PG8_BAR;
            PG8_LDA(At, 1, 1); PG8_STAGE(PG8_SA(1, 0), a3, voffA);
            PG8_BAR; PG8_WAIT_L(0); PG8_MMA(1, 0, At, B0); PG8_BAR; PG8_SCHED;
            PG8_STAGE(PG8_SB(1, 1), b3 + hstep, voffB);
            PG8_WAIT_V(6); PG8_BAR; PG8_MMA(1, 1, At, B1); PG8_BAR;
            }
        }
        if constexpr (F8) { asm volatile("s_nop 15\n\ts_nop 15" ::: "memory"); }
        else { asm volatile("s_nop 15\n\ts_nop 15" : "+v"(acc[1][1][3][1]) :: "memory"); }
        if constexpr (ALIGN_EPI) { if (wr == 0) PG8_BAR; }
        E(acc, cur, wr, wc, fr, fq);
        if (!has_next) break;
#pragma unroll
        for (int a = 0; a < 2; ++a)
#pragma unroll
            for (int b = 0; b < 2; ++b)
#pragma unroll
                for (int m = 0; m < 4; ++m)
#pragma unroll
                    for (int n = 0; n < 2; ++n) acc[a][b][m][n] = (f32x4){0.f, 0.f, 0.f, 0.f};
        cur = nxt; cA = nA; cB = nB; ++ui;
        if constexpr (ALIGN_EPI) { if (wr == 1) PG8_BAR; }
    }
    PG8_WAIT_V(0);
    if constexpr (!ALIGN_EPI) { if (wr == 0) PG8_BAR; }
    PG8_BAR;
#undef PG8_SA
#undef PG8_SB
#undef PG8_STAGE
#undef PG8_LDA
#undef PG8_LDB
#undef PG8_MMA
#undef PG8_WAIT_V
#undef PG8_WAIT_L
#undef PG8_BAR
#undef PG8_SCHED
}
}

namespace att {
constexpr int D = 128, NW = 8, QBLK = 32, KVBLK = 64;
constexpr float SCALE = 0.088388347648318440f;
constexpr float THR = 8.f;
constexpr float LOG2E = 1.4426950408889634f;
constexpr size_t SHM_V = KVBLK * D * 2, SHM_K = KVBLK * D * 2, SHM_ATTN = 2 * SHM_V + 2 * SHM_K + NW * 64 * 4;
#define KSWZ(row, colB) ((row) * 256 + ((colB) ^ (((row) & 7) << 4)))
#define SBAR() __builtin_amdgcn_sched_barrier(0)
__device__ __forceinline__ int crow(int r, int hi) { return (r & 3) + 8 * (r >> 2) + 4 * hi; }
__device__ __forceinline__ unsigned cvtpk(float lo, float hi) { unsigned r; asm volatile("v_cvt_pk_bf16_f32 %0, %1, %2" : "=v"(r) : "v"(lo), "v"(hi)); return r; }

struct NaInfo { const LAS float* rpb; int qrow, rs, c, cs, rlo; };

__device__ __forceinline__ void partialSM(f32x16& p0, f32x16& p1, float& m_reg, float& mn, float& alpha) {
  constexpr float C = SCALE * LOG2E;
  float pmax = p0[0];
#pragma unroll
  for (int r = 1; r < 16; ++r) pmax = fmaxf(pmax, p0[r]);
#pragma unroll
  for (int r = 0; r < 16; ++r) pmax = fmaxf(pmax, p1[r]);
  { auto rr = __builtin_amdgcn_permlane32_swap(__float_as_uint(pmax), __float_as_uint(pmax), false, false);
    pmax = fmaxf(__uint_as_float(rr[0]), __uint_as_float(rr[1])); }
  if (__builtin_expect(__all(pmax - m_reg <= THR / SCALE), 1)) { mn = m_reg; alpha = 1.f; }
  else { mn = fmaxf(m_reg, pmax); alpha = __builtin_amdgcn_exp2f((m_reg - mn) * C); m_reg = mn; }
  float mnC = -mn * C;
#pragma unroll
  for (int r = 0; r < 16; ++r) p0[r] = fmaf(p0[r], C, mnC);
#pragma unroll
  for (int r = 0; r < 16; ++r) p1[r] = fmaf(p1[r], C, mnC);
#pragma unroll
  for (int r = 0; r < 16; ++r) p0[r] = __builtin_amdgcn_exp2f(p0[r]);
}
__device__ __forceinline__ void partialSM_na(f32x16& p0, f32x16& p1, float& m_reg, float& mn, float& alpha, int tile, const NaInfo& na, int hi) {
  constexpr float C = SCALE * LOG2E;
  if (tile < 4) {
#pragma unroll
    for (int r = 0; r < 16; ++r) { p0[r] *= C; p1[r] *= C; }
  } else {
    const int krow = na.rlo + tile - 4;
    const bool rowvalid = (krow >= na.rs) && (krow < na.rs + 8);
    if (rowvalid) {
      const int dr = krow - na.qrow + 7;
      const LAS float* bp = na.rpb + dr * 31 + (15 - na.c + 4 * hi);
      const int kc0 = 4 * hi;
#pragma unroll
      for (int r = 0; r < 16; ++r) { const int ko = (r & 3) + 8 * (r >> 2);
        const int kcA = kc0 + ko, kcB = kcA + 32;
        const float bA = bp[ko], bB = bp[ko + 32];
        const bool vA = (kcA >= na.cs) && (kcA < na.cs + 16), vB = (kcB >= na.cs) && (kcB < na.cs + 16);
        p0[r] = vA ? fmaf(p0[r], C, bA) : -1e30f; p1[r] = vB ? fmaf(p1[r], C, bB) : -1e30f; }
    } else {
#pragma unroll
      for (int r = 0; r < 16; ++r) { p0[r] = -1e30f; p1[r] = -1e30f; }
    }
  }
  float pmax = p0[0];
#pragma unroll
  for (int r = 1; r < 16; ++r) pmax = fmaxf(pmax, p0[r]);
#pragma unroll
  for (int r = 0; r < 16; ++r) pmax = fmaxf(pmax, p1[r]);
  { auto rr = __builtin_amdgcn_permlane32_swap(__float_as_uint(pmax), __float_as_uint(pmax), false, false);
    pmax = fmaxf(__uint_as_float(rr[0]), __uint_as_float(rr[1])); }
  if (__builtin_expect(__all(pmax - m_reg <= THR * LOG2E), 1)) { mn = m_reg; alpha = 1.f; }
  else { mn = fmaxf(m_reg, pmax); alpha = __builtin_amdgcn_exp2f(m_reg - mn); m_reg = mn; }
#pragma unroll
  for (int r = 0; r < 16; ++r) p0[r] = __builtin_amdgcn_exp2f(p0[r] - mn);
#pragma unroll
  for (int r = 0; r < 16; ++r) p1[r] = p1[r] - mn;
}
__device__ __forceinline__ void finishSM(f32x16& p0, f32x16& p1, float alpha, float& l_reg, bf16x8& pa0, bf16x8& pa1, bf16x8& pa2, bf16x8& pa3) {
#pragma unroll
  for (int r = 0; r < 16; ++r) p1[r] = __builtin_amdgcn_exp2f(p1[r]);
  float ps = 0;
#pragma unroll
  for (int r = 0; r < 16; ++r) ps += p0[r];
#pragma unroll
  for (int r = 0; r < 16; ++r) ps += p1[r];
  { auto rr = __builtin_amdgcn_permlane32_swap(__float_as_uint(ps), __float_as_uint(ps), false, false);
    ps = __uint_as_float(rr[0]) + __uint_as_float(rr[1]); }
  l_reg = l_reg * alpha + ps;
#define PK4(P, BASE, OUT) do { unsigned a0 = cvtpk(P[BASE + 0], P[BASE + 1]), a1 = cvtpk(P[BASE + 2], P[BASE + 3]);   \
    unsigned b0 = cvtpk(P[BASE + 4], P[BASE + 5]), b1 = cvtpk(P[BASE + 6], P[BASE + 7]);                              \
    auto r0 = __builtin_amdgcn_permlane32_swap(a0, b0, false, false); auto r1 = __builtin_amdgcn_permlane32_swap(a1, b1, false, false); \
    u32x4 w = {r0[0], r1[0], r0[1], r1[1]}; OUT = *reinterpret_cast<bf16x8*>(&w); } while (0)
  PK4(p0, 0, pa0); PK4(p0, 8, pa1); PK4(p1, 0, pa2); PK4(p1, 8, pa3);
#undef PK4
}
__device__ __forceinline__ void qkt(f32x16& p0, f32x16& p1, const bf16_t* Ks, const bf16x8* qr, int r32, int hi) {
  p0 = f32x16{}; p1 = f32x16{};
#pragma unroll
  for (int d0 = 0; d0 < 8; ++d0) { int cb = (d0 * 16 + hi * 8) * 2;
    bf16x8 b0 = *reinterpret_cast<const bf16x8*>((const char*)Ks + KSWZ(r32, cb));
    bf16x8 b1 = *reinterpret_cast<const bf16x8*>((const char*)Ks + KSWZ(32 + r32, cb));
    p0 = __builtin_amdgcn_mfma_f32_32x32x16_bf16(b0, qr[d0], p0, 0, 0, 0);
    p1 = __builtin_amdgcn_mfma_f32_32x32x16_bf16(b1, qr[d0], p1, 0, 0, 0); }
}
__device__ __forceinline__ int v_st(int k, int c) { const int kk = (k & ~0xC) | ((k & 4) << 1) | ((k & 8) >> 1); return ((kk >> 3) * 4 + (c >> 5)) * 512 + ((kk & 7) * 32 + (c & 31)) * 2; }
__device__ __forceinline__ int v_rd_base(int lane) { return ((lane & 3) << 3) | (((lane >> 2) & 3) << 6) | (((lane >> 4) & 1) << 5) | (((lane >> 5) & 1) << 8); }
constexpr int v_rd_off(int d0, int ks, int half) { return d0 * 512 + ks * 4096 + half * 2048; }
template <int OFF> __device__ __forceinline__ s16x4 tr_read(int vb) {
  s16x4 r; asm volatile("ds_read_b64_tr_b16 %0, %1 offset:%2" : "=&v"(r) : "v"(vb), "i"(OFF) : "memory"); return r;
}
template <int D0> __device__ __forceinline__ void pv_one(f32x16& od, int vb, bf16x8 pa0, bf16x8 pa1, bf16x8 pa2, bf16x8 pa3) {
  const s16x4 l0 = tr_read<v_rd_off(D0, 0, 0)>(vb), h0 = tr_read<v_rd_off(D0, 0, 1)>(vb), l1 = tr_read<v_rd_off(D0, 1, 0)>(vb), h1 = tr_read<v_rd_off(D0, 1, 1)>(vb);
  const s16x4 l2 = tr_read<v_rd_off(D0, 2, 0)>(vb), h2 = tr_read<v_rd_off(D0, 2, 1)>(vb), l3 = tr_read<v_rd_off(D0, 3, 0)>(vb), h3 = tr_read<v_rd_off(D0, 3, 1)>(vb);
  asm volatile("s_waitcnt lgkmcnt(0)" ::: "memory"); SBAR();
#define PK(L, H) (bf16x8){L[0], L[1], L[2], L[3], H[0], H[1], H[2], H[3]}
  od = __builtin_amdgcn_mfma_f32_32x32x16_bf16(pa0, PK(l0, h0), od, 0, 0, 0);
  od = __builtin_amdgcn_mfma_f32_32x32x16_bf16(pa1, PK(l1, h1), od, 0, 0, 0);
  od = __builtin_amdgcn_mfma_f32_32x32x16_bf16(pa2, PK(l2, h2), od, 0, 0, 0);
  od = __builtin_amdgcn_mfma_f32_32x32x16_bf16(pa3, PK(l3, h3), od, 0, 0, 0);
#undef PK
}
__device__ __forceinline__ void pv_d0(f32x16* o, int vb, bf16x8 pa0, bf16x8 pa1, bf16x8 pa2, bf16x8 pa3) {
  pv_one<0>(o[0], vb, pa0, pa1, pa2, pa3); pv_one<1>(o[1], vb, pa0, pa1, pa2, pa3); pv_one<2>(o[2], vb, pa0, pa1, pa2, pa3); pv_one<3>(o[3], vb, pa0, pa1, pa2, pa3);
}

template <int LDQ, int LDO, bool NA, int SDEPTH>
__device__ __forceinline__ void attn_body(const bf16_t* __restrict__ Qb, const bf16_t* __restrict__ Kh, const bf16_t* __restrict__ Vh, bf16_t* __restrict__ Ob, int NT, const int LDK, char* lds, const NaInfo& na) {
  int tid = threadIdx.x; asm volatile("" : "+v"(tid));
  const int wid = tid >> 6, lane = tid & 63, r32 = lane & 31, hi = lane >> 5;
  bf16_t* V_lds = (bf16_t*)lds; bf16_t* K_lds = (bf16_t*)(lds + 2 * SHM_V);
  float* ws = (float*)(lds + 2 * SHM_V + 2 * SHM_K) + wid * 64; float* li_l = ws; float* al_l = ws + 32;
  float m_reg = -1e30f, l_reg = 0; f32x16 o[4] = {}; bf16x8 qr[8];
  const bf16_t* Qw = Qb + (long)(wid * QBLK + r32) * LDQ + hi * 8;
#pragma unroll
  for (int d0 = 0; d0 < 8; ++d0) qr[d0] = *reinterpret_cast<const bf16x8*>(Qw + d0 * 16);
  const int sr = tid >> 4, sc = (tid & 15) * 8, vst0 = v_st(sr, sc), vst1 = v_st(32 + sr, sc);
  const int vb0 = (int)(uintptr_t)V_lds + v_rd_base(lane);
  const int koff = NA ? na.rlo * 64 : 0;
  struct { bf16x8 vs0, vs1, ks0, ks1; } sr_[SDEPTH];
#define KROW(t) ((t) * KVBLK + ((NA && (t) >= 4) ? koff : 0))
#define SLOAD(i, t) do { const long _k0 = KROW(t); sr_[i].vs0 = *reinterpret_cast<const bf16x8*>(&Vh[(_k0 + sr) * LDK + sc]); sr_[i].vs1 = *reinterpret_cast<const bf16x8*>(&Vh[(_k0 + 32 + sr) * LDK + sc]); \
    sr_[i].ks0 = *reinterpret_cast<const bf16x8*>(&Kh[(_k0 + sr) * LDK + sc]); sr_[i].ks1 = *reinterpret_cast<const bf16x8*>(&Kh[(_k0 + 32 + sr) * LDK + sc]); } while (0)
#define SWRITE(b, i) do { *(bf16x8*)((char*)V_lds + (b) * SHM_V + vst0) = sr_[i].vs0;          \
    *(bf16x8*)((char*)V_lds + (b) * SHM_V + vst1) = sr_[i].vs1; int kc = sc * 2;               \
    *(bf16x8*)((char*)K_lds + (b) * SHM_K + KSWZ(sr, kc)) = sr_[i].ks0;                       \
    *(bf16x8*)((char*)K_lds + (b) * SHM_K + KSWZ(32 + sr, kc)) = sr_[i].ks1; } while (0)
#define SWAIT() do { if constexpr (SDEPTH == 2) asm volatile("s_waitcnt vmcnt(4)" ::: "memory"); else asm volatile("s_waitcnt vmcnt(0)" ::: "memory"); } while (0)
#define RESC(a) do { if (__any((a) < 1.f)) { if (hi == 0) al_l[r32] = (a); asm volatile("s_waitcnt lgkmcnt(0)" ::: "memory"); \
    _Pragma("unroll") for (int d = 0; d < 4; ++d) _Pragma("unroll") for (int r = 0; r < 16; ++r) o[d][r] *= al_l[crow(r, hi)]; } } while (0)
#define PSM(P0, P1, MN, AL, T) do { if constexpr (NA) partialSM_na(P0, P1, m_reg, MN, AL, (T), na, hi); else partialSM(P0, P1, m_reg, MN, AL); } while (0)
  f32x16 pA0, pA1, pB0, pB1; float mnA, mnB, alA, alB; bf16x8 pa0, pa1, pa2, pa3;
  constexpr int SE = 0, SO = SDEPTH - 1;
  asm volatile("" : "+s"(NT));
  SLOAD(SE, 0); asm volatile("s_waitcnt vmcnt(0)" ::: "memory"); SWRITE(0, SE); __syncthreads();
  qkt(pA0, pA1, K_lds, qr, r32, hi); PSM(pA0, pA1, mnA, alA, 0);
  SLOAD(SO, 1); if constexpr (SDEPTH == 2) { if (2 < NT) SLOAD(SE, 2); }
  SWAIT(); SWRITE(1, SO); __syncthreads();
  for (int j = 1; j + 1 < NT; j += 2) {
    SBAR(); qkt(pB0, pB1, (bf16_t*)((char*)K_lds + SHM_K), qr, r32, hi);
    finishSM(pA0, pA1, alA, l_reg, pa0, pa1, pa2, pa3); SBAR();
    SLOAD(SO, j + SDEPTH); SBAR();
    pv_d0(o, vb0, pa0, pa1, pa2, pa3); PSM(pB0, pB1, mnB, alB, j);
    __syncthreads(); SWAIT(); SWRITE(0, SE);
    RESC(alB); __syncthreads();
    SBAR(); qkt(pA0, pA1, K_lds, qr, r32, hi);
    finishSM(pB0, pB1, alB, l_reg, pa0, pa1, pa2, pa3); SBAR();
    if (SDEPTH == 1 || j + 3 < NT) SLOAD(SE, j + 1 + SDEPTH); SBAR();
    pv_d0(o, vb0 + (int)SHM_V, pa0, pa1, pa2, pa3); PSM(pA0, pA1, mnA, alA, j + 1);
    __syncthreads(); SWAIT(); SWRITE(1, SO);
    RESC(alA); __syncthreads();
  }
  SBAR(); qkt(pB0, pB1, (bf16_t*)((char*)K_lds + SHM_K), qr, r32, hi);
  finishSM(pA0, pA1, alA, l_reg, pa0, pa1, pa2, pa3); SBAR();
  pv_d0(o, vb0, pa0, pa1, pa2, pa3); PSM(pB0, pB1, mnB, alB, NT - 1);
  __syncthreads(); RESC(alB);
  finishSM(pB0, pB1, alB, l_reg, pa0, pa1, pa2, pa3); SBAR();
  pv_d0(o, vb0 + (int)SHM_V, pa0, pa1, pa2, pa3);
  if (hi == 0) li_l[r32] = l_reg; asm volatile("s_waitcnt lgkmcnt(0)" ::: "memory");
  float rli[16];
#pragma unroll
  for (int r = 0; r < 16; ++r) rli[r] = __builtin_amdgcn_rcpf(li_l[crow(r, hi)]);
  bf16_t* Ow = Ob + (long)(wid * QBLK) * LDO;
#pragma unroll
  for (int r = 0; r < 16; ++r) { int orow = crow(r, hi);
#pragma unroll
    for (int d0 = 0; d0 < 4; ++d0) { const float v = o[d0][r] * rli[r]; Ow[(long)orow * LDO + d0 * 32 + r32] = (bf16_t)(cvtpk(v, v) & 0xffffu); } }
  __syncthreads();
#undef KROW
#undef SLOAD
#undef SWRITE
#undef SWAIT
#undef RESC
#undef PSM
}
#undef KSWZ
}

template <class T> __device__ __forceinline__ T* uni_ptr(T* p) { const unsigned long long v = (unsigned long long)p; const unsigned lo = __builtin_amdgcn_readfirstlane((unsigned)v), hi = __builtin_amdgcn_readfirstlane((unsigned)(v >> 32)); return (T*)(GAS T*)(((unsigned long long)hi << 32) | lo); }
__device__ __forceinline__ void attn_dense_call(const bf16_t* q, const bf16_t* k, const bf16_t* v, bf16_t* o, int nt, int ldk) {
    extern __shared__ __attribute__((aligned(16))) unsigned char lds_raw_[];
    q = uni_ptr(q); k = uni_ptr(k); v = uni_ptr(v); o = uni_ptr(o); nt = __builtin_amdgcn_readfirstlane(nt); ldk = __builtin_amdgcn_readfirstlane(ldk);
    att::NaInfo na0; na0.rpb = (const LAS float*)(LAS unsigned char*)lds_raw_; na0.qrow = 0; na0.rs = 0; na0.c = 0; na0.cs = 0; na0.rlo = 0;
    att::attn_body<512, DM, false, 2>(q, k, v, o, nt, ldk, (char*)lds_raw_, na0);
}
__device__ __forceinline__ void attn_na_call(const bf16_t* q, const bf16_t* k, const bf16_t* v, bf16_t* o, int nt, int r0, int rlo) {
    extern __shared__ __attribute__((aligned(16))) unsigned char lds_raw_[];
    q = uni_ptr(q); k = uni_ptr(k); v = uni_ptr(v); o = uni_ptr(o); nt = __builtin_amdgcn_readfirstlane(nt); r0 = __builtin_amdgcn_readfirstlane(r0); rlo = __builtin_amdgcn_readfirstlane(rlo);
    int tidn = threadIdx.x; asm volatile("" : "+v"(tidn)); const int wave = tidn >> 6, lane = tidn & 63;
    att::NaInfo na; na.rpb = (const LAS float*)((LAS unsigned char*)lds_raw_ + RPB_OFF); na.qrow = r0 + (wave >> 1); na.rs = min(max(na.qrow - 4, 0), 56); na.c = (wave & 1) * 32 + (lane & 31); na.cs = min(max(na.c - 8, 0), 48); na.rlo = rlo;
    att::attn_body<512, DM, true, 1>(q, k, v, o, nt, 512, (char*)lds_raw_, na);
}

__device__ __forceinline__ void cdft_to_slab(LAS unsigned char* lds, const bf16_t* __restrict__ Pv, size_t vstride, const bf16_t* __restrict__ MBl, int mpitch) {
  int tid = threadIdx.x; asm volatile("" : "+v"(tid));
  const int wid = tid >> 6, lane = tid & 63, r32 = lane & 31, hi = lane >> 5, h = wid >> 1, cs = wid & 1;
  const bf16_t* ap = Pv + (size_t)r32 * vstride + h * 128 + hi * 8;
  const bf16_t* bp = MBl + (size_t)(h * 256 + cs * 128 + r32) * mpitch + hi * 8;
  LAS bf16_t* sl = (LAS bf16_t*)lds + (64 * cs) * 512 + h * 128 + r32;
  bf16x8 a[2][8];
#pragma unroll
  for (int i = 0; i < 2; ++i)
#pragma unroll
    for (int k = 0; k < 8; ++k) a[i][k] = *reinterpret_cast<const bf16x8*>(ap + (size_t)(32 * i) * vstride + 16 * k);
#pragma unroll 1
  for (int i = 0; i < 2; ++i) {
    f32x16 acc[4];
#pragma unroll
    for (int j = 0; j < 4; ++j) { acc[j] = f32x16{}; asm volatile("" : "+v"(acc[j])); }
#pragma unroll
    for (int k = 0; k < 8; ++k) {
      bf16x8 bq[4];
#pragma unroll
      for (int j = 0; j < 4; ++j) bq[j] = *reinterpret_cast<const bf16x8*>(bp + (size_t)(32 * j) * mpitch + 16 * k);
      const bf16x8 av = i ? a[1][k] : a[0][k];
#pragma unroll
      for (int j = 0; j < 4; ++j) acc[j] = __builtin_amdgcn_mfma_f32_32x32x16_bf16(av, bq[j], acc[j], 0, 0, 0);
    }
#pragma unroll
    for (int j = 0; j < 4; ++j) asm volatile("s_nop 15\n\ts_nop 15" : "+v"(acc[j]));
#pragma unroll
    for (int r = 0; r < 16; ++r) { const int row = 32 * i + att::crow(r, hi);
#pragma unroll
      for (int j = 0; j < 4; ++j) { const float v = acc[j][r]; sl[row * 512 + 32 * j] = (bf16_t)(cvt_pk_bf16(v, v) & 0xffffu); } }
  }
}
template <int NPASS, bool STAGE = true, class RowPtr, class Epi>
__device__ __forceinline__ void fft_stage(LAS unsigned char* lds, const bf16_t* __restrict__ Mmat, const RowPtr& rowp, const Epi& epi) {
  int tid = threadIdx.x; asm volatile("" : "+v"(tid));
  const int wid = tid >> 6, lane = tid & 63, r32 = lane & 31, hi = lane >> 5;
  if constexpr (STAGE) {
    const int sr = tid >> 6, sc = (tid & 63) * 8;
    bf16x8 st[16];
#pragma unroll
    for (int i = 0; i < 16; ++i) st[i] = *reinterpret_cast<const bf16x8*>(rowp(sr + 8 * i) + sc);
#pragma unroll
    for (int i = 0; i < 16; ++i) *(LAS bf16x8*)(lds + ((sr + 8 * i) * 512 + sc) * 2) = st[i];
  }
  __syncthreads();
  const LAS bf16_t* tb = (const LAS bf16_t*)lds + (8 * hi) * 512 + 64 * wid + r32;
  const bf16_t* Ml = Mmat + r32 * 128 + hi * 8;
#pragma unroll
  for (int p = 0; p < NPASS; ++p) {
    f32x16 acc[2][2];
#pragma unroll
    for (int j = 0; j < 2; ++j) { acc[j][0] = f32x16{}; acc[j][1] = f32x16{}; asm volatile("" : "+v"(acc[j][0]), "+v"(acc[j][1])); }
#pragma unroll 2
    for (int k = 0; k < 8; ++k) {
      bf16x8 b0, b1;
#pragma unroll
      for (int j = 0; j < 8; ++j) { b0[j] = (short)tb[(16 * k + j) * 512]; b1[j] = (short)tb[(16 * k + j) * 512 + 32]; }
      const bf16x8 a0 = *reinterpret_cast<const bf16x8*>(Ml + p * 32 * 128 + k * 16), a1 = *reinterpret_cast<const bf16x8*>(Ml + (p + NPASS) * 32 * 128 + k * 16);
      acc[0][0] = __builtin_amdgcn_mfma_f32_32x32x16_bf16(a0, b0, acc[0][0], 0, 0, 0); acc[0][1] = __builtin_amdgcn_mfma_f32_32x32x16_bf16(a0, b1, acc[0][1], 0, 0, 0);
      acc[1][0] = __builtin_amdgcn_mfma_f32_32x32x16_bf16(a1, b0, acc[1][0], 0, 0, 0); acc[1][1] = __builtin_amdgcn_mfma_f32_32x32x16_bf16(a1, b1, acc[1][1], 0, 0, 0);
    }
#pragma unroll
    for (int j = 0; j < 2; ++j) asm volatile("s_nop 15\n\ts_nop 15" : "+v"(acc[j][0]), "+v"(acc[j][1]));
    epi(p, acc, wid, r32, hi);
  }
  __syncthreads();
}

#define XB_TMO      128
#define XB_XCNT(j)  (256  + 64 * (j))
#define XB_XSUB(j)  (1280 + 64 * (j))
#define XB_XGEN(j)  (2304 + 64 * (j))
#define XB_TOP      3328
#define XB_TOPGEN   3392
#define XCD_BAR_WORDS 3456
#define XB_SPIN_CAP (1u << 18)
__device__ __forceinline__ unsigned xb_ld(unsigned* p)              { return __hip_atomic_load(p, __ATOMIC_RELAXED, __HIP_MEMORY_SCOPE_AGENT); }
__device__ __forceinline__ unsigned xb_add(unsigned* p, unsigned v) { return __hip_atomic_fetch_add(p, v, __ATOMIC_RELAXED, __HIP_MEMORY_SCOPE_AGENT); }
__device__ __forceinline__ unsigned xb_xcc_id() { return (unsigned)__builtin_amdgcn_s_getreg((3 << 11) | 20) & 0xFu; }
#define XB_SPIN(cond, bar) do { unsigned _sp = 0; while (cond) { __builtin_amdgcn_s_sleep(1); \
    if ((++_sp & 255u) == 0u) { if (xb_ld(&(bar)[XB_TMO])) break; if (_sp > XB_SPIN_CAP) { atomicAdd(&(bar)[XB_TMO], 1u); break; } } } } while (0)
struct XcdBarrier { unsigned* bar; unsigned x; volatile LAS unsigned* st; };
__device__ __forceinline__ XcdBarrier xcd_barrier_post(unsigned* bar, volatile LAS unsigned* st) {
    XcdBarrier b; b.bar = bar; b.x = xb_xcc_id(); b.st = st;
    if (threadIdx.x == 0) (void)xb_add(&bar[XB_XCNT(b.x)], 1u);
    return b;
}
__device__ __forceinline__ void xcd_barrier_complete(unsigned* bar, unsigned x, unsigned& nloc, unsigned& nx) {
    const unsigned G = gridDim.x * gridDim.y * gridDim.z;
    unsigned sum, cnt, mine, sp = 0u;
    for (;;) {
        sum = 0u; cnt = 0u; mine = 0u;
#pragma unroll 1
        for (unsigned j = 0; j < 16; ++j) { const unsigned c = xb_ld(&bar[XB_XCNT(j)]); sum += c; cnt += (c > 0u) ? 1u : 0u; mine = (j == x) ? c : mine; }
        if (sum == G) break;
        __builtin_amdgcn_s_sleep(1);
        if ((++sp & 255u) == 0u) { if (xb_ld(&bar[XB_TMO])) break; if (sp > XB_SPIN_CAP) { atomicAdd(&bar[XB_TMO], 1u); break; } }
    }
    nloc = mine > 0u ? mine : 1u; nx = cnt > 0u ? cnt : 1u;
}
__device__ __forceinline__ void xcd_barrier(const XcdBarrier& b) {
    asm volatile("s_waitcnt vmcnt(0)" ::: "memory");
    __syncthreads();
    if (threadIdx.x == 0) {
        unsigned* bar = b.bar;
        __builtin_amdgcn_s_waitcnt(0);
        unsigned nloc = b.st[0], nx = b.st[1];
        if (nloc == 0u) { xcd_barrier_complete(bar, b.x, nloc, nx); b.st[0] = nloc; b.st[1] = nx; }
        const unsigned old = xb_add(&bar[XB_XSUB(b.x)], 1u);
        const unsigned gen = old / nloc;
        if (old + 1u == (gen + 1u) * nloc) {
            __builtin_amdgcn_fence(__ATOMIC_RELEASE, "agent");
            asm volatile("s_waitcnt vmcnt(0)" ::: "memory");
            const unsigned og = xb_add(&bar[XB_TOP], 1u);
            const unsigned tg = og / nx;
            if (og + 1u == (tg + 1u) * nx) xb_add(&bar[XB_TOPGEN], 1u);
            else XB_SPIN(xb_ld(&bar[XB_TOPGEN]) == tg, bar);
            __builtin_amdgcn_fence(__ATOMIC_ACQUIRE, "agent");
            xb_add(&bar[XB_XGEN(b.x)], 1u);
            asm volatile("s_waitcnt vmcnt(0)" ::: "memory");
        } else {
            XB_SPIN(xb_ld(&bar[XB_XGEN(b.x)]) == gen, bar);
            __builtin_amdgcn_fence(__ATOMIC_ACQUIRE, "agent");
            asm volatile("s_waitcnt vmcnt(0)" ::: "memory");
        }
    }
    __syncthreads();
}

struct Args { const float* in[24]; float* out; unsigned char* ws; int ph_lo, ph_hi; };
enum { I_X = 0, I_C, I_CTX, I_CCTX, I_N1G, I_N2G, I_WADA, I_BADA, I_WIN, I_WOUT, I_WFOUR, I_CONVW, I_RPB, I_NAQG, I_NAKG, I_GQG, I_GKG, I_FW1, I_FW3, I_FW2, I_ROUTER, I_MW1, I_MW3, I_MW2 };

__device__ __forceinline__ void transpose_tile(const float* __restrict__ src, int ldw, bf16_t* __restrict__ dst, int ldb, LAS unsigned* scr) {
    const int tid = threadIdx.x;
    const int n4 = (tid & 31) * 4, kq = tid >> 5;
    f32x4 a[4], b[4];
#pragma unroll
    for (int i = 0; i < 4; ++i) { const int kp = kq + 16 * i; a[i] = *(const f32x4*)(src + (size_t)(2 * kp) * ldw + n4); b[i] = *(const f32x4*)(src + (size_t)(2 * kp + 1) * ldw + n4); }
#pragma unroll
    for (int i = 0; i < 4; ++i) { const int kp = kq + 16 * i;
#pragma unroll
        for (int j = 0; j < 4; ++j) scr[(n4 + j) * 65 + kp] = cvt_pk_bf16(a[i][j], b[i][j]); }
    __syncthreads();
    const int n = tid >> 2, q = tid & 3;
#pragma unroll
    for (int i = 0; i < 4; ++i) { u32x4 w; const LAS unsigned* s = scr + n * 65 + q * 16 + i * 4; w.x = s[0]; w.y = s[1]; w.z = s[2]; w.w = s[3];
        *(u32x4*)(dst + (size_t)n * ldb + (q * 16 + i * 4) * 2) = w; }
    __syncthreads();
}

struct T16Regs { f32x4 a[4], b[4]; };
__device__ __forceinline__ void t16_load(const float* __restrict__ src, int ldw, T16Regs& t) {
    const int tid = threadIdx.x; const int n4 = (tid & 31) * 4, kq = tid >> 5;
#pragma unroll
    for (int i = 0; i < 4; ++i) { const int kp = kq + 16 * i; t.a[i] = __builtin_nontemporal_load((const f32x4*)(src + (size_t)(2 * kp) * ldw + n4)); t.b[i] = __builtin_nontemporal_load((const f32x4*)(src + (size_t)(2 * kp + 1) * ldw + n4)); }
}
__device__ __forceinline__ void t16_store(const T16Regs& t, bf16_t* __restrict__ dst, int ldb, LAS unsigned* scr) {
    const int tid = threadIdx.x; const int n4 = (tid & 31) * 4, kq = tid >> 5;
#pragma unroll
    for (int i = 0; i < 4; ++i) { const int kp = kq + 16 * i;
#pragma unroll
        for (int j = 0; j < 4; ++j) scr[(n4 + j) * 65 + kp] = cvt_pk_bf16(t.a[i][j], t.b[i][j]); }
    asm volatile("s_waitcnt lgkmcnt(0)" ::: "memory"); __builtin_amdgcn_s_barrier(); asm volatile("" ::: "memory");
    const int n = tid >> 2, q = tid & 3;
#pragma unroll
    for (int i = 0; i < 4; ++i) { u32x4 w; const LAS unsigned* s = scr + n * 65 + q * 16 + i * 4; w.x = s[0]; w.y = s[1]; w.z = s[2]; w.w = s[3];
        *(u32x4*)(dst + (size_t)n * ldb + (q * 16 + i * 4) * 2) = w; }
    asm volatile("s_waitcnt lgkmcnt(0)" ::: "memory"); __builtin_amdgcn_s_barrier(); asm volatile("" ::: "memory");
}
struct T8Regs { f32x4 r[2][4]; };
__device__ __forceinline__ void t8_load(const float* __restrict__ src, int ldw, T8Regs& t, int tid = threadIdx.x) {
    const int n4 = (tid & 31) * 4, kq = tid >> 5;
#pragma unroll
    for (int i = 0; i < 2; ++i)
#pragma unroll
        for (int q = 0; q < 4; ++q) t.r[i][q] = __builtin_nontemporal_load((const f32x4*)(src + (size_t)(4 * (kq + 16 * i) + q) * ldw + n4));
}
__device__ __forceinline__ void t8_store(const T8Regs& t, unsigned char* __restrict__ dst, int ldb, LAS unsigned* scr, float sc, int tid = threadIdx.x) {
    const int n4 = (tid & 31) * 4, kq = tid >> 5;
#pragma unroll
    for (int i = 0; i < 2; ++i)
#pragma unroll
        for (int j = 0; j < 4; ++j) scr[(n4 + j) * 33 + kq + 16 * i] = pk4_fp8(t.r[i][0][j] * sc, t.r[i][1][j] * sc, t.r[i][2][j] * sc, t.r[i][3][j] * sc);
    asm volatile("s_waitcnt lgkmcnt(0)" ::: "memory"); __builtin_amdgcn_s_barrier(); asm volatile("" ::: "memory");
    const int n = tid >> 2, q = tid & 3;
#pragma unroll
    for (int i = 0; i < 2; ++i) { u32x4 w; const LAS unsigned* s = scr + n * 33 + q * 8 + i * 4; w.x = s[0]; w.y = s[1]; w.z = s[2]; w.w = s[3];
        *(u32x4*)(dst + (size_t)n * ldb + q * 32 + i * 16) = w; }
    asm volatile("s_waitcnt lgkmcnt(0)" ::: "memory"); __builtin_amdgcn_s_barrier(); asm volatile("" ::: "memory");
}

__device__ __forceinline__ const unsigned char* ldptr(volatile LAS unsigned long long* T, int i) {
    const unsigned long long v = T[i]; const unsigned lo = __builtin_amdgcn_readfirstlane((unsigned)v), hi = __builtin_amdgcn_readfirstlane((unsigned)(v >> 32));
    return (const unsigned char*)(const GAS unsigned char*)(((unsigned long long)hi << 32) | lo);
}
constexpr int NT_ME = 16 * 56, NT_MUP = 2 * 8 * NT_ME, NT_MDN = 8 * NT_ME, NT_M = NT_MUP + NT_MDN;
constexpr int CW_QUP = 8192 + 1024, CW_QDN = 8192 + 1088;
__device__ __forceinline__ void moe_tile_decode(int t, volatile LAS unsigned long long* PTRS, const float*& src, int& ldw, unsigned char*& dst, int& ldb) {
    unsigned char* wsb = (unsigned char*)ldptr(PTRS, 25);
    if (t < NT_MUP) { const int which = t / (8 * NT_ME), q2 = t % (8 * NT_ME), e = q2 / NT_ME, r = q2 % NT_ME, kb = r / 56, nb = r % 56;
        src = (const float*)ldptr(PTRS, which ? I_MW3 : I_MW1) + (size_t)e * DM * DFE + (size_t)(kb * 128) * DFE + nb * 128; ldw = DFE; dst = wsb + WS_MUP + (size_t)e * 2 * DFE * DM + (size_t)(nb * 256 + which * 128) * DM + kb * 128; ldb = DM; }
    else { const int q = t - NT_MUP, e = q / NT_ME, r = q % NT_ME, kb = r / 16, nb = r % 16;
        src = (const float*)ldptr(PTRS, I_MW2) + (size_t)e * DFE * DM + (size_t)(kb * 128) * DM + nb * 128; ldw = DM; dst = wsb + WS_MDN + (size_t)e * DM * DFE + (size_t)(nb * 128) * DFE + kb * 128; ldb = DFE; }
}
__device__ __forceinline__ void moe_convert(volatile LAS unsigned long long* PTRS, LAS unsigned* scr, int t, int tend, int step) {
    if (t >= tend) return;
    const int tlast = t + ((tend - 1 - t) / step) * step;
    int tid = threadIdx.x; asm volatile("" : "+v"(tid));
    T8Regs t0, t1, t2; const float* src = nullptr; int ldw = 0; unsigned char *d0 = nullptr, *d1 = nullptr, *d2 = nullptr; int b0 = 0, b1 = 0, b2 = 0;
    moe_tile_decode(t, PTRS, src, ldw, d0, b0); t8_load(src, ldw, t0, tid);
    moe_tile_decode(min(t + step, tlast), PTRS, src, ldw, d1, b1); t8_load(src, ldw, t1, tid);
#define MT8_STEP(TL, DL, BL, TS, DS, BS) { if (t >= tend) break; moe_tile_decode(min(t + 2 * step, tlast), PTRS, src, ldw, DL, BL); t8_load(src, ldw, TL, tid); t8_store(TS, DS, BS, scr, F8_SW, tid); t += step; }
    for (;;) {
        MT8_STEP(t2, d2, b2, t0, d0, b0)
        MT8_STEP(t0, d0, b0, t1, d1, b1)
        MT8_STEP(t1, d1, b1, t2, d2, b2)
    }
#undef MT8_STEP
    asm volatile("s_waitcnt vmcnt(0)" ::: "memory");
}
template <unsigned PM, unsigned MM>
__global__ void __launch_bounds__(512, 2) mk_fwd(Args args) {
    extern __shared__ __attribute__((aligned(16))) unsigned char lds_raw[];
    LAS unsigned char* lds = (LAS unsigned char*)lds_raw;
    volatile LAS unsigned* MISC = (volatile LAS unsigned*)(lds + MISC_OFF);
    const int tid = threadIdx.x, lane = tid & 63, wave = __builtin_amdgcn_readfirstlane(tid >> 6);
    const int G = gridDim.x, wg = blockIdx.x;
    const int NGW = G * 8;
    unsigned* ctl = (unsigned*)(args.ws + WS_CTL);
    if (tid < 64) MISC[tid] = 0u;
    __syncthreads();
    XcdBarrier bar; bar.bar = ctl + CW_BAR; bar.x = 0; bar.st = MISC;
    const bool one_launch = (args.ph_hi - args.ph_lo) > 1;
    if (one_launch) bar = xcd_barrier_post(ctl + CW_BAR, MISC);
    const int lo = args.ph_lo, hi = args.ph_hi;
#define IN(k) (lo <= (k) && (k) < hi)
#define SEAM(k) do { if (IN(k) && IN((k) + 1)) xcd_barrier(bar); } while (0)

    volatile LAS unsigned long long* PTRS = (volatile LAS unsigned long long*)(lds + MISC_OFF + 512);
    if (tid < 24) PTRS[tid] = (unsigned long long)args.in[tid];
    if (tid == 24) PTRS[24] = (unsigned long long)args.out;
    if (tid == 25) PTRS[25] = (unsigned long long)args.ws;
    __syncthreads();
#define PHASE_IDS() int tid = threadIdx.x; asm volatile("" : "+v"(tid)); const int lane = tid & 63, wave = __builtin_amdgcn_readfirstlane(tid >> 6), gw = wg * 8 + wave; (void)lane; (void)gw
#define MOE_GRAB(budget) do { __syncthreads(); if (threadIdx.x == 0) { int t_ = (int)atomicAdd(ctl + CW_QUP, (unsigned)(budget)); if (t_ >= NT_MUP) t_ = NT_MUP + (int)atomicAdd(ctl + CW_QDN, (unsigned)(budget)); MISC[40] = (unsigned)t_; } __syncthreads(); \
    const int t0_ = __builtin_amdgcn_readfirstlane((int)MISC[40]); const int te_ = min(t0_ + (budget), t0_ < NT_MUP ? NT_MUP : NT_M); moe_convert(PTRS, (LAS unsigned*)lds, t0_, te_, 1); } while (0)
#define MOE_DRAIN(cw, base, count) do { __syncthreads(); if (threadIdx.x == 0) MISC[40] = __hip_atomic_load(ctl + (cw), RLX_AGENT); __syncthreads(); \
    const int s0_ = min(__builtin_amdgcn_readfirstlane((int)MISC[40]), (count)); moe_convert(PTRS, (LAS unsigned*)lds, (base) + s0_ + wg, (base) + (count), G); } while (0)
#define DEFICIT(nwg_) ((((nwg_) + G - 1) / G) - (wg < (nwg_) ? ((nwg_) - wg + G - 1) / G : 0))
#define INP(i) ((const float*)ldptr(PTRS, (i)))
#define OUTP() ((float*)ldptr(PTRS, 24))
#define WSB() ((unsigned char*)ldptr(PTRS, 25))

    DUP(10) if (EN(10) && IN(0)) {
            PHASE_IDS();
        constexpr int TR_WIN = 16 * 36, TR_WOUT = 16 * 16, TR_F13 = 16 * 44, TR_F2 = 44 * 16, TR_M13 = 16 * 56, TR_M2 = 56 * 16;
        constexpr int O_WIN = 0, O_WOUT = O_WIN + 2 * TR_WIN, O_F1 = O_WOUT + 2 * TR_WOUT, O_F3 = O_F1 + TR_F13, O_F2 = O_F3 + TR_F13, O_M1 = O_F2 + TR_F2, O_M3 = O_M1 + 8 * TR_M13, O_M2 = O_M3 + 8 * TR_M13, NTR = O_M2 + 8 * TR_M2;
        constexpr int O_T = NTR, N_T = 4096 / 8, O_TC = O_T + N_T, N_TC = 256 / 8, O_FOLD = O_TC + N_TC, N_FOLD = 2 * 4 * 2 * 32, O_MOD = O_FOLD + N_FOLD, N_MOD = 2 * 96, O_ROPE = O_MOD + N_MOD, NITEMS = O_ROPE + 1;
        LAS unsigned* scr = (LAS unsigned*)lds;
        LAS float* cosT = (LAS float*)(lds + 40960);
        LAS float* condL = (LAS float*)(lds + 57344);
        bool have_cond = false;
        unsigned char* wsb = WSB();
        float* mod = (float*)(wsb + WS_MOD); float* ropeT = (float*)(wsb + WS_ROPE); bf16_t* Tc = (bf16_t*)(wsb + WS_TC);
        bf16_t* Win_t = (bf16_t*)(wsb + WS_WIN); bf16_t* Wout_t = (bf16_t*)(wsb + WS_WOUT);
        if (wg == (G >= 128 ? 125 : G - 2)) {
            for (int i = tid; i < 4096; i += 512) cosT[i] = cosf((float)i * (6.283185307179586f / 4096.0f));
            __syncthreads();
            for (int k = wave; k < 256; k += 8) { const int c8 = lane * 8; float v[8];
#pragma unroll
                for (int q = 0; q < 8; ++q) { const int col = c8 + q, l = col & 255; const int idx = ((k * l) & 255) * 16; v[q] = (col < 256 ? cosT[idx] : -cosT[(idx - 1024) & 4095]) * (1.0f / 16.0f); }
                u32x4 w; w.x = cvt_pk_bf16(v[0], v[1]); w.y = cvt_pk_bf16(v[2], v[3]); w.z = cvt_pk_bf16(v[4], v[5]); w.w = cvt_pk_bf16(v[6], v[7]);
                *(u32x4*)(Tc + (size_t)k * 512 + c8) = w; }
            __syncthreads();
        }
        if (wg == (G >= 128 ? 126 : G - 3)) {
            for (int i = tid; i < 4096; i += 512) cosT[i] = cosf((float)i * (6.283185307179586f / 4096.0f));
            __syncthreads();
            bf16_t* M1 = (bf16_t*)(wsb + WS_FFT); bf16_t* M2 = M1 + 128 * 128; float* TW = (float*)(wsb + WS_FFT + 49152);
            for (int i = tid; i < 128 * 128; i += 512) { const int m = i >> 7, kk = i & 127, k1 = m & 63, l1 = kk & 63; const int idx = ((k1 * l1) & 63) * 64; const float c = cosT[idx], sn = cosT[(idx - 1024) & 4095];
                const float v = (m < 64) ? (kk < 64 ? c : -sn) : (kk < 64 ? -sn : -c); M1[i] = (bf16_t)(cvt_pk_bf16(v, v) & 0xffffu); }
            for (int i = tid; i < 64 * 128; i += 512) { const int k2 = i >> 7, kk = i & 127, l2 = kk & 63; const int idx = ((k2 * l2) & 63) * 64; const float c = cosT[idx], sn = cosT[(idx - 1024) & 4095];
                const float v = (kk < 64 ? c : sn) * (1.0f / 64.0f); M2[i] = (bf16_t)(cvt_pk_bf16(v, v) & 0xffffu); }
            for (int i = tid; i < 4096; i += 512) { TW[2 * i] = cosT[i]; TW[2 * i + 1] = cosT[(i - 1024) & 4095]; }
            __syncthreads();
        }
        SUBDUP(3) for (int it4 = wg - 64; it4 >= 0 && it4 < 64; it4 += G) {
                const int it = it4 >> 2, dq = it4 & 3;
                const int cs = it & 1, h = (it >> 1) & 3, l = it >> 3;
                LAS float* trig = (LAS float*)(lds + MISC_OFF + 8192);
                LAS float* wfL = (LAS float*)lds;
                __syncthreads();
                if (tid < 128) trig[tid] = cs ? sinf((float)tid * (6.283185307179586f / 128.0f)) : cosf((float)tid * (6.283185307179586f / 128.0f));
                { const int r = tid >> 5, c4 = (tid & 31) * 4; const float* wf = INP(I_WFOUR) + (size_t)(l * 4 + h) * 128 * 128;
                  f32x4 v[8];
#pragma unroll
                  for (int i = 0; i < 8; ++i) v[i] = *(const f32x4*)(wf + (size_t)(r + 16 * i) * 128 + c4);
#pragma unroll
                  for (int i = 0; i < 8; ++i) *(LAS f32x4*)(wfL + (r + 16 * i) * 128 + c4) = v[i]; }
                __syncthreads();
                { const int e = tid & 127, dg = tid >> 7; float a[8];
#pragma unroll
                  for (int i = 0; i < 8; ++i) a[i] = 0.f;
                  const int d0 = dq * 32 + dg * 8;
#pragma unroll 4
                  for (int m = 0; m < 128; ++m) { const float wv = wfL[m * 128 + e];
#pragma unroll
                    for (int i = 0; i < 8; ++i) a[i] += trig[(m * (d0 + i)) & 127] * wv; }
                  bf16_t* MBr = (bf16_t*)(wsb + WS_MB) + ((size_t)l * PFW + h * 256 + cs * 128 + e) * NP;
#pragma unroll
                  for (int i = 0; i < 8; ++i) a[i] *= 0.08838834764831845f;
                  u32x4 w; w.x = cvt_pk_bf16(a[0], a[1]); w.y = cvt_pk_bf16(a[2], a[3]); w.z = cvt_pk_bf16(a[4], a[5]); w.w = cvt_pk_bf16(a[6], a[7]);
                  *(u32x4*)(MBr + d0) = w; }
                __syncthreads();
                have_cond = false;
        }
        SUBDUP(4) for (int it = O_MOD + ((wg + 128) % G); it < O_ROPE; it += G) {
                const int q = it - O_MOD, l = q / 96, n0 = (q % 96) * 128;
                if (!have_cond) { __syncthreads();
                    for (int i = tid; i < 5 * 2048; i += 512) { const int j = i >> 11, k = i & 2047; const float c = j < 4 ? INP(I_C)[j * 2048 + k] : INP(I_CCTX)[k]; condL[i] = silu_f(c); }
                    have_cond = true; __syncthreads(); }
                const int c4 = (tid & 31) * 4, kg = tid >> 5; f32x4 a[5];
#pragma unroll
                for (int j = 0; j < 5; ++j) a[j] = (f32x4){0.f, 0.f, 0.f, 0.f};
                const float* wp = INP(I_WADA) + (size_t)l * DM * 12288 + (size_t)(kg * 128) * 12288 + n0 + c4;
#pragma unroll 8
                for (int k = 0; k < 128; ++k) { const f32x4 wv = __builtin_nontemporal_load((const f32x4*)(wp + (size_t)k * 12288));
#pragma unroll
                    for (int j = 0; j < 5; ++j) a[j] += wv * condL[j * 2048 + kg * 128 + k]; }
                LAS float* red = (LAS float*)lds;
                __syncthreads();
#pragma unroll
                for (int j = 0; j < 5; ++j) *(LAS f32x4*)(red + (kg * 5 + j) * 128 + c4) = a[j];
                __syncthreads();
                if (tid < 128) {
#pragma unroll
                    for (int j = 0; j < 5; ++j) { float sacc = 0.f;
#pragma unroll
                        for (int g2 = 0; g2 < 16; ++g2) sacc += red[(g2 * 5 + j) * 128 + tid];
                        mod[(size_t)(l * 5 + j) * 12288 + n0 + tid] = sacc + INP(I_BADA)[l * 12288 + n0 + tid]; } }
                __syncthreads();
        }
        if (wg == (G >= 128 ? 127 : G - 1)) {
                for (int i = tid; i < 64 * 32; i += 512) { const int p = i >> 5, f = i & 31; const float inv = 1.0f / powf(10000.0f, (float)f / 32.0f); const float ang = (float)p * inv;
                    ropeT[2 * i] = cosf(ang); ropeT[2 * i + 1] = sinf(ang); }
        }
        __syncthreads();
        SEAM(0);
#define T16_DECODE(it_, src_, ldw_, dst_, ldb_) do { \
            if ((it_) < O_WOUT) { const int l = (it_) / TR_WIN, r = (it_) % TR_WIN, kb = r / 36, nb = r % 36; \
                src_ = INP(I_WIN) + (size_t)l * DM * INW + (size_t)(kb * 128) * INW + nb * 128; ldw_ = INW; dst_ = Win_t + (size_t)l * NP * DM + (size_t)(nb * 128) * DM + kb * 128; ldb_ = DM; } \
            else { const int q = (it_) - O_WOUT, l = q / TR_WOUT, r = q % TR_WOUT, kb = r / 16, nb = r % 16; \
                src_ = INP(I_WOUT) + (size_t)l * DM * DM + (size_t)(kb * 128) * DM + nb * 128; ldw_ = DM; dst_ = Wout_t + (size_t)l * DM * DM + (size_t)(nb * 128) * DM + kb * 128; ldb_ = DM; } } while (0)
        SUBDUP(0) {
            int it = wg; T16Regs t0, t1, t2; const float* src = nullptr; int ldw = 0; bf16_t *d0 = nullptr, *d1 = nullptr, *d2 = nullptr; int b0 = 0, b1 = 0, b2 = 0;
            if (it < O_F1) { T16_DECODE(it, src, ldw, d0, b0); t16_load(src, ldw, t0); }
            { const int itn_ = min(it + G, O_F1 - 1); T16_DECODE(itn_, src, ldw, d1, b1); t16_load(src, ldw, t1); }
#define T16_STEP(TL, DL, BL, TS, DS, BS) { if (it >= O_F1) break; { const int itn_ = min(it + 2 * G, O_F1 - 1); T16_DECODE(itn_, src, ldw, DL, BL); t16_load(src, ldw, TL); } t16_store(TS, DS, BS, scr); it += G; }
            for (;;) {
                T16_STEP(t2, d2, b2, t0, d0, b0)
                T16_STEP(t0, d0, b0, t1, d1, b1)
                T16_STEP(t1, d1, b1, t2, d2, b2)
            }
#undef T16_STEP
            asm volatile("s_waitcnt vmcnt(0)" ::: "memory"); __syncthreads();
        }
#undef T16_DECODE
#define T8_DECODE(it_, src_, ldw_, dst_, ldb_) do { \
            if ((it_) < O_F2) { const int q = (it_) - O_F1, which = q / TR_F13, r = q % TR_F13, kb = r / 44, nb = r % 44; \
                src_ = INP(which ? I_FW3 : I_FW1) + (size_t)(kb * 128) * DFF + nb * 128; ldw_ = DFF; dst_ = wsb + WS_WUP + (size_t)(nb * 256 + which * 128) * DM + kb * 128; ldb_ = DM; } \
            else if ((it_) < O_M1) { const int r = (it_) - O_F2, kb = r / 16, nb = r % 16; \
                src_ = INP(I_FW2) + (size_t)(kb * 128) * DM + nb * 128; ldw_ = DM; dst_ = wsb + WS_WDN + (size_t)(nb * 128) * DFF + kb * 128; ldb_ = DFF; } \
            else if ((it_) < O_M2) { const int q = (it_) - O_M1, which = q / (8 * TR_M13), q2 = q % (8 * TR_M13), e = q2 / TR_M13, r = q2 % TR_M13, kb = r / 56, nb = r % 56; \
                src_ = INP(which ? I_MW3 : I_MW1) + (size_t)e * DM * DFE + (size_t)(kb * 128) * DFE + nb * 128; ldw_ = DFE; dst_ = wsb + WS_MUP + (size_t)e * 2 * DFE * DM + (size_t)(nb * 256 + which * 128) * DM + kb * 128; ldb_ = DM; } \
            else { const int q = (it_) - O_M2, e = q / TR_M2, r = q % TR_M2, kb = r / 16, nb = r % 16; \
                src_ = INP(I_MW2) + (size_t)e * DFE * DM + (size_t)(kb * 128) * DM + nb * 128; ldw_ = DM; dst_ = wsb + WS_MDN + (size_t)e * DM * DFE + (size_t)(nb * 128) * DFE + kb * 128; ldb_ = DFE; } } while (0)
        SUBDUP(1) {
            int it = O_F1 + wg; T8Regs t0, t1, t2; const float* src = nullptr; int ldw = 0; unsigned char *d0 = nullptr, *d1 = nullptr, *d2 = nullptr; int b0 = 0, b1 = 0, b2 = 0;
            if (it < O_M1) { T8_DECODE(it, src, ldw, d0, b0); t8_load(src, ldw, t0); }
            { const int itn_ = min(it + G, O_M1 - 1); T8_DECODE(itn_, src, ldw, d1, b1); t8_load(src, ldw, t1); }
#define T8_STEP(TL, DL, BL, TS, DS, BS) { if (it >= O_M1) break; { const int itn_ = min(it + 2 * G, O_M1 - 1); T8_DECODE(itn_, src, ldw, DL, BL); t8_load(src, ldw, TL); } t8_store(TS, DS, BS, scr, F8_SW); it += G; }
            for (;;) {
                T8_STEP(t2, d2, b2, t0, d0, b0)
                T8_STEP(t0, d0, b0, t1, d1, b1)
                T8_STEP(t1, d1, b1, t2, d2, b2)
            }
#undef T8_STEP
        }
#undef T8_DECODE
        __syncthreads();
    }
    if (!(EN(10) && IN(0))) { SEAM(0); }

    for (int layer = 0; layer < 2; ++layer) {
        const int pb = 1 + 10 * layer;
#define LAYER_PTRS() unsigned char* wsb = WSB(); const float* modl = (const float*)(wsb + WS_MOD) + (size_t)layer * 5 * 12288; (void)modl
#define XIN_PTRS() const float* xin_lat = INP(I_X); const float* xin_ctx = INP(I_CTX); const bf16_t* xin_b = layer == 0 ? (const bf16_t*)nullptr : (const bf16_t*)(wsb + WS_X2)

        DUP(0) if (EN(0) && IN(pb + 0)) {
            PHASE_IDS();
            LAYER_PTRS(); XIN_PTRS(); bf16_t* HB = (bf16_t*)(wsb + WS_HB);
            const float* gn = INP(I_N1G) + layer * DM;
            f32x4 gv[8];
#pragma unroll
            for (int j = 0; j < 8; ++j) gv[j] = *(const f32x4*)(gn + lane * 4 + 256 * j);
#define NORM1_ROW(ROW, V) do { const int row_ = (ROW); const int mr = row_ < RL ? (row_ >> 12) : 4; const float* sh = modl + (size_t)mr * 12288; const float* sc = sh + 2048; float ss = 0.f; \
                _Pragma("unroll") for (int j = 0; j < 8; ++j) ss += (V[j][0] * V[j][0] + V[j][1] * V[j][1]) + (V[j][2] * V[j][2] + V[j][3] * V[j][3]); \
                const float rinv = rsqrtf(wave_sum(ss) * (1.0f / DM) + NORM_EPS); \
                _Pragma("unroll") for (int j = 0; j < 8; ++j) { const int c = lane * 4 + 256 * j; const f32x4 s1 = *(const f32x4*)(sc + c), s0 = *(const f32x4*)(sh + c); \
                    const f32x4 h = V[j] * rinv * gv[j] * (s1 + 1.0f) + s0; u32x2 w; w.x = cvt_pk_bf16(h[0], h[1]); w.y = cvt_pk_bf16(h[2], h[3]); \
                    *(u32x2*)(HB + (size_t)row_ * DM + c) = w; } } while (0)
            for (int row = gw; row < RT; row += 2 * NGW) {
                const int rowB = row + NGW; const bool hasB = rowB < RT; const int rb_ = hasB ? rowB : row;
                const float* xa = row < RL ? xin_lat + (size_t)row * DM : xin_ctx + (size_t)(row - RL) * DM;
                const float* xb = rb_ < RL ? xin_lat + (size_t)rb_ * DM : xin_ctx + (size_t)(rb_ - RL) * DM;
                f32x4 va[8], vb[8];
                if (layer == 0) {
#pragma unroll
                    for (int j = 0; j < 8; ++j) va[j] = *(const f32x4*)(xa + lane * 4 + 256 * j);
#pragma unroll
                    for (int j = 0; j < 8; ++j) vb[j] = *(const f32x4*)(xb + lane * 4 + 256 * j);
                } else { u32x2 qa[8], qb[8];
#pragma unroll
                    for (int j = 0; j < 8; ++j) qa[j] = *(const u32x2*)(xin_b + (size_t)row * DM + lane * 4 + 256 * j);
#pragma unroll
                    for (int j = 0; j < 8; ++j) qb[j] = *(const u32x2*)(xin_b + (size_t)rb_ * DM + lane * 4 + 256 * j);
#pragma unroll
                    for (int j = 0; j < 8; ++j) { va[j] = bf4(qa[j]); vb[j] = bf4(qb[j]); } }
                NORM1_ROW(row, va);
                if (hasB) NORM1_ROW(rowB, vb);
            }
#undef NORM1_ROW
        }
        SEAM(pb + 0);

        DUP(1) if (EN(1) && IN(pb + 1)) {
            unsigned char* wsb = WSB(); bf16_t* HB = (bf16_t*)(wsb + WS_HB); bf16_t* Win_t = (bf16_t*)(wsb + WS_WIN); bf16_t* P = (bf16_t*)(wsb + WS_P);
            pg8::Gemm g{HB, Win_t + (size_t)layer * NP * DM, 2 * DM};
            pg8::InProjOrder S; S.init(G, wg, layer == 1);
            pg8::EpiInProj E{P, (bf16_t*)(wsb + WS_NV), (bf16_t*)(wsb + WS_GV)};
            pg8::gemm_phase<pg8::EpiInProj, pg8::InProjOrder>(lds, g, S, E);
            { const int def_ = DEFICIT((RL / 256) * (NP / 256) + 4 * (layer == 1 ? 6 : NP / 256)); if (def_ > 0) MOE_GRAB(def_ * 14); }
        }
        SEAM(pb + 1);

        DUP(2) if (EN(2) && IN(pb + 2)) {
            PHASE_IDS();
            unsigned char* wsb = WSB(); const float* ropeT = (const float*)(wsb + WS_ROPE); const bf16_t* P = (const bf16_t*)(wsb + WS_P); bf16_t* Y = (bf16_t*)(wsb + WS_Y);
            bf16_t* NQ = (bf16_t*)(wsb + WS_NQ); bf16_t* NK = (bf16_t*)(wsb + WS_NK); bf16_t* NV = (bf16_t*)(wsb + WS_NV); bf16_t* GQ = (bf16_t*)(wsb + WS_GQ); bf16_t* GK = (bf16_t*)(wsb + WS_GK); bf16_t* GV = (bf16_t*)(wsb + WS_GV);
            bf16_t* PTC = (bf16_t*)(wsb + WS_PTC);
            const float* convw = INP(I_CONVW) + layer * 3 * 512;
            const float* g_nq = INP(I_NAQG) + layer * 128; const float* g_nk = INP(I_NAKG) + layer * 128;
            const float* g_gq = INP(I_GQG) + layer * 128; const float* g_gk = INP(I_GKG) + layer * 128;
            bf16_t* PF = (bf16_t*)(wsb + WS_PF);
            { const int nctx = layer == 0 ? 16 : 0; const int hh = wg & 3;
              struct CdftOrder { int G, c, nctx; __device__ __forceinline__ bool next(int i, pg8::Unit& u) const { const int L = i * G + c; if (L >= nctx) return false;
                  const int pm = RL / 256 + (L >> 2);
                  u.arow = 256 * pm; u.brow = 256 * (c & 3); u.orow = 256 * pm; u.ocol = 128 * (c & 3); return true; } };
              pg8::Gemm g{P + hh * 128, (const bf16_t*)(wsb + WS_MB) + (size_t)layer * PFW * NP, 2 * NP, 2 * 128};
              CdftOrder S{G, wg, nctx}; pg8::EpiStoreBf16 E{PF, PFW, 512};
              pg8::gemm_phase<pg8::EpiStoreBf16, CdftOrder>(lds, g, S, E);
              if (threadIdx.x == 0) { __builtin_amdgcn_fence(__ATOMIC_RELEASE, "agent"); asm volatile("s_waitcnt vmcnt(0)" ::: "memory");
                  for (int L = wg; L < nctx; L += G) xb_add(ctl + CW_CDF + 64 * (layer * 5 + 4), 1u); }
            }
            const int l16 = lane & 15;
            f32x4 cw[3][2], gq_[2], gk_[2], hq_[2], hk_[2];
#pragma unroll
            for (int k = 0; k < 3; ++k) { cw[k][0] = *(const f32x4*)(convw + k * 512 + lane * 8); cw[k][1] = *(const f32x4*)(convw + k * 512 + lane * 8 + 4); }
            gq_[0] = *(const f32x4*)(g_nq + l16 * 8); gq_[1] = *(const f32x4*)(g_nq + l16 * 8 + 4); gk_[0] = *(const f32x4*)(g_nk + l16 * 8); gk_[1] = *(const f32x4*)(g_nk + l16 * 8 + 4);
            hq_[0] = *(const f32x4*)(g_gq + l16 * 8); hq_[1] = *(const f32x4*)(g_gq + l16 * 8 + 4); hk_[0] = *(const f32x4*)(g_gk + l16 * 8); hk_[1] = *(const f32x4*)(g_gk + l16 * 8 + 4);
#define CDF_WAIT(f, n) do { __syncthreads(); if (threadIdx.x == 0) { while (__hip_atomic_load(ctl + CW_CDF + 64 * (layer * 5 + (f)), RLX_AGENT) < (unsigned)(n)) __builtin_amdgcn_s_sleep(2); \
                __builtin_amdgcn_fence(__ATOMIC_ACQUIRE, "agent"); asm volatile("s_waitcnt vmcnt(0)" ::: "memory"); } __syncthreads(); } while (0)
            struct PrepRaw { u32x4 gb, zc, zv, pc, pv, nc, nv, nq, nk, gq, gk; f32x4 rcs[4]; };
#define PREP_LOAD(ROW, R) do { const int row_ = (ROW); int t_, Ls_; if (row_ < RL) { t_ = row_ & 4095; Ls_ = SEQ; } else { t_ = (row_ - RL) & 255; Ls_ = CTXL; } \
                const bf16_t* Pr = P + (size_t)row_ * NP; const int ch = lane * 8; const u32x4 z4 = {0u, 0u, 0u, 0u}; \
                R.gb = *(const u32x4*)(Pr + PC_CB + ch); R.zc = *(const u32x4*)(Pr + PC_CC + ch); R.zv = *(const u32x4*)(Pr + PC_CV + ch); \
                R.pc = z4; R.pv = z4; R.nc = z4; R.nv = z4; \
                if (t_ > 0) { R.pc = *(const u32x4*)(Pr - NP + PC_CC + ch); R.pv = *(const u32x4*)(Pr - NP + PC_CV + ch); } \
                if (t_ < Ls_ - 1) { R.nc = *(const u32x4*)(Pr + NP + PC_CC + ch); R.nv = *(const u32x4*)(Pr + NP + PC_CV + ch); } \
                R.nq = *(const u32x4*)(Pr + PC_NQ + ch); R.nk = *(const u32x4*)(Pr + PC_NK + ch); R.gq = *(const u32x4*)(Pr + PC_GQ + ch); R.gk = *(const u32x4*)(Pr + PC_GK + (lane & 31) * 8); \
                { const int seg = l16 >> 2; const int p64 = (seg < 2) ? (t_ >> 6) : (t_ & 63); const float* cs_ = ropeT + (size_t)(p64 * 32 + (l16 & 3) * 8) * 2; \
                  _Pragma("unroll") for (int i = 0; i < 4; ++i) R.rcs[i] = *(const f32x4*)(cs_ + 4 * i); } } while (0)
#define HEADNORM(raw, gain, out) do { float _x[8]; _Pragma("unroll") for (int i = 0; i < 4; ++i) { _x[2 * i] = bf_lo(raw[i]); _x[2 * i + 1] = bf_hi(raw[i]); } \
                    float _ss = 0.f; _Pragma("unroll") for (int i = 0; i < 8; ++i) _ss += _x[i] * _x[i]; \
                    _ss += __shfl_xor(_ss, 1); _ss += __shfl_xor(_ss, 2); _ss += __shfl_xor(_ss, 4); _ss += __shfl_xor(_ss, 8); \
                    const float _ri = rsqrtf(_ss * (1.0f / 128.0f) + NORM_EPS); \
                    _Pragma("unroll") for (int i = 0; i < 8; ++i) out[i] = _x[i] * _ri * gain[i >> 2][i & 3]; } while (0)
#define ROPE8(v, R) do { const int seg = l16 >> 2; \
                    _Pragma("unroll") for (int i = 0; i < 8; ++i) { const float pvv = __shfl_xor(v[i], 4); const float c_ = R.rcs[i >> 1][(2 * i) & 3], s_ = R.rcs[i >> 1][(2 * i + 1) & 3]; v[i] = (seg & 1) ? (v[i] * c_ + pvv * s_) : (v[i] * c_ - pvv * s_); } } while (0)
#define PACK8(v, w) do { w.x = cvt_pk_bf16(v[0], v[1]); w.y = cvt_pk_bf16(v[2], v[3]); w.z = cvt_pk_bf16(v[4], v[5]); w.w = cvt_pk_bf16(v[6], v[7]); } while (0)
#define PREP_ROW(ROW, R) do { const int row_ = (ROW); int b, kvrow; bool lat; if (row_ < RL) { b = row_ >> 12; kvrow = CTXL + (row_ & 4095); lat = true; } else { const int rc = row_ - RL; b = rc >> 8; kvrow = rc & 255; lat = false; } \
                const int ch = lane * 8; \
                { float y[8]; \
                  _Pragma("unroll") for (int i = 0; i < 4; ++i) { \
                      const float w0a = cw[0][i >> 1][(2 * i) & 3], w1a = cw[1][i >> 1][(2 * i) & 3], w2a = cw[2][i >> 1][(2 * i) & 3]; \
                      const float w0b = cw[0][i >> 1][(2 * i + 1) & 3], w1b = cw[1][i >> 1][(2 * i + 1) & 3], w2b = cw[2][i >> 1][(2 * i + 1) & 3]; \
                      y[2 * i] = bf_lo(R.gb[i]) * (w0a * (bf_lo(R.pc[i]) * bf_lo(R.pv[i])) + w1a * (bf_lo(R.zc[i]) * bf_lo(R.zv[i])) + w2a * (bf_lo(R.nc[i]) * bf_lo(R.nv[i]))); \
                      y[2 * i + 1] = bf_hi(R.gb[i]) * (w0b * (bf_hi(R.pc[i]) * bf_hi(R.pv[i])) + w1b * (bf_hi(R.zc[i]) * bf_hi(R.zv[i])) + w2b * (bf_hi(R.nc[i]) * bf_hi(R.nv[i]))); } \
                  u32x4 w; PACK8(y, w); *(u32x4*)(Y + (size_t)row_ * DM + 512 + ch) = w; } \
                { float o[8]; HEADNORM(R.nq, gq_, o); u32x4 w; PACK8(o, w); *(u32x4*)(NQ + (size_t)row_ * 512 + ch) = w; } \
                { float o[8]; HEADNORM(R.nk, gk_, o); u32x4 w; PACK8(o, w); *(u32x4*)(NK + ((size_t)b * KVL + kvrow) * 512 + ch) = w; } \
                { float o[8]; HEADNORM(R.gq, hq_, o); if (lat) ROPE8(o, R); u32x4 w; PACK8(o, w); *(u32x4*)(GQ + (size_t)row_ * 512 + ch) = w; } \
                { float o[8]; HEADNORM(R.gk, hk_, o); if (lat) ROPE8(o, R); u32x4 w; PACK8(o, w); \
                  if (lane < 32) *(u32x4*)(GK + ((size_t)b * KVL + kvrow) * 256 + ch) = w; } } while (0)
            for (int row = gw; row < RT; row += 2 * NGW) {
                const int rowB = row + NGW; const bool hasB = rowB < RT;
                PrepRaw ra, rb;
                PREP_LOAD(row, ra); PREP_LOAD(hasB ? rowB : row, rb);
                PREP_ROW(row, ra);
                if (hasB) PREP_ROW(rowB, rb);
            }
#undef PREP_LOAD
#undef PREP_ROW
#undef HEADNORM
#undef ROPE8
#undef PACK8
            if (layer == 0) { LAS bf16_t* tscr = (LAS bf16_t*)(lds + wave * 8704);
              CDF_WAIT(4, 16);
              for (int item = (RL / 64) * 16 + gw; item < (RT / 64) * 16; item += NGW) {
                  const int rb = item >> 4, cb = item & 15, r0 = rb * 64, c0 = cb * 64;
#pragma unroll
                  for (int i = 0; i < 8; ++i) { const int rr = 8 * i + (lane >> 3), c8 = (lane & 7) * 8; const u32x4 v = *(const u32x4*)(PF + (size_t)(r0 + rr) * PFW + c0 + c8);
#pragma unroll
                      for (int k = 0; k < 4; ++k) { tscr[(c8 + 2 * k) * 66 + rr] = (bf16_t)(v[k] & 0xffffu); tscr[(c8 + 2 * k + 1) * 66 + rr] = (bf16_t)(v[k] >> 16); } }
                  LDS_WAIT();
#pragma unroll
                  for (int i = 0; i < 8; ++i) { const int cc = 8 * i + (lane >> 3), l8 = (lane & 7) * 8; const LAS unsigned* s = (const LAS unsigned*)(tscr + cc * 66 + l8);
                      u32x4 w; w.x = s[0]; w.y = s[1]; w.z = s[2]; w.w = s[3];
                      const int cg = c0 + cc; const int cm = cg & 511, sn = cg >> 9;
                      const int rc0 = r0 - RL, b = rc0 >> 8, l0 = rc0 & 255; *(u32x4*)(PTC + ((size_t)b * 512 + cm) * 512 + sn * 256 + l0 + l8) = w; }
                  LDS_WAIT();
              } }
            __syncthreads();
            for (int u = wg; u < NB * 64; u += G) {
                const int b = u >> 6, l2 = u & 63;
                const bf16_t* M1 = (const bf16_t*)(wsb + WS_FFT); const float* TW = (const float*)(wsb + WS_FFT + 49152); bf16_t* O1 = (bf16_t*)(wsb + WS_T);
                __syncthreads();
                cdft_to_slab(lds, P + ((size_t)b * SEQ + l2) * NP, (size_t)64 * NP, (const bf16_t*)(wsb + WS_MB) + (size_t)layer * PFW * NP, NP);
                auto rowp = [=](int) -> const bf16_t* { return nullptr; };
                auto epi = [=](int mbp, const f32x16 (&acc)[2][2], int wid, int r32, int hi) {
#pragma unroll
                        for (int r = 0; r < 16; ++r) { const int k1 = 32 * mbp + att::crow(r, hi); const f32x2 tw = *(const f32x2*)(TW + 2 * ((k1 * l2) & 4095));
                            bf16_t* o = O1 + ((((size_t)b * 64 + k1) * 2) * 64 + l2) * 512 + 64 * wid + r32;
#pragma unroll
                            for (int nb = 0; nb < 2; ++nb) { const float ur = acc[0][nb][r], ui = acc[1][nb][r]; const float vr = ur * tw.x + ui * tw.y, vi = ui * tw.x - ur * tw.y;
                                o[32 * nb] = (bf16_t)(cvt_pk_bf16(vr, vr) & 0xffffu); o[64 * 512 + 32 * nb] = (bf16_t)(cvt_pk_bf16(vi, vi) & 0xffffu); } } };
                fft_stage<2, false>(lds, M1, rowp, epi);
            }
#undef CDF_WAIT
        }
        SEAM(pb + 2);

        DUP(3) if (EN(3) && IN(pb + 3)) {
            PHASE_IDS();
            unsigned char* wsb = WSB(); bf16_t* Y = (bf16_t*)(wsb + WS_Y);
            const bf16_t* NQ = (const bf16_t*)(wsb + WS_NQ); const bf16_t* NK = (const bf16_t*)(wsb + WS_NK); const bf16_t* NV = (const bf16_t*)(wsb + WS_NV); const bf16_t* GQ = (const bf16_t*)(wsb + WS_GQ); const bf16_t* GK = (const bf16_t*)(wsb + WS_GK); const bf16_t* GV = (const bf16_t*)(wsb + WS_GV);
            const bf16_t* PTC = (const bf16_t*)(wsb + WS_PTC); const bf16_t* Tc = (const bf16_t*)(wsb + WS_TC);
            LAS float* rpbL = (LAS float*)(lds + RPB_OFF);
            if (MX(0)) for (int u = wg; u < NB * 64; u += G) {
                const int b = u >> 6, k1 = u & 63;
                const bf16_t* M2 = (const bf16_t*)(wsb + WS_FFT) + 128 * 128; const bf16_t* O1 = (const bf16_t*)(wsb + WS_T) + ((size_t)b * 64 + k1) * 2 * 64 * 512;
                auto rowp = [=](int kk) -> const bf16_t* { return O1 + (size_t)kk * 512; };
                auto epi = [=](int, const f32x16 (&acc)[2][2], int wid, int r32, int hi) {
#pragma unroll
                    for (int mb = 0; mb < 2; ++mb)
#pragma unroll
                        for (int r = 0; r < 16; ++r) { const int k2 = 32 * mb + att::crow(r, hi); bf16_t* o = Y + ((size_t)b * SEQ + k1 + 64 * k2) * DM + 64 * wid + r32;
#pragma unroll
                            for (int nb = 0; nb < 2; ++nb) { const float v = acc[mb][nb][r]; o[32 * nb] = (bf16_t)(cvt_pk_bf16(v, v) & 0xffffu); } } };
                fft_stage<1>(lds, M2, rowp, epi);
            }
            if (MX(5) && layer == 0) { pg8::Gemm g{Tc, PTC, 2 * 512}; pg8::DftOrder S{wg, 1}; pg8::EpiStoreBf16 E{Y, DM}; pg8::gemm_phase<pg8::EpiStoreBf16, pg8::DftOrder>(lds, g, S, E); }
            __syncthreads();
            if (MX(1)) for (int uu = wg; uu < 256; uu += G) {
                const int qb = uu & 15, h = (uu >> 4) & 3, b = uu >> 6;
                __syncthreads();
                for (int i = tid; i < 465; i += 512) rpbL[i] = INP(I_RPB)[(size_t)(layer * 4 + h) * 465 + i] * att::LOG2E;
                __syncthreads();
                const int r0 = qb * 4;
                const int rs_lo = min(max(r0 - 4, 0), 56), rs_hi = min(max(r0 + 3 - 4, 0), 56);
                int rlo = rs_lo, rhi = rs_hi + 7; if (((rhi - rlo + 1) & 1) != 0) { if (rhi < 63) ++rhi; else --rlo; }
                const int NT = 4 + (rhi - rlo + 1);
                attn_na_call(NQ + ((size_t)b * SEQ + qb * 256) * 512 + h * 128, NK + (size_t)b * KVL * 512 + h * 128, NV + (size_t)b * KVL * 512 + h * 128, Y + ((size_t)b * SEQ + qb * 256) * DM + 1024 + h * 128, NT, r0, rlo);
            }
            if (MX(2)) {
                const int w2 = (wg & 15) == 0 ? 2 * (wg >> 4) : (wg & 15) == 15 ? 2 * (wg >> 4) + 1 : -1;
                const int nun = 1 + ((layer == 0 && w2 >= 0) ? 1 : 0);
                for (int i = 0; i < nun; ++i) {
                    const bf16_t *qp, *kp, *vp; bf16_t* op; int ldk, nt;
                    if (i < 1) { const int uu = wg & 255, qb = uu & 15, h = (uu >> 4) & 3, b = uu >> 6, kvh = h >> 1;
                        qp = GQ + ((size_t)b * SEQ + qb * 256) * 512 + h * 128; kp = GK + (size_t)b * KVL * 256 + kvh * 128; vp = GV + (size_t)b * KVL * 256 + kvh * 128;
                        op = Y + ((size_t)b * SEQ + qb * 256) * DM + 1536 + h * 128; ldk = 256; nt = KVL / 64; }
                    else if (w2 < 16) { const int h = w2 & 3, b = w2 >> 2, kvh = h >> 1;
                        qp = GQ + ((size_t)RL + b * CTXL) * 512 + h * 128; kp = GK + (size_t)b * KVL * 256 + kvh * 128; vp = GV + (size_t)b * KVL * 256 + kvh * 128;
                        op = Y + ((size_t)RL + b * CTXL) * DM + 1536 + h * 128; ldk = 256; nt = CTXL / 64; }
                    else { const int h = w2 & 3, b = (w2 - 16) >> 2;
                        qp = NQ + ((size_t)RL + b * CTXL) * 512 + h * 128; kp = NK + (size_t)b * KVL * 512 + h * 128; vp = NV + (size_t)b * KVL * 512 + h * 128;
                        op = Y + ((size_t)RL + b * CTXL) * DM + 1024 + h * 128; ldk = 512; nt = CTXL / 64; }
                    attn_dense_call(qp, kp, vp, op, nt, ldk);
                }
            }
        }
        SEAM(pb + 3);

        DUP(4) if (EN(4) && IN(pb + 4)) {
            LAYER_PTRS(); XIN_PTRS(); const bf16_t* Y = (const bf16_t*)(wsb + WS_Y); const bf16_t* Wout_t = (const bf16_t*)(wsb + WS_WOUT); bf16_t* Xmid = (bf16_t*)(wsb + WS_X1);
            pg8::Gemm g{Y, Wout_t + (size_t)layer * DM * DM, 2 * DM};
            pg8::GridOrder S; S.init((layer == 0 ? RT : RL) / 256, DM / 256, G, wg, 0, 0, 0, 0, 256);
            pg8::EpiResid E{xin_lat, xin_ctx, xin_b, Xmid, modl + 2 * 2048, 1.0f};
            pg8::gemm_phase<pg8::EpiResid, pg8::GridOrder>(lds, g, S, E);
            { const int def_ = DEFICIT(((layer == 0 ? RT : RL) / 256) * (DM / 256)); if (def_ > 0) MOE_GRAB(def_ * 14); }
        }
        SEAM(pb + 4);

        if (EN(5) && IN(pb + 5)) {
            PHASE_IDS();
            LAYER_PTRS(); const bf16_t* Xmid = (const bf16_t*)(wsb + WS_X1); unsigned char* HB8 = (unsigned char*)(wsb + WS_HB);
            int* route_pos = (int*)(wsb + WS_ROUTE + 256 * 1024);
            const float* gn = INP(I_N2G) + layer * DM;
            LAS float* wrL = (LAS float*)(lds + ROUTER_LDS);
            if (layer == 1) { for (int i = tid; i < 2048 * 8; i += 512) wrL[i] = INP(I_ROUTER)[i]; __syncthreads(); }
            const int nrows = layer == 0 ? RT : RL;
            f32x4 gv[8];
#pragma unroll
            for (int j = 0; j < 8; ++j) gv[j] = *(const f32x4*)(gn + lane * 4 + 256 * j);
            for (int row0 = gw; row0 < nrows; row0 += 2 * NGW) {
                const int rowB = row0 + NGW; const bool hasB = rowB < nrows; const int rb_ = hasB ? rowB : row0;
                u32x2 va[8], vb[8];
#pragma unroll
                for (int j = 0; j < 8; ++j) va[j] = *(const u32x2*)(Xmid + (size_t)row0 * DM + lane * 4 + 256 * j);
#pragma unroll
                for (int j = 0; j < 8; ++j) vb[j] = *(const u32x2*)(Xmid + (size_t)rb_ * DM + lane * 4 + 256 * j);
#pragma unroll 1
                for (int half = 0; half < 2; ++half) {
                if (half == 1 && !hasB) break;
                const int row = half ? rowB : row0;
                f32x4 v[8];
#pragma unroll
                for (int j = 0; j < 8; ++j) v[j] = bf4(half ? vb[j] : va[j]);
                const int mr = row < RL ? (row >> 12) : 4;
                const float* sh = modl + (size_t)mr * 12288 + 3 * 2048; const float* sc = sh + 2048;
                float ss = 0.f;
#pragma unroll
                for (int j = 0; j < 8; ++j) ss += (v[j][0] * v[j][0] + v[j][1] * v[j][1]) + (v[j][2] * v[j][2] + v[j][3] * v[j][3]);
                const float rinv = rsqrtf(wave_sum(ss) * (1.0f / DM) + NORM_EPS);
                float lg[8] = {0.f, 0.f, 0.f, 0.f, 0.f, 0.f, 0.f, 0.f};
                unsigned hq[8];
#pragma unroll
                for (int j = 0; j < 8; ++j) { const int c = lane * 4 + 256 * j; const f32x4 g = gv[j], s1 = *(const f32x4*)(sc + c), s0 = *(const f32x4*)(sh + c);
                    const f32x4 h = v[j] * rinv * g * (s1 + 1.0f) + s0;
                    hq[j] = pk4_fp8(h[0] * F8_SH, h[1] * F8_SH, h[2] * F8_SH, h[3] * F8_SH);
                    if (layer == 0) *(unsigned*)(HB8 + (size_t)row * DM + c) = hq[j];
                    if (layer == 1) {
#pragma unroll
                        for (int k = 0; k < 4; ++k) { const f32x4 wa = *(const LAS f32x4*)(wrL + (c + k) * 8), wb = *(const LAS f32x4*)(wrL + (c + k) * 8 + 4);
                            lg[0] += h[k] * wa[0]; lg[1] += h[k] * wa[1]; lg[2] += h[k] * wa[2]; lg[3] += h[k] * wa[3]; lg[4] += h[k] * wb[0]; lg[5] += h[k] * wb[1]; lg[6] += h[k] * wb[2]; lg[7] += h[k] * wb[3]; } } }
                if (layer == 1) {
#pragma unroll
                    for (int e = 0; e < 8; ++e) lg[e] = wave_sum(lg[e]);
                    int i0 = 0; float v0 = lg[0];
#pragma unroll
                    for (int e = 1; e < 8; ++e) if (lg[e] > v0) { v0 = lg[e]; i0 = e; }
                    int i1 = -1; float v1 = -3.0e38f;
#pragma unroll
                    for (int e = 0; e < 8; ++e) if (e != i0 && lg[e] > v1) { v1 = lg[e]; i1 = e; }
                    const float w0 = 1.0f / (1.0f + __expf(v1 - v0)), w1 = 1.0f - w0;
                    int d0 = 0, d1 = 0;
                    if (lane == 0) {
                        const unsigned p0 = atomicAdd(ctl + CW_CNT + 64 * i0, 1u), p1 = atomicAdd(ctl + CW_CNT + 64 * i1, 1u);
                        unsigned* t0w = ctl + CW_TILE + 64 * i0 + (p0 >> 8); unsigned* t1w = ctl + CW_TILE + 64 * i1 + (p1 >> 8);
                        unsigned q0 = 0, q1 = 0;
                        if ((p0 & 255u) == 0u) { q0 = atomicAdd(ctl + CW_POOL, 1u) + 1u; __hip_atomic_store(t0w, q0, RLX_AGENT); }
                        if ((p1 & 255u) == 0u) { q1 = atomicAdd(ctl + CW_POOL, 1u) + 1u; __hip_atomic_store(t1w, q1, RLX_AGENT); }
                        while (q0 == 0u) { q0 = __hip_atomic_load(t0w, RLX_AGENT); if (q0 == 0u) __builtin_amdgcn_s_sleep(1); }
                        while (q1 == 0u) { q1 = __hip_atomic_load(t1w, RLX_AGENT); if (q1 == 0u) __builtin_amdgcn_s_sleep(1); }
                        d0 = (int)((q0 - 1u) * 256u + (p0 & 255u)); d1 = (int)((q1 - 1u) * 256u + (p1 & 255u));
                        route_pos[2 * row] = d0; route_pos[2 * row + 1] = d1; }
                    d0 = __builtin_amdgcn_readfirstlane(d0); d1 = __builtin_amdgcn_readfirstlane(d1);
                    unsigned char* APERM8 = wsb + WS_APERM; float* roww = (float*)(wsb + WS_ROUTE + 384 * 1024);
                    { const size_t d = (size_t)d0;
#pragma unroll
                        for (int j = 0; j < 8; ++j) *(unsigned*)(APERM8 + d * DM + lane * 4 + 256 * j) = hq[j];
                        if (lane == 0) roww[d] = w0; }
                    { const size_t d = (size_t)d1;
#pragma unroll
                        for (int j = 0; j < 8; ++j) *(unsigned*)(APERM8 + d * DM + lane * 4 + 256 * j) = hq[j];
                        if (lane == 0) roww[d] = w1; }
                }
                }
            }
            if (layer == 1) MOE_DRAIN(CW_QUP, 0, NT_MUP);
            __syncthreads();
        }
        SEAM(pb + 5);

        if (layer == 0) {
            DUP(7) if (EN(7) && IN(pb + 7)) {
                unsigned char* wsb = WSB(); const unsigned char* HB8 = wsb + WS_HB; const unsigned char* Wup8 = wsb + WS_WUP; unsigned char* ACT8 = wsb + WS_ACT;
                pg8::Gemm g{HB8, Wup8, DM};
                pg8::GridOrder S; S.init(RT / 256, 2 * DFF / 256, G, wg, 0, 0, 0, 0, 128);
                pg8::EpiSwiglu8 E{ACT8, DFF, 1.0f / (F8_SW * F8_SH), F8_SA};
                pg8::gemm_phase<pg8::EpiSwiglu8, pg8::GridOrder, true>(lds, g, S, E);
                { const int def_ = DEFICIT((RT / 256) * (2 * DFF / 256)); if (def_ > 0) MOE_GRAB(def_ * 7); }
            }
            SEAM(pb + 7);
            DUP(8) if (EN(8) && IN(pb + 8)) {
                LAYER_PTRS(); const unsigned char* ACT8 = wsb + WS_ACT; const unsigned char* Wdn8 = wsb + WS_WDN; const bf16_t* Xmid = (const bf16_t*)(wsb + WS_X1); bf16_t* X2 = (bf16_t*)(wsb + WS_X2);
                pg8::Gemm g{ACT8, Wdn8, DFF};
                pg8::GridOrder S; S.init(RT / 256, DM / 256, G, wg, 0, 0, 0, 0, 256);
                pg8::EpiResid E{nullptr, nullptr, Xmid, X2, modl + 5 * 2048, 1.0f / (F8_SW * F8_SA)};
                pg8::gemm_phase<pg8::EpiResid, pg8::GridOrder, true>(lds, g, S, E);
                { const int def_ = DEFICIT((RT / 256) * (DM / 256)); if (def_ > 0) MOE_GRAB(def_ * 20); }
            }
            SEAM(pb + 8);
        } else {
            volatile LAS int* tb = (volatile LAS int*)(MISC + 16); volatile LAS int* tl = (volatile LAS int*)(lds + TL_OFF);
            if (IN(pb + 7) || IN(pb + 8) || IN(pb + 9)) {
                __syncthreads();
                if (tid == 0) { int acc = 0; for (int e = 0; e < 8; ++e) { tb[e] = acc; const int c = (int)__hip_atomic_load(ctl + CW_CNT + 64 * e, RLX_AGENT); acc += (c + 255) >> 8; } tb[8] = acc; }
                __syncthreads();
                { int t_ = (int)threadIdx.x; asm volatile("" : "+v"(t_)); const int e = t_ >> 6, j = t_ & 63; if (j < tb[e + 1] - tb[e]) tl[tb[e] + j] = (int)__hip_atomic_load(ctl + CW_TILE + 64 * e + j, RLX_AGENT) - 1; }
                __syncthreads();
            }
            DUP(11) if (EN(11) && IN(pb + 7)) {
                unsigned char* wsb = WSB(); const unsigned char* APERM8 = wsb + WS_APERM; const unsigned char* Mup8 = wsb + WS_MUP; unsigned char* ACTM8 = wsb + WS_ACTM;
                pg8::Gemm g{APERM8, Mup8, DM};
                pg8::MoeOrder S{G, wg, 2 * DFE / 256, 128, 2 * DFE, tb, tl};
                pg8::EpiSwiglu8 E{ACTM8, DFE, 1.0f / (F8_SW * F8_SH), F8_SA};
                pg8::gemm_phase<pg8::EpiSwiglu8, pg8::MoeOrder, true>(lds, g, S, E);
                MOE_DRAIN(CW_QDN, NT_MUP, NT_MDN);
            }
            SEAM(pb + 7);
            DUP(12) if (EN(12) && IN(pb + 8)) {
                unsigned char* wsb = WSB(); const unsigned char* ACTM8 = wsb + WS_ACTM; const unsigned char* Mdn8 = wsb + WS_MDN; bf16_t* OPERM = (bf16_t*)(wsb + WS_OPERM); const float* roww = (const float*)(wsb + WS_ROUTE + 384 * 1024);
                pg8::Gemm g{ACTM8, Mdn8, DFE};
                const int T_ = tb[8] * (DM / 256), F_ = T_ / G, rem_ = T_ % G;
                const int KS = (rem_ > 0 && rem_ * 4 <= G) ? 4 : (rem_ > 0 && rem_ * 2 <= G) ? 2 : 1;
                pg8::MoeOrder S{G, wg, DM / 256, 256, DM, tb, tl, KS > 1 ? F_ * G : 0x7fffffff};
                pg8::EpiMoeDown E{OPERM, roww, 1.0f / (F8_SW * F8_SA)};
                pg8::gemm_phase<pg8::EpiMoeDown, pg8::MoeOrder, true>(lds, g, S, E);
                if (KS > 1) {
                    const int j = wg / KS, q = wg % KS; const bool mine = j < rem_;
                    float* slab = (float*)(wsb + WS_APERM) + (size_t)(j * KS + q) * 65536;
                    pg8::MoeTailOrder TS{S, mine ? F_ * G + j : -1};
                    pg8::Gemm g2{ACTM8 + q * (DFE / KS), Mdn8 + q * (DFE / KS), DFE, DFE / KS};
                    pg8::EpiPartial E2{slab};
                    pg8::gemm_phase<pg8::EpiPartial, pg8::MoeTailOrder, true>(lds, g2, TS, E2);
                    if (mine) {
                        if (threadIdx.x == 0) { __builtin_amdgcn_fence(__ATOMIC_RELEASE, "agent"); asm volatile("s_waitcnt vmcnt(0)" ::: "memory");
                            (void)xb_add(ctl + CW_KS + j, 1u);
                            while (xb_ld(ctl + CW_KS + j) < (unsigned)KS) __builtin_amdgcn_s_sleep(1);
                            __builtin_amdgcn_fence(__ATOMIC_ACQUIRE, "agent"); asm volatile("s_waitcnt vmcnt(0)" ::: "memory"); }
                        __syncthreads();
                        {   pg8::Unit u; (void)S.unit(F_ * G + j, u);
                            int t_ = (int)threadIdx.x; asm volatile("" : "+v"(t_));
                            const int rpw = 256 / KS;
                            const int r = q * rpw + t_ / (512 / rpw), ncol = 256 / (512 / rpw), hc = (t_ % (512 / rpw)) * ncol;
                            const float rw = roww[u.orow + r] * (1.0f / (F8_SW * F8_SA));
                            const float* sp = (const float*)(wsb + WS_APERM) + (size_t)(j * KS) * 65536 + (size_t)r * 256 + hc; bf16_t* op = OPERM + (size_t)(u.orow + r) * DM + u.ocol + hc;
#pragma unroll 4
                            for (int c8 = 0; c8 < ncol / 8; ++c8) { f32x4 a0 = {0.f, 0.f, 0.f, 0.f}, a1 = {0.f, 0.f, 0.f, 0.f};
                                for (int qq = 0; qq < KS; ++qq) { a0 += *(const f32x4*)(sp + (size_t)qq * 65536 + c8 * 8); a1 += *(const f32x4*)(sp + (size_t)qq * 65536 + c8 * 8 + 4); }
                                a0 *= rw; a1 *= rw;
                                u32x4 w; w.x = cvt_pk_bf16(a0[0], a0[1]); w.y = cvt_pk_bf16(a0[2], a0[3]); w.z = cvt_pk_bf16(a1[0], a1[1]); w.w = cvt_pk_bf16(a1[2], a1[3]);
                                *(u32x4*)(op + c8 * 8) = w; }
                        }
                        __syncthreads();
                    }
                }
            }
            SEAM(pb + 8);
            DUP(9) if (EN(9) && IN(pb + 9)) {
            PHASE_IDS();
                LAYER_PTRS(); const bf16_t* Xmid = (const bf16_t*)(wsb + WS_X1); const bf16_t* OPERM = (const bf16_t*)(wsb + WS_OPERM); float* outp = OUTP();
                const int* route_pos = (const int*)(wsb + WS_ROUTE + 256 * 1024);
                for (int t = gw; t < RL; t += 2 * NGW) {
                    const int tB = t + NGW; const bool hasB = tB < RL; const int tb_ = hasB ? tB : t;
                    const int a0 = route_pos[2 * t], a1 = route_pos[2 * t + 1];
                    const int c0 = route_pos[2 * tb_], c1 = route_pos[2 * tb_ + 1];
                    u32x2 xa[8], xb[8]; u32x2 pa0[8], pa1[8], pb0[8], pb1[8];
#pragma unroll
                    for (int j = 0; j < 8; ++j) { const int c = lane * 4 + 256 * j; xa[j] = *(const u32x2*)(Xmid + (size_t)t * DM + c); pa0[j] = *(const u32x2*)(OPERM + (size_t)a0 * DM + c); pa1[j] = *(const u32x2*)(OPERM + (size_t)a1 * DM + c); }
#pragma unroll
                    for (int j = 0; j < 8; ++j) { const int c = lane * 4 + 256 * j; xb[j] = *(const u32x2*)(Xmid + (size_t)tb_ * DM + c); pb0[j] = *(const u32x2*)(OPERM + (size_t)c0 * DM + c); pb1[j] = *(const u32x2*)(OPERM + (size_t)c1 * DM + c); }
                    { const float* g2 = modl + (size_t)(t >> 12) * 12288 + 5 * 2048;
#pragma unroll
                      for (int j = 0; j < 8; ++j) { const int c = lane * 4 + 256 * j; const f32x4 gg = *(const f32x4*)(g2 + c); const u32x2 a = pa0[j], b = pa1[j]; const f32x4 x = bf4(xa[j]);
                        f32x4 o; o[0] = x[0] + gg[0] * (bf_lo(a.x) + bf_lo(b.x)); o[1] = x[1] + gg[1] * (bf_hi(a.x) + bf_hi(b.x)); o[2] = x[2] + gg[2] * (bf_lo(a.y) + bf_lo(b.y)); o[3] = x[3] + gg[3] * (bf_hi(a.y) + bf_hi(b.y));
                        *(f32x4*)(outp + (size_t)t * DM + c) = o; } }
                    if (hasB) { const float* g2 = modl + (size_t)(tB >> 12) * 12288 + 5 * 2048;
#pragma unroll
                      for (int j = 0; j < 8; ++j) { const int c = lane * 4 + 256 * j; const f32x4 gg = *(const f32x4*)(g2 + c); const u32x2 a = pb0[j], b = pb1[j]; const f32x4 x = bf4(xb[j]);
                        f32x4 o; o[0] = x[0] + gg[0] * (bf_lo(a.x) + bf_lo(b.x)); o[1] = x[1] + gg[1] * (bf_hi(a.x) + bf_hi(b.x)); o[2] = x[2] + gg[2] * (bf_lo(a.y) + bf_lo(b.y)); o[3] = x[3] + gg[3] * (bf_hi(a.y) + bf_hi(b.y));
                        *(f32x4*)(outp + (size_t)tB * DM + c) = o; } }
                }
            }
        }
    }
#undef IN
#undef SEAM
}

template <unsigned PM, unsigned MM> static int prep_kernel() {
    if (hipFuncSetAttribute((const void*)mk_fwd<PM, MM>, hipFuncAttributeMaxDynamicSharedMemorySize, LDS_BYTES) != hipSuccess) { fprintf(stderr, "kernel_launch: hipFuncSetAttribute failed\n"); return -1; }
    return 0;
}
template <unsigned PM, unsigned MM> static void launch_ph(int grid, Args a, int lo, int hi, hipStream_t stream) {
    static int ok = 0; if (ok == 0) ok = prep_kernel<PM, MM>() == 0 ? 1 : -1; if (ok < 0) return;
    a.ph_lo = lo; a.ph_hi = hi;
    hipLaunchKernelGGL((mk_fwd<PM, MM>), dim3(grid), dim3(512), LDS_BYTES, stream, a);
}
extern "C" void kernel_launch(void* const* d_in, const int* in_sizes, int n_in, void* d_out, int out_size, void* d_ws, size_t ws_size, hipStream_t stream) {
    static int grid = 0;
    if (grid == 0) {
        if (n_in != 24 || out_size != RL * DM || ws_size < WS_END) { fprintf(stderr, "kernel_launch: unexpected shapes (n_in %d out %d ws %zu need %zu)\n", n_in, out_size, ws_size, (size_t)WS_END); grid = -1; return; }
        int dev = 0, cus = 0;
        if (hipGetDevice(&dev) != hipSuccess || hipDeviceGetAttribute(&cus, hipDeviceAttributeMultiprocessorCount, dev) != hipSuccess) { grid = -1; return; }
        grid = cus;
    }
    if (grid < 0) return;
    (void)hipMemsetAsync((char*)d_ws + WS_CTL, 0, CTL_ZERO_BYTES, stream);
    Args a{};
    for (int i = 0; i < 24; ++i) a.in[i] = (const float*)d_in[i];
    a.out = (float*)d_out; a.ws = (unsigned char*)d_ws;
#if MK_ONE_LAUNCH
    launch_ph<0xFFFFFFFFu, 0xFFu>(grid, a, 0, 21, stream);
#else
    launch_ph<1u << 10, 0>(grid, a, 0, 1, stream);
    for (int l = 0; l < 2; ++l) { const int pb = 1 + 10 * l;
        launch_ph<1u << 0, 0>(grid, a, pb + 0, pb + 1, stream);
        launch_ph<1u << 1, 0>(grid, a, pb + 1, pb + 2, stream);
        launch_ph<1u << 2, 0>(grid, a, pb + 2, pb + 3, stream);
        launch_ph<1u << 3, 1u>(grid, a, pb + 3, pb + 4, stream);
        if (l == 0) launch_ph<1u << 3, 32u>(grid, a, pb + 3, pb + 4, stream);
        launch_ph<1u << 3, 2u>(grid, a, pb + 3, pb + 4, stream);
        launch_ph<1u << 3, 4u>(grid, a, pb + 3, pb + 4, stream);
        launch_ph<1u << 4, 0>(grid, a, pb + 4, pb + 5, stream);
        launch_ph<1u << 5, 0>(grid, a, pb + 5, pb + 6, stream);
        if (l == 0) { launch_ph<1u << 7, 0>(grid, a, pb + 7, pb + 8, stream); launch_ph<1u << 8, 0>(grid, a, pb + 8, pb + 9, stream); }
        else { launch_ph<1u << 11, 0>(grid, a, pb + 7, pb + 8, stream); launch_ph<1u << 12, 0>(grid, a, pb + 8, pb + 9, stream); launch_ph<1u << 9, 0>(grid, a, pb + 9, pb + 10, stream); }
    }
#endif
}
```

```cpp
#include <hip/hip_runtime.h>
#include <hip/hip_bf16.h>
#include <cstdio>
#include <cstdint>

#ifndef PROBE_DUP
#define PROBE_DUP 0u
#endif
#ifndef PROBE_SUB
#define PROBE_SUB 0u
#endif
#define SUBDUP(k) for (int _q = 0; _q < 1 + (int)((PROBE_SUB >> (k)) & 1u); ++_q)
#define DUP(k) for (int _r = 0; _r < 1 + (int)((PROBE_DUP >> (k)) & 1u); ++_r)
#define EN(k) (((PM) >> (k)) & 1u)
#define MX(k) (((MM) >> (k)) & 1u)
#ifndef MK_ONE_LAUNCH
#define MK_ONE_LAUNCH 1
#endif

#define LAS __attribute__((address_space(3)))
typedef unsigned short bf16_t;
typedef short bf16x8 __attribute__((ext_vector_type(8)));
typedef short s16x4 __attribute__((ext_vector_type(4)));
typedef float f32x4 __attribute__((ext_vector_type(4)));
typedef float f32x2 __attribute__((ext_vector_type(2)));
typedef float f32x16 __attribute__((ext_vector_type(16)));
typedef unsigned u32x4 __attribute__((ext_vector_type(4)));
typedef unsigned u32x2 __attribute__((ext_vector_type(2)));

constexpr int DM = 2048, NB = 4, SEQ = 4096, CTXL = 256;
constexpr int RL = NB * SEQ, RC = NB * CTXL, RT = RL + RC;
constexpr int NP = 4608;
constexpr int INW = 4608;
constexpr int KVL = CTXL + SEQ;
constexpr int DFF = 5632, NEXP = 8, DFE = 7168;
constexpr int MOE_TILES_MAX = 2 * RL / 256 + NEXP;
constexpr int MOE_ROWS_MAX = MOE_TILES_MAX * 256;
constexpr float NORM_EPS = 1e-6f;
constexpr int PC_V = 0, PC_CB = 512, PC_CC = 1024, PC_CV = 1536, PC_NQ = 2048, PC_NK = 2560, PC_NV = 3072, PC_GQ = 3584, PC_GK = 4096, PC_GV = 4352;
constexpr int PFW = 1024;

constexpr size_t MiB = 1u << 20;
constexpr size_t WS_CTL = 0, CTL_ZERO_BYTES = 1 * MiB;
constexpr size_t WS_MOD = 1 * MiB;
constexpr size_t WS_ROPE = 1 * MiB + 512 * 1024;
constexpr size_t WS_ROUTE = 2 * MiB;
constexpr size_t WS_T = 3 * MiB;
constexpr size_t WS_MB = 37 * MiB;
constexpr size_t WS_FFT = 1 * MiB + 768 * 1024;
constexpr size_t WS_TC = 67 * MiB;
constexpr size_t WS_WIN = 68 * MiB;
constexpr size_t WS_WOUT = 108 * MiB;
constexpr size_t WS_WUP = 124 * MiB;
constexpr size_t WS_WDN = 168 * MiB;
constexpr size_t WS_MUP = 190 * MiB;
constexpr size_t WS_MDN = 638 * MiB;
constexpr size_t WS_X1 = 862 * MiB;
constexpr size_t WS_X2 = 998 * MiB;
constexpr size_t WS_HB = 1134 * MiB;
constexpr size_t WS_S = 1202 * MiB;
constexpr size_t WS_P = WS_S;
constexpr size_t WS_NQ = WS_S + 170 * MiB;
constexpr size_t WS_NK = WS_NQ + 17 * MiB;
constexpr size_t WS_NV = WS_NK + 17 * MiB;
constexpr size_t WS_GQ = WS_NV + 17 * MiB;
constexpr size_t WS_GK = WS_GQ + 17 * MiB;
constexpr size_t WS_GV = WS_GK + 9 * MiB;
constexpr size_t WS_PF = WS_GV + 9 * MiB;
constexpr size_t WS_PTC = WS_PF + 34 * MiB;
constexpr size_t WS_Y = WS_PTC + 2 * MiB;
constexpr size_t WS_ACT = WS_S;
constexpr size_t WS_APERM = WS_S;
constexpr size_t WS_ACTM = WS_S + 136 * MiB;
constexpr size_t WS_OPERM = WS_X2;
constexpr size_t WS_END = WS_ACTM + 240 * MiB;
static_assert(WS_Y + 68 * MiB <= WS_END && WS_ACT + 187 * MiB <= WS_Y, "ws map");

constexpr int CW_BAR = 4096;
constexpr int CW_CNT = 8192;
constexpr int CW_POOL = 9344;
constexpr int CW_KS = 11264;
constexpr int CW_CDF = 9408;
constexpr int CW_TILE = 10240;

constexpr int LDS_BYTES = 147456;
constexpr int MISC_OFF = 131072;
constexpr int TL_OFF = MISC_OFF + 12288;
constexpr int RPB_OFF = MISC_OFF + 1024 + 512;
constexpr int ROUTER_LDS = 0;

#define GAS __attribute__((address_space(1)))
#define RLX_AGENT __ATOMIC_RELAXED, __HIP_MEMORY_SCOPE_AGENT
#define LDS_WAIT() asm volatile("s_waitcnt lgkmcnt(0)" ::: "memory")
#define VM_WAIT() asm volatile("s_waitcnt vmcnt(0)" ::: "memory")

__device__ __forceinline__ unsigned cvt_pk_bf16(float lo, float hi) { unsigned r; asm volatile("v_cvt_pk_bf16_f32 %0, %1, %2" : "=v"(r) : "v"(lo), "v"(hi)); return r; }
__device__ __forceinline__ float bf_lo(unsigned w) { return __uint_as_float(w << 16); }
__device__ __forceinline__ float bf_hi(unsigned w) { return __uint_as_float(w & 0xffff0000u); }
__device__ __forceinline__ f32x4 bf4(u32x2 w) { f32x4 r; r[0] = bf_lo(w.x); r[1] = bf_hi(w.x); r[2] = bf_lo(w.y); r[3] = bf_hi(w.y); return r; }
__device__ __forceinline__ float wave_sum(float v) {
#pragma unroll
    for (int o = 1; o < 64; o <<= 1) v += __shfl_xor(v, o);
    return v;
}
constexpr float F8_SW = 64.0f, F8_SH = 2.0f, F8_SA = 4.0f;
__device__ __forceinline__ float clamp448(float x) { return __builtin_amdgcn_fmed3f(x, -448.0f, 448.0f); }
__device__ __forceinline__ unsigned pk4_fp8(float a, float b, float c, float d) { int w = 0; w = __builtin_amdgcn_cvt_pk_fp8_f32(clamp448(a), clamp448(b), w, false); w = __builtin_amdgcn_cvt_pk_fp8_f32(clamp448(c), clamp448(d), w, true); return (unsigned)w; }
__device__ __forceinline__ float silu_f(float a) { return a / (1.0f + __expf(-a)); }

namespace pg8 {
constexpr int BM = 256, BK = 64, HALF = 128, HTB = HALF * BK * 2, STAGE_BYTES = 8 * HTB, NXCD = 8, WGM = 8;
__host__ __device__ __forceinline__ int lds_byte(int r, int c) { const int st = (r >> 4) * 2 + (c >> 5), rr = r & 15, cc = c & 31, ob = rr * 64 + cc * 2; return st * 1024 + (ob ^ (((ob >> 9) & 1) << 5)); }
__host__ __device__ __forceinline__ void stage_rc(int b, int& R, int& C) { const int st = b / 1024, sb = b % 1024, swz = sb ^ (((sb >> 9) & 1) << 5); R = (st >> 1) * 16 + swz / 64; C = (st & 1) * 32 + (swz % 64) / 2; }
__host__ __device__ __forceinline__ int perm32(int rho) { const int n = rho >> 4, i = rho & 15; return 8 * (i >> 2) + 4 * n + (i & 3); }

typedef int i32x4 __attribute__((ext_vector_type(4)));
typedef int i32x8 __attribute__((ext_vector_type(8)));
__device__ __forceinline__ i32x8 cat8(bf16x8 a, bf16x8 b) { const i32x4 x = __builtin_bit_cast(i32x4, a), y = __builtin_bit_cast(i32x4, b); return __builtin_shufflevector(x, y, 0, 1, 2, 3, 4, 5, 6, 7); }
struct Unit { int arow, brow, orow, ocol; };
struct Gemm { const void* A; const void* Bt; int rb; int kb = 0; };

struct GridOrder {
    int nM, nN, nwg, G, c, arow0, brow0, orow0, ocol0, ocstep;
    __device__ void init(int nM_, int nN_, int G_, int c_, int arow0_, int brow0_, int orow0_, int ocol0_, int ocstep_) { nM = nM_; nN = nN_; nwg = nM * nN; G = G_; c = c_; asm volatile("" : "+s"(c)); arow0 = arow0_; brow0 = brow0_; orow0 = orow0_; ocol0 = ocol0_; ocstep = ocstep_; }
    __device__ __forceinline__ bool next(int i, Unit& u) const {
        const long L = (long)i * G + c; if (L >= nwg) return false;
        int wgid = (int)L; { const int q = nwg / NXCD, r = nwg % NXCD, xcd = wgid % NXCD, off = wgid / NXCD; wgid = (xcd < r ? xcd * (q + 1) : r * (q + 1) + (xcd - r) * q) + off; }
        const int nig = WGM * nN, gid = wgid / nig, fm = gid * WGM, gsz = (nM - fm) < WGM ? (nM - fm) : WGM;
        const int pm = __builtin_amdgcn_readfirstlane(fm + ((wgid % nig) % gsz)), pn = __builtin_amdgcn_readfirstlane((wgid % nig) / gsz);
        u.arow = arow0 + 256 * pm; u.brow = brow0 + 256 * pn; u.orow = orow0 + 256 * pm; u.ocol = ocol0 + ocstep * pn; return true;
    }
};
struct InProjOrder {
    GridOrder go; int nctxcols;
    __device__ void init(int G_, int c_, int kv_only) { go.init(RL / 256, NP / 256, G_, c_, 0, 0, 0, 0, 256); nctxcols = kv_only ? 6 : NP / 256; }
    __device__ __forceinline__ bool next(int i, Unit& u) const {
        const int L = i * go.G + go.c, nlat = (RL / 256) * (NP / 256);
        if (L < nlat) return go.next(i, u);
        const int q = L - nlat; if (q >= 4 * nctxcols) return false;
        const int pm = RL / 256 + q / nctxcols, j = q % nctxcols; const int pn = nctxcols == 6 ? (j < 4 ? 10 + j : 12 + j) : j;
        u.arow = 256 * pm; u.brow = 256 * pn; u.orow = 256 * pm; u.ocol = 256 * pn; return true;
    }
};
struct DftOrder {
    int c, ctx;
    __device__ __forceinline__ bool next(int i, Unit& u) const {
        if (i > 0) return false;
        if (!ctx) { if (c >= 128) return false; const int b = c >> 5, pm = (c & 31) >> 1, pn = c & 1; u.arow = 256 * pm; u.brow = b * 512 + 256 * pn; u.orow = b * SEQ + 256 * pm; u.ocol = 256 * pn; return true; }
        if (c >= 8) return false; const int b = c >> 1, pn = c & 1; u.arow = 0; u.brow = b * 512 + 256 * pn; u.orow = RL + b * CTXL; u.ocol = 256 * pn; return true;
    }
};
struct MoeOrder {
    int G, c, nN, ocstep, brow_per_exp; const volatile LAS int* tb; const volatile LAS int* tl; int lmax = 0x7fffffff;
    __device__ __forceinline__ bool next(int i, Unit& u) const { const int L = i * G + c; if (L >= lmax) return false; return unit(L, u); }
    __device__ __forceinline__ bool unit(int L, Unit& u) const {
        const int total = tb[8] * nN; if (L >= total) return false;
        int w; { const int q = total / NXCD, r = total % NXCD, xcd = L % NXCD, off = L / NXCD; w = (xcd < r ? xcd * (q + 1) : r * (q + 1) + (xcd - r) * q) + off; }
        int e = 0;
#pragma unroll
        for (int j = 1; j < 8; ++j) if (w >= tb[j] * nN) e = j;
        const int t0 = tb[e], nt = tb[e + 1] - t0, q2 = w - t0 * nN;
        const int nig = WGM * nN, gid = q2 / nig, fm = gid * WGM, gsz = (nt - fm) < WGM ? (nt - fm) : WGM;
        const int pml = fm + ((q2 % nig) % gsz), pn = (q2 % nig) / gsz;
        u.arow = __builtin_amdgcn_readfirstlane(tl[t0 + pml] * 256); u.brow = __builtin_amdgcn_readfirstlane(e * brow_per_exp + pn * 256); u.orow = u.arow; u.ocol = __builtin_amdgcn_readfirstlane(pn * ocstep); return true;
    }
};

struct MoeTailOrder { MoeOrder mo; int L; __device__ __forceinline__ bool next(int i, Unit& u) const { if (i > 0 || L < 0) return false; return mo.unit(L, u); } };

struct EpiStoreBf16 {
    static constexpr bool PERM = true;
    bf16_t* O; int ldc; int bjstep = HALF;
    __device__ __forceinline__ void operator()(const f32x4 (&acc)[2][2][4][2], const Unit& u, int wr, int wc, int fr, int fq) const {
        const int row0 = u.orow + wr * 64 + fr, col0 = u.ocol + wc * 32 + 8 * fq;
#pragma unroll
        for (int ai = 0; ai < 2; ++ai)
#pragma unroll
            for (int m = 0; m < 4; ++m) { bf16_t* rowp = O + (size_t)(row0 + ai * HALF + m * 16) * ldc + col0;
#pragma unroll
                for (int bj = 0; bj < 2; ++bj) { const f32x4 v0 = acc[ai][bj][m][0], v1 = acc[ai][bj][m][1];
                    u32x4 w; w.x = cvt_pk_bf16(v0[0], v0[1]); w.y = cvt_pk_bf16(v0[2], v0[3]); w.z = cvt_pk_bf16(v1[0], v1[1]); w.w = cvt_pk_bf16(v1[2], v1[3]);
                    *(u32x4*)(rowp + bj * bjstep) = w; } }
    }
};
struct EpiInProj {
    static constexpr bool PERM = true;
    bf16_t* P; bf16_t* NV; bf16_t* GV;
    __device__ __forceinline__ void operator()(const f32x4 (&acc)[2][2][4][2], const Unit& u, int wr, int wc, int fr, int fq) const {
        bf16_t* O = P; int ldc = NP, orow = u.orow, ocol = u.ocol;
        const int kvr = u.orow < RL ? (u.orow >> 12) * KVL + CTXL + (u.orow & 4095) : ((u.orow - RL) >> 8) * KVL;
        if (ocol >= PC_NV && ocol < PC_NV + 512) { O = NV; ldc = 512; orow = kvr; ocol -= PC_NV; }
        else if (ocol >= PC_GV) { O = GV; ldc = 256; orow = kvr; ocol -= PC_GV; }
        const int row0 = orow + wr * 64 + fr, col0 = ocol + wc * 32 + 8 * fq;
#pragma unroll
        for (int ai = 0; ai < 2; ++ai)
#pragma unroll
            for (int m = 0; m < 4; ++m) { bf16_t* rowp = O + (size_t)(row0 + ai * HALF + m * 16) * ldc + col0;
#pragma unroll
                for (int bj = 0; bj < 2; ++bj) { const f32x4 v0 = acc[ai][bj][m][0], v1 = acc[ai][bj][m][1];
                    u32x4 w; w.x = cvt_pk_bf16(v0[0], v0[1]); w.y = cvt_pk_bf16(v0[2], v0[3]); w.z = cvt_pk_bf16(v1[0], v1[1]); w.w = cvt_pk_bf16(v1[2], v1[3]);
                    *(u32x4*)(rowp + bj * HALF) = w; } }
    }
};
struct EpiResid {
    static constexpr bool PERM = true;
    const float* res_lat; const float* res_ctx; const bf16_t* res_b; bf16_t* out; const float* gate; float sc;
    __device__ __forceinline__ void operator()(const f32x4 (&acc)[2][2][4][2], const Unit& u, int wr, int wc, int fr, int fq) const {
        const int col0 = u.ocol + wc * 32 + 8 * fq; const int mrow = u.orow < RL ? (u.orow >> 12) : 4;
        const float* rf = u.orow < RL ? res_lat + (size_t)u.orow * DM : res_ctx + (size_t)(u.orow - RL) * DM;
        const bool rbf = res_b != nullptr;
        f32x4 gv[2][2];
#pragma unroll
        for (int bj = 0; bj < 2; ++bj)
#pragma unroll
            for (int n = 0; n < 2; ++n) gv[bj][n] = *(const f32x4*)(gate + (size_t)mrow * 12288 + col0 + bj * HALF + n * 4);
#pragma unroll
        for (int ai = 0; ai < 2; ++ai)
#pragma unroll
            for (int m = 0; m < 4; ++m) { const size_t off = (size_t)(wr * 64 + fr + ai * HALF + m * 16) * DM + col0;
#pragma unroll
                for (int bj = 0; bj < 2; ++bj) { f32x4 r0, r1;
                    if (rbf) { const u32x4 rr = *(const u32x4*)(res_b + (size_t)u.orow * DM + off + bj * HALF);
                        r0[0] = bf_lo(rr.x); r0[1] = bf_hi(rr.x); r0[2] = bf_lo(rr.y); r0[3] = bf_hi(rr.y); r1[0] = bf_lo(rr.z); r1[1] = bf_hi(rr.z); r1[2] = bf_lo(rr.w); r1[3] = bf_hi(rr.w); }
                    else { r0 = *(const f32x4*)(rf + off + bj * HALF); r1 = *(const f32x4*)(rf + off + bj * HALF + 4); }
                    const f32x4 v0 = r0 + gv[bj][0] * (acc[ai][bj][m][0] * sc), v1 = r1 + gv[bj][1] * (acc[ai][bj][m][1] * sc);
                    u32x4 w; w.x = cvt_pk_bf16(v0[0], v0[1]); w.y = cvt_pk_bf16(v0[2], v0[3]); w.z = cvt_pk_bf16(v1[0], v1[1]); w.w = cvt_pk_bf16(v1[2], v1[3]);
                    *(u32x4*)(out + (size_t)u.orow * DM + off + bj * HALF) = w; } }
    }
};
struct EpiSwiglu8 {
    static constexpr bool PERM = true;
    unsigned char* O; int ldc; float inv, osc;
    __device__ __forceinline__ void operator()(const f32x4 (&acc)[2][2][4][2], const Unit& u, int wr, int wc, int fr, int fq) const {
        const int row0 = u.orow + wr * 64 + fr, col0 = u.ocol + wc * 32 + 8 * fq;
        const float io = inv * osc, c1 = -1.4426950408889634f * inv, kk = 1.0f / (inv * io);
#pragma unroll
        for (int ai = 0; ai < 2; ++ai)
#pragma unroll
            for (int m = 0; m < 4; ++m) { unsigned char* rowp = O + (size_t)(row0 + ai * HALF + m * 16) * ldc + col0;
                float v[8];
#pragma unroll
                for (int n = 0; n < 2; ++n)
#pragma unroll
                    for (int j = 0; j < 4; ++j) { const float x0 = acc[ai][0][m][n][j], x1 = acc[ai][1][m][n][j];
                        const float t = __builtin_amdgcn_exp2f(x0 * c1); v[n * 4 + j] = (x0 * x1) * __builtin_amdgcn_rcpf(__builtin_fmaf(t, kk, kk)); }
                u32x2 w; w.x = pk4_fp8(v[0], v[1], v[2], v[3]); w.y = pk4_fp8(v[4], v[5], v[6], v[7]);
                *(u32x2*)rowp = w; }
    }
};
struct EpiMoeDown {
    static constexpr bool PERM = true;
    bf16_t* O; const float* roww; float sc;
    __device__ __forceinline__ void operator()(const f32x4 (&acc)[2][2][4][2], const Unit& u, int wr, int wc, int fr, int fq) const {
        const int row0 = u.orow + wr * 64 + fr, col0 = u.ocol + wc * 32 + 8 * fq;
#pragma unroll
        for (int ai = 0; ai < 2; ++ai)
#pragma unroll
            for (int m = 0; m < 4; ++m) { const int row = row0 + ai * HALF + m * 16; const float rw = roww[row] * sc; bf16_t* rowp = O + (size_t)row * DM + col0;
#pragma unroll
                for (int bj = 0; bj < 2; ++bj) { const f32x4 v0 = acc[ai][bj][m][0] * rw, v1 = acc[ai][bj][m][1] * rw;
                    u32x4 w; w.x = cvt_pk_bf16(v0[0], v0[1]); w.y = cvt_pk_bf16(v0[2], v0[3]); w.z = cvt_pk_bf16(v1[0], v1[1]); w.w = cvt_pk_bf16(v1[2], v1[3]);
                    *(u32x4*)(rowp + bj * HALF) = w; } }
    }
};

struct EpiPartial {
    static constexpr bool PERM = true;
    float* slab;
    __device__ __forceinline__ void operator()(const f32x4 (&acc)[2][2][4][2], const Unit&, int wr, int wc, int fr, int fq) const {
        const int row0 = wr * 64 + fr, col0 = wc * 32 + 8 * fq;
#pragma unroll
        for (int ai = 0; ai < 2; ++ai)
#pragma unroll
            for (int m = 0; m < 4; ++m) { float* rowp = slab + (size_t)(row0 + ai * HALF + m * 16) * 256 + col0;
#pragma unroll
                for (int bj = 0; bj < 2; ++bj) { *(f32x4*)(rowp + bj * HALF) = acc[ai][bj][m][0]; *(f32x4*)(rowp + bj * HALF + 4) = acc[ai][bj][m][1]; } }
    }
};

template <class Epi, class Sched, bool F8 = false, bool ALIGN_EPI = true, bool SP2 = true>
__device__ __forceinline__ void gemm_phase(LAS unsigned char* lds, const Gemm g, const Sched& S, const Epi& E) {
    int tid = threadIdx.x; asm volatile("" : "+v"(tid));
    const int wid = __builtin_amdgcn_readfirstlane(tid >> 6), lane = tid & 63, wr = wid >> 2, wc = wid & 3, fr = lane & 15, fq = lane >> 4;
    int RB = g.rb; asm volatile("" : "+s"(RB)); int KB_ = g.kb ? g.kb : g.rb; asm volatile("" : "+s"(KB_)); const int nt = KB_ / (2 * BK);
    unsigned voffA[2], voffB[2];
#pragma unroll
    for (int i = 0; i < 2; ++i) { int R, C; stage_rc(tid * 16 + i * 8192, R, C); const int Rb = Epi::PERM ? ((R & ~31) + perm32(R & 31)) : R;
        voffA[i] = (unsigned)(R * RB + C * 2); voffB[i] = (unsigned)(Rb * RB + C * 2); }
    const size_t kstep = (size_t)(BK * 2);
    const size_t hstep = (size_t)HALF * RB;
    const size_t rstep = (size_t)RB;
    const unsigned ldsw = (unsigned)wid * 1024u;
    const int aoff = lds_byte(wr * 64 + fr, fq * 8), boff = lds_byte(wc * 32 + fr, fq * 8);
#define PG8_SA(b, h) (((b) * 2 + (h)) * HTB)
#define PG8_SB(b, h) ((4 + (b) * 2 + (h)) * HTB)
#define PG8_STAGE(bufoff, gbase, voff) do { _Pragma("unroll") for (int _i = 0; _i < 2; ++_i) \
        __builtin_amdgcn_global_load_lds((const unsigned*)((const char*)(gbase) + (voff)[_i]), (LAS unsigned*)(lds + (bufoff) + ldsw + _i * 8192), 16, 0, 0); } while (0)
#define PG8_LDA(dst, b, h) do { _Pragma("unroll") for (int m = 0; m < 4; ++m) _Pragma("unroll") for (int k = 0; k < 2; ++k) dst[m][k] = *(const LAS bf16x8*)(lds + PG8_SA(b, h) + aoff + m * 2048 + k * 1024); } while (0)
#define PG8_LDB(dst, b, h) do { _Pragma("unroll") for (int n = 0; n < 2; ++n) _Pragma("unroll") for (int k = 0; k < 2; ++k) dst[n][k] = *(const LAS bf16x8*)(lds + PG8_SB(b, h) + boff + n * 2048 + k * 1024); } while (0)
#define PG8_MMA(ai, bj, At, Bt) do { __builtin_amdgcn_s_setprio(1); _Pragma("unroll") for (int m = 0; m < 4; ++m) _Pragma("unroll") for (int n = 0; n < 2; ++n) { \
        if constexpr (F8) { asm volatile("v_mfma_scale_f32_16x16x128_f8f6f4 %0, %1, %2, %0, %3, %3 op_sel_hi:[0,0,0]" : "+v"(acc[ai][bj][m][n]) : "v"(cat8(Bt[n][0], Bt[n][1])), "v"(cat8(At[m][0], At[m][1])), "v"(f8scale)); } \
        else { _Pragma("unroll") for (int k = 0; k < 2; ++k) acc[ai][bj][m][n] = __builtin_amdgcn_mfma_f32_16x16x32_bf16(Bt[n][k], At[m][k], acc[ai][bj][m][n], 0, 0, 0); } } __builtin_amdgcn_s_setprio(0); } while (0)
#define PG8_WAIT_V(n) asm volatile("s_waitcnt vmcnt(" #n ")" ::: "memory")
#define PG8_WAIT_L(n) asm volatile("s_waitcnt lgkmcnt(" #n ")" ::: "memory")
#define PG8_BAR __builtin_amdgcn_s_barrier()
#define PG8_SCHED __builtin_amdgcn_sched_barrier(0)
    Unit cur, nxt; int ui = 0;
    if (!S.next(0, cur)) return;
    f32x4 acc[2][2][4][2];
#pragma unroll
    for (int a = 0; a < 2; ++a)
#pragma unroll
        for (int b = 0; b < 2; ++b)
#pragma unroll
            for (int m = 0; m < 4; ++m)
#pragma unroll
                for (int n = 0; n < 2; ++n) acc[a][b][m][n] = (f32x4){0.f, 0.f, 0.f, 0.f};
    bf16x8 At[4][2], B0[2][2], B1[2][2];
    int f8scale = 0x7f7f7f7f; asm volatile("" : "+v"(f8scale));
    const char* cA = (const char*)g.A + (size_t)cur.arow * rstep; const char* cB = (const char*)g.Bt + (size_t)cur.brow * rstep;
    if constexpr (SP2) {
        PG8_STAGE(PG8_SB(0, 0), cB, voffB); PG8_STAGE(PG8_SB(0, 1), cB + hstep, voffB); PG8_STAGE(PG8_SA(0, 0), cA, voffA); PG8_STAGE(PG8_SA(0, 1), cA + hstep, voffA);
        if (wr == 1) PG8_BAR;
        PG8_WAIT_V(2); PG8_BAR;
        PG8_STAGE(PG8_SB(1, 0), cB + kstep, voffB); PG8_STAGE(PG8_SA(1, 0), cA + kstep, voffA); PG8_STAGE(PG8_SB(1, 1), cB + hstep + kstep, voffB);
        PG8_WAIT_V(6); PG8_BAR;
    } else {
        PG8_STAGE(PG8_SB(0, 0), cB, voffB); PG8_STAGE(PG8_SA(0, 0), cA, voffA); PG8_STAGE(PG8_SB(0, 1), cB + hstep, voffB); PG8_STAGE(PG8_SA(0, 1), cA + hstep, voffA);
        if (wr == 1) PG8_BAR;
        PG8_WAIT_V(4); PG8_BAR;
        PG8_STAGE(PG8_SB(1, 0), cB + kstep, voffB); PG8_STAGE(PG8_SA(1, 0), cA + kstep, voffA); PG8_STAGE(PG8_SB(1, 1), cB + hstep + kstep, voffB);
        PG8_WAIT_V(6); PG8_BAR;
    }
    for (;;) {
        const bool has_next = S.next(ui + 1, nxt);
        const char* nA = has_next ? (const char*)g.A + (size_t)nxt.arow * rstep : cA; const char* nB = has_next ? (const char*)g.Bt + (size_t)nxt.brow * rstep : cB;
        for (int t = 0; t < nt; t += 2) {
            const bool last = (t == nt - 2);
            const char* a1 = cA + (size_t)(t + 1) * kstep;
            const char* a2 = last ? nA : cA + (size_t)(t + 2) * kstep; const char* b2 = last ? nB : cB + (size_t)(t + 2) * kstep;
            const char* a3 = a2 + kstep; const char* b3 = b2 + kstep;
            if constexpr (SP2) {
            PG8_LDB(B0, 0, 0); PG8_LDB(B1, 0, 1); PG8_SCHED; PG8_LDA(At, 0, 0); PG8_STAGE(PG8_SA(1, 1), a1 + hstep, voffA);
            PG8_WAIT_V(8); PG8_WAIT_L(0); PG8_BAR; PG8_MMA(0, 0, At, B0); PG8_MMA(0, 1, At, B1); PG8_BAR; PG8_SCHED;
            PG8_LDA(At, 0, 1); PG8_STAGE(PG8_SB(0, 0), b2, voffB); PG8_STAGE(PG8_SB(0, 1), b2 + hstep, voffB); PG8_STAGE(PG8_SA(0, 0), a2, voffA);
            PG8_WAIT_V(8); PG8_WAIT_L(0); PG8_BAR; PG8_MMA(1, 0, At, B0); PG8_MMA(1, 1, At, B1); PG8_BAR; PG8_SCHED;
            PG8_LDB(B0, 1, 0); PG8_LDB(B1, 1, 1); PG8_SCHED; PG8_LDA(At, 1, 0); PG8_STAGE(PG8_SA(0, 1), a2 + hstep, voffA);
            PG8_WAIT_V(8); PG8_WAIT_L(0); PG8_BAR; PG8_MMA(0, 0, At, B0); PG8_MMA(0, 1, At, B1); PG8_BAR; PG8_SCHED;
            PG8_LDA(At, 1, 1); PG8_STAGE(PG8_SB(1, 0), b3, voffB); PG8_STAGE(PG8_SB(1, 1), b3 + hstep, voffB); PG8_STAGE(PG8_SA(1, 0), a3, voffA);
            PG8_WAIT_V(8); PG8_WAIT_L(0); PG8_BAR; PG8_MMA(1, 0, At, B0); PG8_MMA(1, 1, At, B1); PG8_BAR; PG8_SCHED;
            } else {
            PG8_LDB(B0, 0, 0); PG8_SCHED; PG8_LDA(At, 0, 0); PG8_STAGE(PG8_SA(1, 1), a1 + hstep, voffA);
            PG8_WAIT_L(8); PG8_BAR; PG8_WAIT_L(0); PG8_MMA(0, 0, At, B0); PG8_BAR; PG8_SCHED;
            PG8_LDB(B1, 0, 1); PG8_STAGE(PG8_SB(0, 0), b2, voffB);
            PG8_BAR; PG8_WAIT_L(0); PG8_MMA(0, 1, At, B1); PG8_BAR;
            PG8_LDA(At, 0, 1); PG8_STAGE(PG8_SA(0, 0), a2, voffA);
            PG8_BAR; PG8_WAIT_L(0); PG8_MMA(1, 0, At, B0); PG8_BAR; PG8_SCHED;
            PG8_STAGE(PG8_SB(0, 1), b2 + hstep, voffB);
            PG8_WAIT_V(6); PG8_BAR; PG8_MMA(1, 1, At, B1); PG8_BAR;
            PG8_LDB(B0, 1, 0); PG8_SCHED; PG8_LDA(At, 1, 0); PG8_STAGE(PG8_SA(0, 1), a2 + hstep, voffA);
            PG8_WAIT_L(8); PG8_BAR; PG8_WAIT_L(0); PG8_MMA(0, 0, At, B0); PG8_BAR; PG8_SCHED;
            PG8_LDB(B1, 1, 1); PG8_STAGE(PG8_SB(1, 0), b3, voffB);
            PG8_BAR; PG8_WAIT_L(0); PG8_MMA(0, 1, At, B1); PG8_BAR;
            PG8_LDA(At, 1, 1); PG8_STAGE(PG8_SA(1, 0), a3, voffA);
            PG8_BAR; PG8_WAIT_L(0); PG8_MMA(1, 0, At, B0); PG8_BAR; PG8_SCHED;
            PG8_STAGE(PG8_SB(1, 1), b3 + hstep, voffB);
            PG8_WAIT_V(6); PG8_BAR; PG8_MMA(1, 1, At, B1); PG8_BAR;
            }
        }
        if constexpr (F8) { asm volatile("s_nop 15\n\ts_nop 15" ::: "memory"); }
        else { asm volatile("s_nop 15\n\ts_nop 15" : "+v"(acc[1][1][3][1]) :: "memory"); }
        if constexpr (ALIGN_EPI) { if (wr == 0) PG8_BAR; }
        E(acc, cur, wr, wc, fr, fq);
        if (!has_next) break;
#pragma unroll
        for (int a = 0; a < 2; ++a)
#pragma unroll
            for (int b = 0; b < 2; ++b)
#pragma unroll
                for (int m = 0; m < 4; ++m)
#pragma unroll
                    for (int n = 0; n < 2; ++n) acc[a][b][m][n] = (f32x4){0.f, 0.f, 0.f, 0.f};
        cur = nxt; cA = nA; cB = nB; ++ui;
        if constexpr (ALIGN_EPI) { if (wr == 1) PG8_BAR; }
    }
    PG8_WAIT_V(0);
    if constexpr (!ALIGN_EPI) { if (wr == 0) PG8_BAR; }
    PG8_BAR;
#undef PG8_SA
#undef PG8_SB
#undef PG8_STAGE
#undef PG8_LDA
#undef PG8_LDB
#undef PG8_MMA
#undef PG8_WAIT_V
#undef PG8_WAIT_L
#undef PG8_BAR
#undef PG8_SCHED
}
}

namespace att {
constexpr int D = 128, NW = 8, QBLK = 32, KVBLK = 64;
constexpr float SCALE = 0.088388347648318440f;
constexpr float THR = 8.f;
constexpr float LOG2E = 1.4426950408889634f;
constexpr size_t SHM_V = KVBLK * D * 2, SHM_K = KVBLK * D * 2, SHM_ATTN = 2 * SHM_V + 2 * SHM_K + NW * 64 * 4;
#define KSWZ(row, colB) ((row) * 256 + ((colB) ^ (((row) & 7) << 4)))
#define SBAR() __builtin_amdgcn_sched_barrier(0)
__device__ __forceinline__ int crow(int r, int hi) { return (r & 3) + 8 * (r >> 2) + 4 * hi; }
__device__ __forceinline__ unsigned cvtpk(float lo, float hi) { unsigned r; asm volatile("v_cvt_pk_bf16_f32 %0, %1, %2" : "=v"(r) : "v"(lo), "v"(hi)); return r; }

struct NaInfo { const LAS float* rpb; int qrow, rs, c, cs, rlo; };

__device__ __forceinline__ void partialSM(f32x16& p0, f32x16& p1, float& m_reg, float& mn, float& alpha) {
  constexpr float C = SCALE * LOG2E;
  float pmax = p0[0];
#pragma unroll
  for (int r = 1; r < 16; ++r) pmax = fmaxf(pmax, p0[r]);
#pragma unroll
  for (int r = 0; r < 16; ++r) pmax = fmaxf(pmax, p1[r]);
  { auto rr = __builtin_amdgcn_permlane32_swap(__float_as_uint(pmax), __float_as_uint(pmax), false, false);
    pmax = fmaxf(__uint_as_float(rr[0]), __uint_as_float(rr[1])); }
  if (__builtin_expect(__all(pmax - m_reg <= THR / SCALE), 1)) { mn = m_reg; alpha = 1.f; }
  else { mn = fmaxf(m_reg, pmax); alpha = __builtin_amdgcn_exp2f((m_reg - mn) * C); m_reg = mn; }
  float mnC = -mn * C;
#pragma unroll
  for (int r = 0; r < 16; ++r) p0[r] = fmaf(p0[r], C, mnC);
#pragma unroll
  for (int r = 0; r < 16; ++r) p1[r] = fmaf(p1[r], C, mnC);
#pragma unroll
  for (int r = 0; r < 16; ++r) p0[r] = __builtin_amdgcn_exp2f(p0[r]);
}
__device__ __forceinline__ void partialSM_na(f32x16& p0, f32x16& p1, float& m_reg, float& mn, float& alpha, int tile, const NaInfo& na, int hi) {
  constexpr float C = SCALE * LOG2E;
  if (tile < 4) {
#pragma unroll
    for (int r = 0; r < 16; ++r) { p0[r] *= C; p1[r] *= C; }
  } else {
    const int krow = na.rlo + tile - 4;
    const bool rowvalid = (krow >= na.rs) && (krow < na.rs + 8);
    if (rowvalid) {
      const int dr = krow - na.qrow + 7;
      const LAS float* bp = na.rpb + dr * 31 + (15 - na.c + 4 * hi);
      const int kc0 = 4 * hi;
#pragma unroll
      for (int r = 0; r < 16; ++r) { const int ko = (r & 3) + 8 * (r >> 2);
        const int kcA = kc0 + ko, kcB = kcA + 32;
        const float bA = bp[ko], bB = bp[ko + 32];
        const bool vA = (kcA >= na.cs) && (kcA < na.cs + 16), vB = (kcB >= na.cs) && (kcB < na.cs + 16);
        p0[r] = vA ? fmaf(p0[r], C, bA) : -1e30f; p1[r] = vB ? fmaf(p1[r], C, bB) : -1e30f; }
    } else {
#pragma unroll
      for (int r = 0; r < 16; ++r) { p0[r] = -1e30f; p1[r] = -1e30f; }
    }
  }
  float pmax = p0[0];
#pragma unroll
  for (int r = 1; r < 16; ++r) pmax = fmaxf(pmax, p0[r]);
#pragma unroll
  for (int r = 0; r < 16; ++r) pmax = fmaxf(pmax, p1[r]);
  { auto rr = __builtin_amdgcn_permlane32_swap(__float_as_uint(pmax), __float_as_uint(pmax), false, false);
    pmax = fmaxf(__uint_as_float(rr[0]), __uint_as_float(rr[1])); }
  if (__builtin_expect(__all(pmax - m_reg <= THR * LOG2E), 1)) { mn = m_reg; alpha = 1.f; }
  else { mn = fmaxf(m_reg, pmax); alpha = __builtin_amdgcn_exp2f(m_reg - mn); m_reg = mn; }
#pragma unroll
  for (int r = 0; r < 16; ++r) p0[r] = __builtin_amdgcn_exp2f(p0[r] - mn);
#pragma unroll
  for (int r = 0; r < 16; ++r) p1[r] = p1[r] - mn;
}
__device__ __forceinline__ void finishSM(f32x16& p0, f32x16& p1, float alpha, float& l_reg, bf16x8& pa0, bf16x8& pa1, bf16x8& pa2, bf16x8& pa3) {
#pragma unroll
  for (int r = 0; r < 16; ++r) p1[r] = __builtin_amdgcn_exp2f(p1[r]);
  float ps = 0;
#pragma unroll
  for (int r = 0; r < 16; ++r) ps += p0[r];
#pragma unroll
  for (int r = 0; r < 16; ++r) ps += p1[r];
  { auto rr = __builtin_amdgcn_permlane32_swap(__float_as_uint(ps), __float_as_uint(ps), false, false);
    ps = __uint_as_float(rr[0]) + __uint_as_float(rr[1]); }
  l_reg = l_reg * alpha + ps;
#define PK4(P, BASE, OUT) do { unsigned a0 = cvtpk(P[BASE + 0], P[BASE + 1]), a1 = cvtpk(P[BASE + 2], P[BASE + 3]);   \
    unsigned b0 = cvtpk(P[BASE + 4], P[BASE + 5]), b1 = cvtpk(P[BASE + 6], P[BASE + 7]);                              \
    auto r0 = __builtin_amdgcn_permlane32_swap(a0, b0, false, false); auto r1 = __builtin_amdgcn_permlane32_swap(a1, b1, false, false); \
    u32x4 w = {r0[0], r1[0], r0[1], r1[1]}; OUT = *reinterpret_cast<bf16x8*>(&w); } while (0)
  PK4(p0, 0, pa0); PK4(p0, 8, pa1); PK4(p1, 0, pa2); PK4(p1, 8, pa3);
#undef PK4
}
__device__ __forceinline__ void qkt(f32x16& p0, f32x16& p1, const bf16_t* Ks, const bf16x8* qr, int r32, int hi) {
  p0 = f32x16{}; p1 = f32x16{};
#pragma unroll
  for (int d0 = 0; d0 < 8; ++d0) { int cb = (d0 * 16 + hi * 8) * 2;
    bf16x8 b0 = *reinterpret_cast<const bf16x8*>((const char*)Ks + KSWZ(r32, cb));
    bf16x8 b1 = *reinterpret_cast<const bf16x8*>((const char*)Ks + KSWZ(32 + r32, cb));
    p0 = __builtin_amdgcn_mfma_f32_32x32x16_bf16(b0, qr[d0], p0, 0, 0, 0);
    p1 = __builtin_amdgcn_mfma_f32_32x32x16_bf16(b1, qr[d0], p1, 0, 0, 0); }
}
__device__ __forceinline__ int v_st(int k, int c) { const int kk = (k & ~0xC) | ((k & 4) << 1) | ((k & 8) >> 1); return ((kk >> 3) * 4 + (c >> 5)) * 512 + ((kk & 7) * 32 + (c & 31)) * 2; }
__device__ __forceinline__ int v_rd_base(int lane) { return ((lane & 3) << 3) | (((lane >> 2) & 3) << 6) | (((lane >> 4) & 1) << 5) | (((lane >> 5) & 1) << 8); }
constexpr int v_rd_off(int d0, int ks, int half) { return d0 * 512 + ks * 4096 + half * 2048; }
template <int OFF> __device__ __forceinline__ s16x4 tr_read(int vb) {
  s16x4 r; asm volatile("ds_read_b64_tr_b16 %0, %1 offset:%2" : "=&v"(r) : "v"(vb), "i"(OFF) : "memory"); return r;
}
template <int D0> __device__ __forceinline__ void pv_one(f32x16& od, int vb, bf16x8 pa0, bf16x8 pa1, bf16x8 pa2, bf16x8 pa3) {
  const s16x4 l0 = tr_read<v_rd_off(D0, 0, 0)>(vb), h0 = tr_read<v_rd_off(D0, 0, 1)>(vb), l1 = tr_read<v_rd_off(D0, 1, 0)>(vb), h1 = tr_read<v_rd_off(D0, 1, 1)>(vb);
  const s16x4 l2 = tr_read<v_rd_off(D0, 2, 0)>(vb), h2 = tr_read<v_rd_off(D0, 2, 1)>(vb), l3 = tr_read<v_rd_off(D0, 3, 0)>(vb), h3 = tr_read<v_rd_off(D0, 3, 1)>(vb);
  asm volatile("s_waitcnt lgkmcnt(0)" ::: "memory"); SBAR();
#define PK(L, H) (bf16x8){L[0], L[1], L[2], L[3], H[0], H[1], H[2], H[3]}
  od = __builtin_amdgcn_mfma_f32_32x32x16_bf16(pa0, PK(l0, h0), od, 0, 0, 0);
  od = __builtin_amdgcn_mfma_f32_32x32x16_bf16(pa1, PK(l1, h1), od, 0, 0, 0);
  od = __builtin_amdgcn_mfma_f32_32x32x16_bf16(pa2, PK(l2, h2), od, 0, 0, 0);
  od = __builtin_amdgcn_mfma_f32_32x32x16_bf16(pa3, PK(l3, h3), od, 0, 0, 0);
#undef PK
}
__device__ __forceinline__ void pv_d0(f32x16* o, int vb, bf16x8 pa0, bf16x8 pa1, bf16x8 pa2, bf16x8 pa3) {
  pv_one<0>(o[0], vb, pa0, pa1, pa2, pa3); pv_one<1>(o[1], vb, pa0, pa1, pa2, pa3); pv_one<2>(o[2], vb, pa0, pa1, pa2, pa3); pv_one<3>(o[3], vb, pa0, pa1, pa2, pa3);
}

template <int LDQ, int LDO, bool NA, int SDEPTH>
__device__ __forceinline__ void attn_body(const bf16_t* __restrict__ Qb, const bf16_t* __restrict__ Kh, const bf16_t* __restrict__ Vh, bf16_t* __restrict__ Ob, int NT, const int LDK, char* lds, const NaInfo& na) {
  int tid = threadIdx.x; asm volatile("" : "+v"(tid));
  const int wid = tid >> 6, lane = tid & 63, r32 = lane & 31, hi = lane >> 5;
  bf16_t* V_lds = (bf16_t*)lds; bf16_t* K_lds = (bf16_t*)(lds + 2 * SHM_V);
  float* ws = (float*)(lds + 2 * SHM_V + 2 * SHM_K) + wid * 64; float* li_l = ws; float* al_l = ws + 32;
  float m_reg = -1e30f, l_reg = 0; f32x16 o[4] = {}; bf16x8 qr[8];
  const bf16_t* Qw = Qb + (long)(wid * QBLK + r32) * LDQ + hi * 8;
#pragma unroll
  for (int d0 = 0; d0 < 8; ++d0) qr[d0] = *reinterpret_cast<const bf16x8*>(Qw + d0 * 16);
  const int sr = tid >> 4, sc = (tid & 15) * 8, vst0 = v_st(sr, sc), vst1 = v_st(32 + sr, sc);
  const int vb0 = (int)(uintptr_t)V_lds + v_rd_base(lane);
  const int koff = NA ? na.rlo * 64 : 0;
  struct { bf16x8 vs0, vs1, ks0, ks1; } sr_[SDEPTH];
#define KROW(t) ((t) * KVBLK + ((NA && (t) >= 4) ? koff : 0))
#define SLOAD(i, t) do { const long _k0 = KROW(t); sr_[i].vs0 = *reinterpret_cast<const bf16x8*>(&Vh[(_k0 + sr) * LDK + sc]); sr_[i].vs1 = *reinterpret_cast<const bf16x8*>(&Vh[(_k0 + 32 + sr) * LDK + sc]); \
    sr_[i].ks0 = *reinterpret_cast<const bf16x8*>(&Kh[(_k0 + sr) * LDK + sc]); sr_[i].ks1 = *reinterpret_cast<const bf16x8*>(&Kh[(_k0 + 32 + sr) * LDK + sc]); } while (0)
#define SWRITE(b, i) do { *(bf16x8*)((char*)V_lds + (b) * SHM_V + vst0) = sr_[i].vs0;          \
    *(bf16x8*)((char*)V_lds + (b) * SHM_V + vst1) = sr_[i].vs1; int kc = sc * 2;               \
    *(bf16x8*)((char*)K_lds + (b) * SHM_K + KSWZ(sr, kc)) = sr_[i].ks0;                       \
    *(bf16x8*)((char*)K_lds + (b) * SHM_K + KSWZ(32 + sr, kc)) = sr_[i].ks1; } while (0)
#define SWAIT() do { if constexpr (SDEPTH == 2) asm volatile("s_waitcnt vmcnt(4)" ::: "memory"); else asm volatile("s_waitcnt vmcnt(0)" ::: "memory"); } while (0)
#define RESC(a) do { if (__any((a) < 1.f)) { if (hi == 0) al_l[r32] = (a); asm volatile("s_waitcnt lgkmcnt(0)" ::: "memory"); \
    _Pragma("unroll") for (int d = 0; d < 4; ++d) _Pragma("unroll") for (int r = 0; r < 16; ++r) o[d][r] *= al_l[crow(r, hi)]; } } while (0)
#define PSM(P0, P1, MN, AL, T) do { if constexpr (NA) partialSM_na(P0, P1, m_reg, MN, AL, (T), na, hi); else partialSM(P0, P1, m_reg, MN, AL); } while (0)
  f32x16 pA0, pA1, pB0, pB1; float mnA, mnB, alA, alB; bf16x8 pa0, pa1, pa2, pa3;
  constexpr int SE = 0, SO = SDEPTH - 1;
  asm volatile("" : "+s"(NT));
  SLOAD(SE, 0); asm volatile("s_waitcnt vmcnt(0)" ::: "memory"); SWRITE(0, SE); __syncthreads();
  qkt(pA0, pA1, K_lds, qr, r32, hi); PSM(pA0, pA1, mnA, alA, 0);
  SLOAD(SO, 1); if constexpr (SDEPTH == 2) { if (2 < NT) SLOAD(SE, 2); }
  SWAIT(); SWRITE(1, SO); __syncthreads();
  for (int j = 1; j + 1 < NT; j += 2) {
    SBAR(); qkt(pB0, pB1, (bf16_t*)((char*)K_lds + SHM_K), qr, r32, hi);
    finishSM(pA0, pA1, alA, l_reg, pa0, pa1, pa2, pa3); SBAR();
    SLOAD(SO, j + SDEPTH); SBAR();
    pv_d0(o, vb0, pa0, pa1, pa2, pa3); PSM(pB0, pB1, mnB, alB, j);
    __syncthreads(); SWAIT(); SWRITE(0, SE);
    RESC(alB); __syncthreads();
    SBAR(); qkt(pA0, pA1, K_lds, qr, r32, hi);
    finishSM(pB0, pB1, alB, l_reg, pa0, pa1, pa2, pa3); SBAR();
    if (SDEPTH == 1 || j + 3 < NT) SLOAD(SE, j + 1 + SDEPTH); SBAR();
    pv_d0(o, vb0 + (int)SHM_V, pa0, pa1, pa2, pa3); PSM(pA0, pA1, mnA, alA, j + 1);
    __syncthreads(); SWAIT(); SWRITE(1, SO);
    RESC(alA); __syncthreads();
  }
  SBAR(); qkt(pB0, pB1, (bf16_t*)((char*)K_lds + SHM_K), qr, r32, hi);
  finishSM(pA0, pA1, alA, l_reg, pa0, pa1, pa2, pa3); SBAR();
  pv_d0(o, vb0, pa0, pa1, pa2, pa3); PSM(pB0, pB1, mnB, alB, NT - 1);
  __syncthreads(); RESC(alB);
  finishSM(pB0, pB1, alB, l_reg, pa0, pa1, pa2, pa3); SBAR();
  pv_d0(o, vb0 + (int)SHM_V, pa0, pa1, pa2, pa3);
  if (hi == 0) li_l[r32] = l_reg; asm volatile("s_waitcnt lgkmcnt(0)" ::: "memory");
  float rli[16];
#pragma unroll
  for (int r = 0; r < 16; ++r) rli[r] = __builtin_amdgcn_rcpf(li_l[crow(r, hi)]);
  bf16_t* Ow = Ob + (long)(wid * QBLK) * LDO;
#pragma unroll
  for (int r = 0; r < 16; ++r) { int orow = crow(r, hi);
#pragma unroll
    for (int d0 = 0; d0 < 4; ++d0) { const float v = o[d0][r] * rli[r]; Ow[(long)orow * LDO + d0 * 32 + r32] = (bf16_t)(cvtpk(v, v) & 0xffffu); } }
  __syncthreads();
#undef KROW
#undef SLOAD
#undef SWRITE
#undef SWAIT
#undef RESC
#undef PSM
}
#undef KSWZ
}

template <class T> __device__ __forceinline__ T* uni_ptr(T* p) { const unsigned long long v = (unsigned long long)p; const unsigned lo = __builtin_amdgcn_readfirstlane((unsigned)v), hi = __builtin_amdgcn_readfirstlane((unsigned)(v >> 32)); return (T*)(GAS T*)(((unsigned long long)hi << 32) | lo); }
__device__ __forceinline__ void attn_dense_call(const bf16_t* q, const bf16_t* k, const bf16_t* v, bf16_t* o, int nt, int ldk) {
    extern __shared__ __attribute__((aligned(16))) unsigned char lds_raw_[];
    q = uni_ptr(q); k = uni_ptr(k); v = uni_ptr(v); o = uni_ptr(o); nt = __builtin_amdgcn_readfirstlane(nt); ldk = __builtin_amdgcn_readfirstlane(ldk);
    att::NaInfo na0; na0.rpb = (const LAS float*)(LAS unsigned char*)lds_raw_; na0.qrow = 0; na0.rs = 0; na0.c = 0; na0.cs = 0; na0.rlo = 0;
    att::attn_body<512, DM, false, 2>(q, k, v, o, nt, ldk, (char*)lds_raw_, na0);
}
__device__ __forceinline__ void attn_na_call(const bf16_t* q, const bf16_t* k, const bf16_t* v, bf16_t* o, int nt, int r0, int rlo) {
    extern __shared__ __attribute__((aligned(16))) unsigned char lds_raw_[];
    q = uni_ptr(q); k = uni_ptr(k); v = uni_ptr(v); o = uni_ptr(o); nt = __builtin_amdgcn_readfirstlane(nt); r0 = __builtin_amdgcn_readfirstlane(r0); rlo = __builtin_amdgcn_readfirstlane(rlo);
    int tidn = threadIdx.x; asm volatile("" : "+v"(tidn)); const int wave = tidn >> 6, lane = tidn & 63;
    att::NaInfo na; na.rpb = (const LAS float*)((LAS unsigned char*)lds_raw_ + RPB_OFF); na.qrow = r0 + (wave >> 1); na.rs = min(max(na.qrow - 4, 0), 56); na.c = (wave & 1) * 32 + (lane & 31); na.cs = min(max(na.c - 8, 0), 48); na.rlo = rlo;
    att::attn_body<512, DM, true, 1>(q, k, v, o, nt, 512, (char*)lds_raw_, na);
}

__device__ __forceinline__ void cdft_to_slab(LAS unsigned char* lds, const bf16_t* __restrict__ Pv, size_t vstride, const bf16_t* __restrict__ MBl, int mpitch) {
  int tid = threadIdx.x; asm volatile("" : "+v"(tid));
  const int wid = tid >> 6, lane = tid & 63, r32 = lane & 31, hi = lane >> 5, h = wid >> 1, cs = wid & 1;
  const bf16_t* ap = Pv + (size_t)r32 * vstride + h * 128 + hi * 8;
  const bf16_t* bp = MBl + (size_t)(h * 256 + cs * 128 + r32) * mpitch + hi * 8;
  LAS bf16_t* sl = (LAS bf16_t*)lds + (64 * cs) * 512 + h * 128 + r32;
  bf16x8 a[2][8];
#pragma unroll
  for (int i = 0; i < 2; ++i)
#pragma unroll
    for (int k = 0; k < 8; ++k) a[i][k] = *reinterpret_cast<const bf16x8*>(ap + (size_t)(32 * i) * vstride + 16 * k);
#pragma unroll 1
  for (int i = 0; i < 2; ++i) {
    f32x16 acc[4];
#pragma unroll
    for (int j = 0; j < 4; ++j) { acc[j] = f32x16{}; asm volatile("" : "+v"(acc[j])); }
#pragma unroll
    for (int k = 0; k < 8; ++k) {
      bf16x8 bq[4];
#pragma unroll
      for (int j = 0; j < 4; ++j) bq[j] = *reinterpret_cast<const bf16x8*>(bp + (size_t)(32 * j) * mpitch + 16 * k);
      const bf16x8 av = i ? a[1][k] : a[0][k];
#pragma unroll
      for (int j = 0; j < 4; ++j) acc[j] = __builtin_amdgcn_mfma_f32_32x32x16_bf16(av, bq[j], acc[j], 0, 0, 0);
    }
#pragma unroll
    for (int j = 0; j < 4; ++j) asm volatile("s_nop 15\n\ts_nop 15" : "+v"(acc[j]));
#pragma unroll
    for (int r = 0; r < 16; ++r) { const int row = 32 * i + att::crow(r, hi);
#pragma unroll
      for (int j = 0; j < 4; ++j) { const float v = acc[j][r]; sl[row * 512 + 32 * j] = (bf16_t)(cvt_pk_bf16(v, v) & 0xffffu); } }
  }
}
template <int NPASS, bool STAGE = true, class RowPtr, class Epi>
__device__ __forceinline__ void fft_stage(LAS unsigned char* lds, const bf16_t* __restrict__ Mmat, const RowPtr& rowp, const Epi& epi) {
  int tid = threadIdx.x; asm volatile("" : "+v"(tid));
  const int wid = tid >> 6, lane = tid & 63, r32 = lane & 31, hi = lane >> 5;
  if constexpr (STAGE) {
    const int sr = tid >> 6, sc = (tid & 63) * 8;
    bf16x8 st[16];
#pragma unroll
    for (int i = 0; i < 16; ++i) st[i] = *reinterpret_cast<const bf16x8*>(rowp(sr + 8 * i) + sc);
#pragma unroll
    for (int i = 0; i < 16; ++i) *(LAS bf16x8*)(lds + ((sr + 8 * i) * 512 + sc) * 2) = st[i];
  }
  __syncthreads();
  const LAS bf16_t* tb = (const LAS bf16_t*)lds + (8 * hi) * 512 + 64 * wid + r32;
  const bf16_t* Ml = Mmat + r32 * 128 + hi * 8;
#pragma unroll
  for (int p = 0; p < NPASS; ++p) {
    f32x16 acc[2][2];
#pragma unroll
    for (int j = 0; j < 2; ++j) { acc[j][0] = f32x16{}; acc[j][1] = f32x16{}; asm volatile("" : "+v"(acc[j][0]), "+v"(acc[j][1])); }
#pragma unroll 2
    for (int k = 0; k < 8; ++k) {
      bf16x8 b0, b1;
#pragma unroll
      for (int j = 0; j < 8; ++j) { b0[j] = (short)tb[(16 * k + j) * 512]; b1[j] = (short)tb[(16 * k + j) * 512 + 32]; }
      const bf16x8 a0 = *reinterpret_cast<const bf16x8*>(Ml + p * 32 * 128 + k * 16), a1 = *reinterpret_cast<const bf16x8*>(Ml + (p + NPASS) * 32 * 128 + k * 16);
      acc[0][0] = __builtin_amdgcn_mfma_f32_32x32x16_bf16(a0, b0, acc[0][0], 0, 0, 0); acc[0][1] = __builtin_amdgcn_mfma_f32_32x32x16_bf16(a0, b1, acc[0][1], 0, 0, 0);
      acc[1][0] = __builtin_amdgcn_mfma_f32_32x32x16_bf16(a1, b0, acc[1][0], 0, 0, 0); acc[1][1] = __builtin_amdgcn_mfma_f32_32x32x16_bf16(a1, b1, acc[1][1], 0, 0, 0);
    }
#pragma unroll
    for (int j = 0; j < 2; ++j) asm volatile("s_nop 15\n\ts_nop 15" : "+v"(acc[j][0]), "+v"(acc[j][1]));
    epi(p, acc, wid, r32, hi);
  }
  __syncthreads();
}

#define XB_TMO      128
#define XB_XCNT(j)  (256  + 64 * (j))
#define XB_XSUB(j)  (1280 + 64 * (j))
#define XB_XGEN(j)  (2304 + 64 * (j))
#define XB_TOP      3328
#define XB_TOPGEN   3392
#define XCD_BAR_WORDS 3456
#define XB_SPIN_CAP (1u << 18)
__device__ __forceinline__ unsigned xb_ld(unsigned* p)              { return __hip_atomic_load(p, __ATOMIC_RELAXED, __HIP_MEMORY_SCOPE_AGENT); }
__device__ __forceinline__ unsigned xb_add(unsigned* p, unsigned v) { return __hip_atomic_fetch_add(p, v, __ATOMIC_RELAXED, __HIP_MEMORY_SCOPE_AGENT); }
__device__ __forceinline__ unsigned xb_xcc_id() { return (unsigned)__builtin_amdgcn_s_getreg((3 << 11) | 20) & 0xFu; }
#define XB_SPIN(cond, bar) do { unsigned _sp = 0; while (cond) { __builtin_amdgcn_s_sleep(1); \
    if ((++_sp & 255u) == 0u) { if (xb_ld(&(bar)[XB_TMO])) break; if (_sp > XB_SPIN_CAP) { atomicAdd(&(bar)[XB_TMO], 1u); break; } } } } while (0)
struct XcdBarrier { unsigned* bar; unsigned x; volatile LAS unsigned* st; };
__device__ __forceinline__ XcdBarrier xcd_barrier_post(unsigned* bar, volatile LAS unsigned* st) {
    XcdBarrier b; b.bar = bar; b.x = xb_xcc_id(); b.st = st;
    if (threadIdx.x == 0) (void)xb_add(&bar[XB_XCNT(b.x)], 1u);
    return b;
}
__device__ __forceinline__ void xcd_barrier_complete(unsigned* bar, unsigned x, unsigned& nloc, unsigned& nx) {
    const unsigned G = gridDim.x * gridDim.y * gridDim.z;
    unsigned sum, cnt, mine, sp = 0u;
    for (;;) {
        sum = 0u; cnt = 0u; mine = 0u;
#pragma unroll 1
        for (unsigned j = 0; j < 16; ++j) { const unsigned c = xb_ld(&bar[XB_XCNT(j)]); sum += c; cnt += (c > 0u) ? 1u : 0u; mine = (j == x) ? c : mine; }
        if (sum == G) break;
        __builtin_amdgcn_s_sleep(1);
        if ((++sp & 255u) == 0u) { if (xb_ld(&bar[XB_TMO])) break; if (sp > XB_SPIN_CAP) { atomicAdd(&bar[XB_TMO], 1u); break; } }
    }
    nloc = mine > 0u ? mine : 1u; nx = cnt > 0u ? cnt : 1u;
}
__device__ __forceinline__ void xcd_barrier(const XcdBarrier& b) {
    asm volatile("s_waitcnt vmcnt(0)" ::: "memory");
    __syncthreads();
    if (threadIdx.x == 0) {
        unsigned* bar = b.bar;
        __builtin_amdgcn_s_waitcnt(0);
        unsigned nloc = b.st[0], nx = b.st[1];
        if (nloc == 0u) { xcd_barrier_complete(bar, b.x, nloc, nx); b.st[0] = nloc; b.st[1] = nx; }
        const unsigned old = xb_add(&bar[XB_XSUB(b.x)], 1u);
        const unsigned gen = old / nloc;
        if (old + 1u == (gen + 1u) * nloc) {
            __builtin_amdgcn_fence(__ATOMIC_RELEASE, "agent");
            asm volatile("s_waitcnt vmcnt(0)" ::: "memory");
            const unsigned og = xb_add(&bar[XB_TOP], 1u);
            const unsigned tg = og / nx;
            if (og + 1u == (tg + 1u) * nx) xb_add(&bar[XB_TOPGEN], 1u);
            else XB_SPIN(xb_ld(&bar[XB_TOPGEN]) == tg, bar);
            __builtin_amdgcn_fence(__ATOMIC_ACQUIRE, "agent");
            xb_add(&bar[XB_XGEN(b.x)], 1u);
            asm volatile("s_waitcnt vmcnt(0)" ::: "memory");
        } else {
            XB_SPIN(xb_ld(&bar[XB_XGEN(b.x)]) == gen, bar);
            __builtin_amdgcn_fence(__ATOMIC_ACQUIRE, "agent");
            asm volatile("s_waitcnt vmcnt(0)" ::: "memory");
        }
    }
    __syncthreads();
}

struct Args { const float* in[24]; float* out; unsigned char* ws; int ph_lo, ph_hi; };
enum { I_X = 0, I_C, I_CTX, I_CCTX, I_N1G, I_N2G, I_WADA, I_BADA, I_WIN, I_WOUT, I_WFOUR, I_CONVW, I_RPB, I_NAQG, I_NAKG, I_GQG, I_GKG, I_FW1, I_FW3, I_FW2, I_ROUTER, I_MW1, I_MW3, I_MW2 };

__device__ __forceinline__ void transpose_tile(const float* __restrict__ src, int ldw, bf16_t* __restrict__ dst, int ldb, LAS unsigned* scr) {
    const int tid = threadIdx.x;
    const int n4 = (tid & 31) * 4, kq = tid >> 5;
    f32x4 a[4], b[4];
#pragma unroll
    for (int i = 0; i < 4; ++i) { const int kp = kq + 16 * i; a[i] = *(const f32x4*)(src + (size_t)(2 * kp) * ldw + n4); b[i] = *(const f32x4*)(src + (size_t)(2 * kp + 1) * ldw + n4); }
#pragma unroll
    for (int i = 0; i < 4; ++i) { const int kp = kq + 16 * i;
#pragma unroll
        for (int j = 0; j < 4; ++j) scr[(n4 + j) * 65 + kp] = cvt_pk_bf16(a[i][j], b[i][j]); }
    __syncthreads();
    const int n = tid >> 2, q = tid & 3;
#pragma unroll
    for (int i = 0; i < 4; ++i) { u32x4 w; const LAS unsigned* s = scr + n * 65 + q * 16 + i * 4; w.x = s[0]; w.y = s[1]; w.z = s[2]; w.w = s[3];
        *(u32x4*)(dst + (size_t)n * ldb + (q * 16 + i * 4) * 2) = w; }
    __syncthreads();
}

struct T16Regs { f32x4 a[4], b[4]; };
__device__ __forceinline__ void t16_load(const float* __restrict__ src, int ldw, T16Regs& t) {
    const int tid = threadIdx.x; const int n4 = (tid & 31) * 4, kq = tid >> 5;
#pragma unroll
    for (int i = 0; i < 4; ++i) { const int kp = kq + 16 * i; t.a[i] = __builtin_nontemporal_load((const f32x4*)(src + (size_t)(2 * kp) * ldw + n4)); t.b[i] = __builtin_nontemporal_load((const f32x4*)(src + (size_t)(2 * kp + 1) * ldw + n4)); }
}
__device__ __forceinline__ void t16_store(const T16Regs& t, bf16_t* __restrict__ dst, int ldb, LAS unsigned* scr) {
    const int tid = threadIdx.x; const int n4 = (tid & 31) * 4, kq = tid >> 5;
#pragma unroll
    for (int i = 0; i < 4; ++i) { const int kp = kq + 16 * i;
#pragma unroll
        for (int j = 0; j < 4; ++j) scr[(n4 + j) * 65 + kp] = cvt_pk_bf16(t.a[i][j], t.b[i][j]); }
    asm volatile("s_waitcnt lgkmcnt(0)" ::: "memory"); __builtin_amdgcn_s_barrier(); asm volatile("" ::: "memory");
    const int n = tid >> 2, q = tid & 3;
#pragma unroll
    for (int i = 0; i < 4; ++i) { u32x4 w; const LAS unsigned* s = scr + n * 65 + q * 16 + i * 4; w.x = s[0]; w.y = s[1]; w.z = s[2]; w.w = s[3];
        *(u32x4*)(dst + (size_t)n * ldb + (q * 16 + i * 4) * 2) = w; }
    asm volatile("s_waitcnt lgkmcnt(0)" ::: "memory"); __builtin_amdgcn_s_barrier(); asm volatile("" ::: "memory");
}
struct T8Regs { f32x4 r[2][4]; };
__device__ __forceinline__ void t8_load(const float* __restrict__ src, int ldw, T8Regs& t, int tid = threadIdx.x) {
    const int n4 = (tid & 31) * 4, kq = tid >> 5;
#pragma unroll
    for (int i = 0; i < 2; ++i)
#pragma unroll
        for (int q = 0; q < 4; ++q) t.r[i][q] = __builtin_nontemporal_load((const f32x4*)(src + (size_t)(4 * (kq + 16 * i) + q) * ldw + n4));
}
__device__ __forceinline__ void t8_store(const T8Regs& t, unsigned char* __restrict__ dst, int ldb, LAS unsigned* scr, float sc, int tid = threadIdx.x) {
    const int n4 = (tid & 31) * 4, kq = tid >> 5;
#pragma unroll
    for (int i = 0; i < 2; ++i)
#pragma unroll
        for (int j = 0; j < 4; ++j) scr[(n4 + j) * 33 + kq + 16 * i] = pk4_fp8(t.r[i][0][j] * sc, t.r[i][1][j] * sc, t.r[i][2][j] * sc, t.r[i][3][j] * sc);
    asm volatile("s_waitcnt lgkmcnt(0)" ::: "memory"); __builtin_amdgcn_s_barrier(); asm volatile("" ::: "memory");
    const int n = tid >> 2, q = tid & 3;
#pragma unroll
    for (int i = 0; i < 2; ++i) { u32x4 w; const LAS unsigned* s = scr + n * 33 + q * 8 + i * 4; w.x = s[0]; w.y = s[1]; w.z = s[2]; w.w = s[3];
        *(u32x4*)(dst + (size_t)n * ldb + q * 32 + i * 16) = w; }
    asm volatile("s_waitcnt lgkmcnt(0)" ::: "memory"); __builtin_amdgcn_s_barrier(); asm volatile("" ::: "memory");
}

__device__ __forceinline__ const unsigned char* ldptr(volatile LAS unsigned long long* T, int i) {
    const unsigned long long v = T[i]; const unsigned lo = __builtin_amdgcn_readfirstlane((unsigned)v), hi = __builtin_amdgcn_readfirstlane((unsigned)(v >> 32));
    return (const unsigned char*)(const GAS unsigned char*)(((unsigned long long)hi << 32) | lo);
}
constexpr int NT_ME = 16 * 56, NT_MUP = 2 * 8 * NT_ME, NT_MDN = 8 * NT_ME, NT_M = NT_MUP + NT_MDN;
constexpr int CW_QUP = 8192 + 1024, CW_QDN = 8192 + 1088;
__device__ __forceinline__ void moe_tile_decode(int t, volatile LAS unsigned long long* PTRS, const float*& src, int& ldw, unsigned char*& dst, int& ldb) {
    unsigned char* wsb = (unsigned char*)ldptr(PTRS, 25);
    if (t < NT_MUP) { const int which = t / (8 * NT_ME), q2 = t % (8 * NT_ME), e = q2 / NT_ME, r = q2 % NT_ME, kb = r / 56, nb = r % 56;
        src = (const float*)ldptr(PTRS, which ? I_MW3 : I_MW1) + (size_t)e * DM * DFE + (size_t)(kb * 128) * DFE + nb * 128; ldw = DFE; dst = wsb + WS_MUP + (size_t)e * 2 * DFE * DM + (size_t)(nb * 256 + which * 128) * DM + kb * 128; ldb = DM; }
    else { const int q = t - NT_MUP, e = q / NT_ME, r = q % NT_ME, kb = r / 16, nb = r % 16;
        src = (const float*)ldptr(PTRS, I_MW2) + (size_t)e * DFE * DM + (size_t)(kb * 128) * DM + nb * 128; ldw = DM; dst = wsb + WS_MDN + (size_t)e * DM * DFE + (size_t)(nb * 128) * DFE + kb * 128; ldb = DFE; }
}
__device__ __forceinline__ void moe_convert(volatile LAS unsigned long long* PTRS, LAS unsigned* scr, int t, int tend, int step) {
    if (t >= tend) return;
    const int tlast = t + ((tend - 1 - t) / step) * step;
    int tid = threadIdx.x; asm volatile("" : "+v"(tid));
    T8Regs t0, t1, t2; const float* src = nullptr; int ldw = 0; unsigned char *d0 = nullptr, *d1 = nullptr, *d2 = nullptr; int b0 = 0, b1 = 0, b2 = 0;
    moe_tile_decode(t, PTRS, src, ldw, d0, b0); t8_load(src, ldw, t0, tid);
    moe_tile_decode(min(t + step, tlast), PTRS, src, ldw, d1, b1); t8_load(src, ldw, t1, tid);
#define MT8_STEP(TL, DL, BL, TS, DS, BS) { if (t >= tend) break; moe_tile_decode(min(t + 2 * step, tlast), PTRS, src, ldw, DL, BL); t8_load(src, ldw, TL, tid); t8_store(TS, DS, BS, scr, F8_SW, tid); t += step; }
    for (;;) {
        MT8_STEP(t2, d2, b2, t0, d0, b0)
        MT8_STEP(t0, d0, b0, t1, d1, b1)
        MT8_STEP(t1, d1, b1, t2, d2, b2)
    }
#undef MT8_STEP
    asm volatile("s_waitcnt vmcnt(0)" ::: "memory");
}
template <unsigned PM, unsigned MM>
__global__ void __launch_bounds__(512, 2) mk_fwd(Args args) {
    extern __shared__ __attribute__((aligned(16))) unsigned char lds_raw[];
    LAS unsigned char* lds = (LAS unsigned char*)lds_raw;
    volatile LAS unsigned* MISC = (volatile LAS unsigned*)(lds + MISC_OFF);
    const int tid = threadIdx.x, lane = tid & 63, wave = __builtin_amdgcn_readfirstlane(tid >> 6);
    const int G = gridDim.x, wg = blockIdx.x;
    const int NGW = G * 8;
    unsigned* ctl = (unsigned*)(args.ws + WS_CTL);
    if (tid < 64) MISC[tid] = 0u;
    __syncthreads();
    XcdBarrier bar; bar.bar = ctl + CW_BAR; bar.x = 0; bar.st = MISC;
    const bool one_launch = (args.ph_hi - args.ph_lo) > 1;
    if (one_launch) bar = xcd_barrier_post(ctl + CW_BAR, MISC);
    const int lo = args.ph_lo, hi = args.ph_hi;
#define IN(k) (lo <= (k) && (k) < hi)
#define SEAM(k) do { if (IN(k) && IN((k) + 1)) xcd_barrier(bar); } while (0)

    volatile LAS unsigned long long* PTRS = (volatile LAS unsigned long long*)(lds + MISC_OFF + 512);
    if (tid < 24) PTRS[tid] = (unsigned long long)args.in[tid];
    if (tid == 24) PTRS[24] = (unsigned long long)args.out;
    if (tid == 25) PTRS[25] = (unsigned long long)args.ws;
    __syncthreads();
#define PHASE_IDS() int tid = threadIdx.x; asm volatile("" : "+v"(tid)); const int lane = tid & 63, wave = __builtin_amdgcn_readfirstlane(tid >> 6), gw = wg * 8 + wave; (void)lane; (void)gw
#define MOE_GRAB(budget) do { __syncthreads(); if (threadIdx.x == 0) { int t_ = (int)atomicAdd(ctl + CW_QUP, (unsigned)(budget)); if (t_ >= NT_MUP) t_ = NT_MUP + (int)atomicAdd(ctl + CW_QDN, (unsigned)(budget)); MISC[40] = (unsigned)t_; } __syncthreads(); \
    const int t0_ = __builtin_amdgcn_readfirstlane((int)MISC[40]); const int te_ = min(t0_ + (budget), t0_ < NT_MUP ? NT_MUP : NT_M); moe_convert(PTRS, (LAS unsigned*)lds, t0_, te_, 1); } while (0)
#define MOE_DRAIN(cw, base, count) do { __syncthreads(); if (threadIdx.x == 0) MISC[40] = __hip_atomic_load(ctl + (cw), RLX_AGENT); __syncthreads(); \
    const int s0_ = min(__builtin_amdgcn_readfirstlane((int)MISC[40]), (count)); moe_convert(PTRS, (LAS unsigned*)lds, (base) + s0_ + wg, (base) + (count), G); } while (0)
#define DEFICIT(nwg_) ((((nwg_) + G - 1) / G) - (wg < (nwg_) ? ((nwg_) - wg + G - 1) / G : 0))
#define INP(i) ((const float*)ldptr(PTRS, (i)))
#define OUTP() ((float*)ldptr(PTRS, 24))
#define WSB() ((unsigned char*)ldptr(PTRS, 25))

    DUP(10) if (EN(10) && IN(0)) {
            PHASE_IDS();
        constexpr int TR_WIN = 16 * 36, TR_WOUT = 16 * 16, TR_F13 = 16 * 44, TR_F2 = 44 * 16, TR_M13 = 16 * 56, TR_M2 = 56 * 16;
        constexpr int O_WIN = 0, O_WOUT = O_WIN + 2 * TR_WIN, O_F1 = O_WOUT + 2 * TR_WOUT, O_F3 = O_F1 + TR_F13, O_F2 = O_F3 + TR_F13, O_M1 = O_F2 + TR_F2, O_M3 = O_M1 + 8 * TR_M13, O_M2 = O_M3 + 8 * TR_M13, NTR = O_M2 + 8 * TR_M2;
        constexpr int O_T = NTR, N_T = 4096 / 8, O_TC = O_T + N_T, N_TC = 256 / 8, O_FOLD = O_TC + N_TC, N_FOLD = 2 * 4 * 2 * 32, O_MOD = O_FOLD + N_FOLD, N_MOD = 2 * 96, O_ROPE = O_MOD + N_MOD, NITEMS = O_ROPE + 1;
        LAS unsigned* scr = (LAS unsigned*)lds;
        LAS float* cosT = (LAS float*)(lds + 40960);
        LAS float* condL = (LAS float*)(lds + 57344);
        bool have_cond = false;
        unsigned char* wsb = WSB();
        float* mod = (float*)(wsb + WS_MOD); float* ropeT = (float*)(wsb + WS_ROPE); bf16_t* Tc = (bf16_t*)(wsb + WS_TC);
        bf16_t* Win_t = (bf16_t*)(wsb + WS_WIN); bf16_t* Wout_t = (bf16_t*)(wsb + WS_WOUT);
#define T16_DECODE(it_, src_, ldw_, dst_, ldb_) do { \
            if ((it_) < O_WOUT) { const int l = (it_) / TR_WIN, r = (it_) % TR_WIN, kb = r / 36, nb = r % 36; \
                src_ = INP(I_WIN) + (size_t)l * DM * INW + (size_t)(kb * 128) * INW + nb * 128; ldw_ = INW; dst_ = Win_t + (size_t)l * NP * DM + (size_t)(nb * 128) * DM + kb * 128; ldb_ = DM; } \
            else { const int q = (it_) - O_WOUT, l = q / TR_WOUT, r = q % TR_WOUT, kb = r / 16, nb = r % 16; \
                src_ = INP(I_WOUT) + (size_t)l * DM * DM + (size_t)(kb * 128) * DM + nb * 128; ldw_ = DM; dst_ = Wout_t + (size_t)l * DM * DM + (size_t)(nb * 128) * DM + kb * 128; ldb_ = DM; } } while (0)
        SUBDUP(0) {
            int it = wg; T16Regs t0, t1, t2; const float* src = nullptr; int ldw = 0; bf16_t *d0 = nullptr, *d1 = nullptr, *d2 = nullptr; int b0 = 0, b1 = 0, b2 = 0;
            if (it < O_F1) { T16_DECODE(it, src, ldw, d0, b0); t16_load(src, ldw, t0); }
            { const int itn_ = min(it + G, O_F1 - 1); T16_DECODE(itn_, src, ldw, d1, b1); t16_load(src, ldw, t1); }
#define T16_STEP(TL, DL, BL, TS, DS, BS) { if (it >= O_F1) break; { const int itn_ = min(it + 2 * G, O_F1 - 1); T16_DECODE(itn_, src, ldw, DL, BL); t16_load(src, ldw, TL); } t16_store(TS, DS, BS, scr); it += G; }
            for (;;) {
                T16_STEP(t2, d2, b2, t0, d0, b0)
                T16_STEP(t0, d0, b0, t1, d1, b1)
                T16_STEP(t1, d1, b1, t2, d2, b2)
            }
#undef T16_STEP
            asm volatile("s_waitcnt vmcnt(0)" ::: "memory"); __syncthreads();
        }
#undef T16_DECODE
#define T8_DECODE(it_, src_, ldw_, dst_, ldb_) do { \
            if ((it_) < O_F2) { const int q = (it_) - O_F1, which = q / TR_F13, r = q % TR_F13, kb = r / 44, nb = r % 44; \
                src_ = INP(which ? I_FW3 : I_FW1) + (size_t)(kb * 128) * DFF + nb * 128; ldw_ = DFF; dst_ = wsb + WS_WUP + (size_t)(nb * 256 + which * 128) * DM + kb * 128; ldb_ = DM; } \
            else if ((it_) < O_M1) { const int r = (it_) - O_F2, kb = r / 16, nb = r % 16; \
                src_ = INP(I_FW2) + (size_t)(kb * 128) * DM + nb * 128; ldw_ = DM; dst_ = wsb + WS_WDN + (size_t)(nb * 128) * DFF + kb * 128; ldb_ = DFF; } \
            else if ((it_) < O_M2) { const int q = (it_) - O_M1, which = q / (8 * TR_M13), q2 = q % (8 * TR_M13), e = q2 / TR_M13, r = q2 % TR_M13, kb = r / 56, nb = r % 56; \
                src_ = INP(which ? I_MW3 : I_MW1) + (size_t)e * DM * DFE + (size_t)(kb * 128) * DFE + nb * 128; ldw_ = DFE; dst_ = wsb + WS_MUP + (size_t)e * 2 * DFE * DM + (size_t)(nb * 256 + which * 128) * DM + kb * 128; ldb_ = DM; } \
            else { const int q = (it_) - O_M2, e = q / TR_M2, r = q % TR_M2, kb = r / 16, nb = r % 16; \
                src_ = INP(I_MW2) + (size_t)e * DFE * DM + (size_t)(kb * 128) * DM + nb * 128; ldw_ = DM; dst_ = wsb + WS_MDN + (size_t)e * DM * DFE + (size_t)(nb * 128) * DFE + kb * 128; ldb_ = DFE; } } while (0)
        SUBDUP(1) {
            int it = O_F1 + wg; T8Regs t0, t1, t2; const float* src = nullptr; int ldw = 0; unsigned char *d0 = nullptr, *d1 = nullptr, *d2 = nullptr; int b0 = 0, b1 = 0, b2 = 0;
            if (it < O_M1) { T8_DECODE(it, src, ldw, d0, b0); t8_load(src, ldw, t0); }
            { const int itn_ = min(it + G, O_M1 - 1); T8_DECODE(itn_, src, ldw, d1, b1); t8_load(src, ldw, t1); }
#define T8_STEP(TL, DL, BL, TS, DS, BS) { if (it >= O_M1) break; { const int itn_ = min(it + 2 * G, O_M1 - 1); T8_DECODE(itn_, src, ldw, DL, BL); t8_load(src, ldw, TL); } t8_store(TS, DS, BS, scr, F8_SW); it += G; }
            for (;;) {
                T8_STEP(t2, d2, b2, t0, d0, b0)
                T8_STEP(t0, d0, b0, t1, d1, b1)
                T8_STEP(t1, d1, b1, t2, d2, b2)
            }
#undef T8_STEP
        }
#undef T8_DECODE
        {   const int nsl = G >= 128 ? 64 : 1, part = G >= 128 ? wg - 64 : (wg == G - 1 ? 0 : -1);
            if (part >= 0 && part < nsl) {
                auto ctab = [](int j) -> float { return cosf((float)j * (6.283185307179586f / 4096.0f)); };
                bf16_t* M1 = (bf16_t*)(wsb + WS_FFT); bf16_t* M2 = M1 + 128 * 128; float* TW = (float*)(wsb + WS_FFT + 49152);
                for (int sl = part; sl < 64; sl += nsl) {
                    if (tid < 256) { const int k = 4 * sl + (tid >> 6), c8 = (tid & 63) * 8; float v[8];
#pragma unroll
                        for (int q = 0; q < 8; ++q) { const int col = c8 + q, l = col & 255; const int idx = ((k * l) & 255) * 16; v[q] = (col < 256 ? ctab(idx) : -ctab((idx - 1024) & 4095)) * (1.0f / 16.0f); }
                        u32x4 w; w.x = cvt_pk_bf16(v[0], v[1]); w.y = cvt_pk_bf16(v[2], v[3]); w.z = cvt_pk_bf16(v[4], v[5]); w.w = cvt_pk_bf16(v[6], v[7]);
                        *(u32x4*)(Tc + (size_t)k * 512 + c8) = w; }
                    else { const int i = (2 * sl) * 128 + (tid - 256);
                        const int m = i >> 7, kk = i & 127, k1 = m & 63, l1 = kk & 63; const int idx = ((k1 * l1) & 63) * 64; const float c = ctab(idx), sn = ctab((idx - 1024) & 4095);
                        const float v = (m < 64) ? (kk < 64 ? c : -sn) : (kk < 64 ? -sn : -c); M1[i] = (bf16_t)(cvt_pk_bf16(v, v) & 0xffffu); }
                    if (tid < 128) { const int i = sl * 128 + tid;
                        const int k2 = i >> 7, kk = i & 127, l2 = kk & 63; const int idx = ((k2 * l2) & 63) * 64; const float c = ctab(idx), sn = ctab((idx - 1024) & 4095);
                        const float v = (kk < 64 ? c : sn) * (1.0f / 64.0f); M2[i] = (bf16_t)(cvt_pk_bf16(v, v) & 0xffffu); }
                    else if (tid < 192) { const int i = sl * 64 + (tid - 128); TW[2 * i] = ctab(i); TW[2 * i + 1] = ctab((i - 1024) & 4095); }
                    else if (tid < 224) { const int i = sl * 32 + (tid - 192); const int p = i >> 5, f = i & 31; const float inv = 1.0f / powf(10000.0f, (float)f / 32.0f); const float ang = (float)p * inv;
                        ropeT[2 * i] = cosf(ang); ropeT[2 * i + 1] = sinf(ang); }
                }
            }
        }
        SUBDUP(3) for (int it4 = wg - 64; it4 >= 0 && it4 < 64; it4 += G) {
                const int it = it4 >> 2, dq = it4 & 3;
                const int cs = it & 1, h = (it >> 1) & 3, l = it >> 3;
                LAS float* trig = (LAS float*)(lds + MISC_OFF + 8192);
                LAS float* wfL = (LAS float*)lds;
                __syncthreads();
                if (tid < 128) trig[tid] = cs ? sinf((float)tid * (6.283185307179586f / 128.0f)) : cosf((float)tid * (6.283185307179586f / 128.0f));
                { const int r = tid >> 5, c4 = (tid & 31) * 4; const float* wf = INP(I_WFOUR) + (size_t)(l * 4 + h) * 128 * 128;
                  f32x4 v[8];
#pragma unroll
                  for (int i = 0; i < 8; ++i) v[i] = *(const f32x4*)(wf + (size_t)(r + 16 * i) * 128 + c4);
#pragma unroll
                  for (int i = 0; i < 8; ++i) *(LAS f32x4*)(wfL + (r + 16 * i) * 128 + c4) = v[i]; }
                __syncthreads();
                { const int e = tid & 127, dg = tid >> 7; float a[8];
#pragma unroll
                  for (int i = 0; i < 8; ++i) a[i] = 0.f;
                  const int d0 = dq * 32 + dg * 8;
#pragma unroll 4
                  for (int m = 0; m < 128; ++m) { const float wv = wfL[m * 128 + e];
#pragma unroll
                    for (int i = 0; i < 8; ++i) a[i] += trig[(m * (d0 + i)) & 127] * wv; }
                  bf16_t* MBr = (bf16_t*)(wsb + WS_MB) + ((size_t)l * PFW + h * 256 + cs * 128 + e) * NP;
#pragma unroll
                  for (int i = 0; i < 8; ++i) a[i] *= 0.08838834764831845f;
                  u32x4 w; w.x = cvt_pk_bf16(a[0], a[1]); w.y = cvt_pk_bf16(a[2], a[3]); w.z = cvt_pk_bf16(a[4], a[5]); w.w = cvt_pk_bf16(a[6], a[7]);
                  *(u32x4*)(MBr + d0) = w; }
                __syncthreads();
                have_cond = false;
        }
        SUBDUP(4) for (int it = O_MOD + ((wg + 128) % G); it < O_ROPE; it += G) {
                const int q = it - O_MOD, l = q / 96, n0 = (q % 96) * 128;
                if (!have_cond) { __syncthreads();
                    for (int i = tid; i < 5 * 2048; i += 512) { const int j = i >> 11, k = i & 2047; const float c = j < 4 ? INP(I_C)[j * 2048 + k] : INP(I_CCTX)[k]; condL[i] = silu_f(c); }
                    have_cond = true; __syncthreads(); }
                const int c4 = (tid & 31) * 4, kg = tid >> 5; f32x4 a[5];
#pragma unroll
                for (int j = 0; j < 5; ++j) a[j] = (f32x4){0.f, 0.f, 0.f, 0.f};
                const float* wp = INP(I_WADA) + (size_t)l * DM * 12288 + (size_t)(kg * 128) * 12288 + n0 + c4;
#pragma unroll 8
                for (int k = 0; k < 128; ++k) { const f32x4 wv = __builtin_nontemporal_load((const f32x4*)(wp + (size_t)k * 12288));
#pragma unroll
                    for (int j = 0; j < 5; ++j) a[j] += wv * condL[j * 2048 + kg * 128 + k]; }
                LAS float* red = (LAS float*)lds;
                __syncthreads();
#pragma unroll
                for (int j = 0; j < 5; ++j) *(LAS f32x4*)(red + (kg * 5 + j) * 128 + c4) = a[j];
                __syncthreads();
                if (tid < 128) {
#pragma unroll
                    for (int j = 0; j < 5; ++j) { float sacc = 0.f;
#pragma unroll
                        for (int g2 = 0; g2 < 16; ++g2) sacc += red[(g2 * 5 + j) * 128 + tid];
                        mod[(size_t)(l * 5 + j) * 12288 + n0 + tid] = sacc + INP(I_BADA)[l * 12288 + n0 + tid]; } }
                __syncthreads();
        }
        __syncthreads();
    }
    SEAM(0);

    for (int layer = 0; layer < 2; ++layer) {
        const int pb = 1 + 10 * layer;
#define LAYER_PTRS() unsigned char* wsb = WSB(); const float* modl = (const float*)(wsb + WS_MOD) + (size_t)layer * 5 * 12288; (void)modl
#define XIN_PTRS() const float* xin_lat = INP(I_X); const float* xin_ctx = INP(I_CTX); const bf16_t* xin_b = layer == 0 ? (const bf16_t*)nullptr : (const bf16_t*)(wsb + WS_X2)

        DUP(0) if (EN(0) && IN(pb + 0)) {
            PHASE_IDS();
            LAYER_PTRS(); XIN_PTRS(); bf16_t* HB = (bf16_t*)(wsb + WS_HB);
            const float* gn = INP(I_N1G) + layer * DM;
            f32x4 gv[8];
#pragma unroll
            for (int j = 0; j < 8; ++j) gv[j] = *(const f32x4*)(gn + lane * 4 + 256 * j);
#define NORM1_ROW(ROW, V) do { const int row_ = (ROW); const int mr = row_ < RL ? (row_ >> 12) : 4; const float* sh = modl + (size_t)mr * 12288; const float* sc = sh + 2048; float ss = 0.f; \
                _Pragma("unroll") for (int j = 0; j < 8; ++j) ss += (V[j][0] * V[j][0] + V[j][1] * V[j][1]) + (V[j][2] * V[j][2] + V[j][3] * V[j][3]); \
                const float rinv = rsqrtf(wave_sum(ss) * (1.0f / DM) + NORM_EPS); \
                _Pragma("unroll") for (int j = 0; j < 8; ++j) { const int c = lane * 4 + 256 * j; const f32x4 s1 = *(const f32x4*)(sc + c), s0 = *(const f32x4*)(sh + c); \
                    const f32x4 h = V[j] * rinv * gv[j] * (s1 + 1.0f) + s0; u32x2 w; w.x = cvt_pk_bf16(h[0], h[1]); w.y = cvt_pk_bf16(h[2], h[3]); \
                    *(u32x2*)(HB + (size_t)row_ * DM + c) = w; } } while (0)
            for (int row = gw; row < RT; row += 2 * NGW) {
                const int rowB = row + NGW; const bool hasB = rowB < RT; const int rb_ = hasB ? rowB : row;
                const float* xa = row < RL ? xin_lat + (size_t)row * DM : xin_ctx + (size_t)(row - RL) * DM;
                const float* xb = rb_ < RL ? xin_lat + (size_t)rb_ * DM : xin_ctx + (size_t)(rb_ - RL) * DM;
                f32x4 va[8], vb[8];
                if (layer == 0) {
#pragma unroll
                    for (int j = 0; j < 8; ++j) va[j] = *(const f32x4*)(xa + lane * 4 + 256 * j);
#pragma unroll
                    for (int j = 0; j < 8; ++j) vb[j] = *(const f32x4*)(xb + lane * 4 + 256 * j);
                } else { u32x2 qa[8], qb[8];
#pragma unroll
                    for (int j = 0; j < 8; ++j) qa[j] = *(const u32x2*)(xin_b + (size_t)row * DM + lane * 4 + 256 * j);
#pragma unroll
                    for (int j = 0; j < 8; ++j) qb[j] = *(const u32x2*)(xin_b + (size_t)rb_ * DM + lane * 4 + 256 * j);
#pragma unroll
                    for (int j = 0; j < 8; ++j) { va[j] = bf4(qa[j]); vb[j] = bf4(qb[j]); } }
                NORM1_ROW(row, va);
                if (hasB) NORM1_ROW(rowB, vb);
            }
#undef NORM1_ROW
        }
        SEAM(pb + 0);

        DUP(1) if (EN(1) && IN(pb + 1)) {
            unsigned char* wsb = WSB(); bf16_t* HB = (bf16_t*)(wsb + WS_HB); bf16_t* Win_t = (bf16_t*)(wsb + WS_WIN); bf16_t* P = (bf16_t*)(wsb + WS_P);
            pg8::Gemm g{HB, Win_t + (size_t)layer * NP * DM, 2 * DM};
            pg8::InProjOrder S; S.init(G, wg, layer == 1);
            pg8::EpiInProj E{P, (bf16_t*)(wsb + WS_NV), (bf16_t*)(wsb + WS_GV)};
            pg8::gemm_phase<pg8::EpiInProj, pg8::InProjOrder>(lds, g, S, E);
            { const int def_ = DEFICIT((RL / 256) * (NP / 256) + 4 * (layer == 1 ? 6 : NP / 256)); if (def_ > 0) MOE_GRAB(def_ * 14); }
        }
        SEAM(pb + 1);

        DUP(2) if (EN(2) && IN(pb + 2)) {
            PHASE_IDS();
            unsigned char* wsb = WSB(); const float* ropeT = (const float*)(wsb + WS_ROPE); const bf16_t* P = (const bf16_t*)(wsb + WS_P); bf16_t* Y = (bf16_t*)(wsb + WS_Y);
            bf16_t* NQ = (bf16_t*)(wsb + WS_NQ); bf16_t* NK = (bf16_t*)(wsb + WS_NK); bf16_t* NV = (bf16_t*)(wsb + WS_NV); bf16_t* GQ = (bf16_t*)(wsb + WS_GQ); bf16_t* GK = (bf16_t*)(wsb + WS_GK); bf16_t* GV = (bf16_t*)(wsb + WS_GV);
            bf16_t* PTC = (bf16_t*)(wsb + WS_PTC);
            const float* convw = INP(I_CONVW) + layer * 3 * 512;
            const float* g_nq = INP(I_NAQG) + layer * 128; const float* g_nk = INP(I_NAKG) + layer * 128;
            const float* g_gq = INP(I_GQG) + layer * 128; const float* g_gk = INP(I_GKG) + layer * 128;
            bf16_t* PF = (bf16_t*)(wsb + WS_PF);
            { const int nctx = layer == 0 ? 16 : 0; const int hh = wg & 3;
              struct CdftOrder { int G, c, nctx; __device__ __forceinline__ bool next(int i, pg8::Unit& u) const { const int L = i * G + c; if (L >= nctx) return false;
                  const int pm = RL / 256 + (L >> 2);
                  u.arow = 256 * pm; u.brow = 256 * (c & 3); u.orow = 256 * pm; u.ocol = 128 * (c & 3); return true; } };
              pg8::Gemm g{P + hh * 128, (const bf16_t*)(wsb + WS_MB) + (size_t)layer * PFW * NP, 2 * NP, 2 * 128};
              CdftOrder S{G, wg, nctx}; pg8::EpiStoreBf16 E{PF, PFW, 512};
              pg8::gemm_phase<pg8::EpiStoreBf16, CdftOrder>(lds, g, S, E);
              if (threadIdx.x == 0) { __builtin_amdgcn_fence(__ATOMIC_RELEASE, "agent"); asm volatile("s_waitcnt vmcnt(0)" ::: "memory");
                  for (int L = wg; L < nctx; L += G) xb_add(ctl + CW_CDF + 64 * (layer * 5 + 4), 1u); }
            }
            const int l16 = lane & 15;
            f32x4 cw[3][2], gq_[2], gk_[2], hq_[2], hk_[2];
#pragma unroll
            for (int k = 0; k < 3; ++k) { cw[k][0] = *(const f32x4*)(convw + k * 512 + lane * 8); cw[k][1] = *(const f32x4*)(convw + k * 512 + lane * 8 + 4); }
            gq_[0] = *(const f32x4*)(g_nq + l16 * 8); gq_[1] = *(const f32x4*)(g_nq + l16 * 8 + 4); gk_[0] = *(const f32x4*)(g_nk + l16 * 8); gk_[1] = *(const f32x4*)(g_nk + l16 * 8 + 4);
            hq_[0] = *(const f32x4*)(g_gq + l16 * 8); hq_[1] = *(const f32x4*)(g_gq + l16 * 8 + 4); hk_[0] = *(const f32x4*)(g_gk + l16 * 8); hk_[1] = *(const f32x4*)(g_gk + l16 * 8 + 4);
#define CDF_WAIT(f, n) do { __syncthreads(); if (threadIdx.x == 0) { while (__hip_atomic_load(ctl + CW_CDF + 64 * (layer * 5 + (f)), RLX_AGENT) < (unsigned)(n)) __builtin_amdgcn_s_sleep(2); \
                __builtin_amdgcn_fence(__ATOMIC_ACQUIRE, "agent"); asm volatile("s_waitcnt vmcnt(0)" ::: "memory"); } __syncthreads(); } while (0)
            struct PrepRaw { u32x4 gb, zc, zv, pc, pv, nc, nv, nq, nk, gq, gk; f32x4 rcs[4]; };
#define PREP_LOAD(ROW, R) do { const int row_ = (ROW); int t_, Ls_; if (row_ < RL) { t_ = row_ & 4095; Ls_ = SEQ; } else { t_ = (row_ - RL) & 255; Ls_ = CTXL; } \
                const bf16_t* Pr = P + (size_t)row_ * NP; const int ch = lane * 8; const u32x4 z4 = {0u, 0u, 0u, 0u}; \
                R.gb = *(const u32x4*)(Pr + PC_CB + ch); R.zc = *(const u32x4*)(Pr + PC_CC + ch); R.zv = *(const u32x4*)(Pr + PC_CV + ch); \
                R.pc = z4; R.pv = z4; R.nc = z4; R.nv = z4; \
                if (t_ > 0) { R.pc = *(const u32x4*)(Pr - NP + PC_CC + ch); R.pv = *(const u32x4*)(Pr - NP + PC_CV + ch); } \
                if (t_ < Ls_ - 1) { R.nc = *(const u32x4*)(Pr + NP + PC_CC + ch); R.nv = *(const u32x4*)(Pr + NP + PC_CV + ch); } \
                R.nq = *(const u32x4*)(Pr + PC_NQ + ch); R.nk = *(const u32x4*)(Pr + PC_NK + ch); R.gq = *(const u32x4*)(Pr + PC_GQ + ch); R.gk = *(const u32x4*)(Pr + PC_GK + (lane & 31) * 8); \
                { const int seg = l16 >> 2; const int p64 = (seg < 2) ? (t_ >> 6) : (t_ & 63); const float* cs_ = ropeT + (size_t)(p64 * 32 + (l16 & 3) * 8) * 2; \
                  _Pragma("unroll") for (int i = 0; i < 4; ++i) R.rcs[i] = *(const f32x4*)(cs_ + 4 * i); } } while (0)
#define HEADNORM(raw, gain, out) do { float _x[8]; _Pragma("unroll") for (int i = 0; i < 4; ++i) { _x[2 * i] = bf_lo(raw[i]); _x[2 * i + 1] = bf_hi(raw[i]); } \
                    float _ss = 0.f; _Pragma("unroll") for (int i = 0; i < 8; ++i) _ss += _x[i] * _x[i]; \
                    _ss += __shfl_xor(_ss, 1); _ss += __shfl_xor(_ss, 2); _ss += __shfl_xor(_ss, 4); _ss += __shfl_xor(_ss, 8); \
                    const float _ri = rsqrtf(_ss * (1.0f / 128.0f) + NORM_EPS); \
                    _Pragma("unroll") for (int i = 0; i < 8; ++i) out[i] = _x[i] * _ri * gain[i >> 2][i & 3]; } while (0)
#define ROPE8(v, R) do { const int seg = l16 >> 2; \
                    _Pragma("unroll") for (int i = 0; i < 8; ++i) { const float pvv = __shfl_xor(v[i], 4); const float c_ = R.rcs[i >> 1][(2 * i) & 3], s_ = R.rcs[i >> 1][(2 * i + 1) & 3]; v[i] = (seg & 1) ? (v[i] * c_ + pvv * s_) : (v[i] * c_ - pvv * s_); } } while (0)
#define PACK8(v, w) do { w.x = cvt_pk_bf16(v[0], v[1]); w.y = cvt_pk_bf16(v[2], v[3]); w.z = cvt_pk_bf16(v[4], v[5]); w.w = cvt_pk_bf16(v[6], v[7]); } while (0)
#define PREP_ROW(ROW, R) do { const int row_ = (ROW); int b, kvrow; bool lat; if (row_ < RL) { b = row_ >> 12; kvrow = CTXL + (row_ & 4095); lat = true; } else { const int rc = row_ - RL; b = rc >> 8; kvrow = rc & 255; lat = false; } \
                const int ch = lane * 8; \
                { float y[8]; \
                  _Pragma("unroll") for (int i = 0; i < 4; ++i) { \
                      const float w0a = cw[0][i >> 1][(2 * i) & 3], w1a = cw[1][i >> 1][(2 * i) & 3], w2a = cw[2][i >> 1][(2 * i) & 3]; \
                      const float w0b = cw[0][i >> 1][(2 * i + 1) & 3], w1b = cw[1][i >> 1][(2 * i + 1) & 3], w2b = cw[2][i >> 1][(2 * i + 1) & 3]; \
                      y[2 * i] = bf_lo(R.gb[i]) * (w0a * (bf_lo(R.pc[i]) * bf_lo(R.pv[i])) + w1a * (bf_lo(R.zc[i]) * bf_lo(R.zv[i])) + w2a * (bf_lo(R.nc[i]) * bf_lo(R.nv[i]))); \
                      y[2 * i + 1] = bf_hi(R.gb[i]) * (w0b * (bf_hi(R.pc[i]) * bf_hi(R.pv[i])) + w1b * (bf_hi(R.zc[i]) * bf_hi(R.zv[i])) + w2b * (bf_hi(R.nc[i]) * bf_hi(R.nv[i]))); } \
                  u32x4 w; PACK8(y, w); *(u32x4*)(Y + (size_t)row_ * DM + 512 + ch) = w; } \
                { float o[8]; HEADNORM(R.nq, gq_, o); u32x4 w; PACK8(o, w); *(u32x4*)(NQ + (size_t)row_ * 512 + ch) = w; } \
                { float o[8]; HEADNORM(R.nk, gk_, o); u32x4 w; PACK8(o, w); *(u32x4*)(NK + ((size_t)b * KVL + kvrow) * 512 + ch) = w; } \
                { float o[8]; HEADNORM(R.gq, hq_, o); if (lat) ROPE8(o, R); u32x4 w; PACK8(o, w); *(u32x4*)(GQ + (size_t)row_ * 512 + ch) = w; } \
                { float o[8]; HEADNORM(R.gk, hk_, o); if (lat) ROPE8(o, R); u32x4 w; PACK8(o, w); \
                  if (lane < 32) *(u32x4*)(GK + ((size_t)b * KVL + kvrow) * 256 + ch) = w; } } while (0)
            for (int row = gw; row < RT; row += 2 * NGW) {
                const int rowB = row + NGW; const bool hasB = rowB < RT;
                PrepRaw ra, rb;
                PREP_LOAD(row, ra); PREP_LOAD(hasB ? rowB : row, rb);
                PREP_ROW(row, ra);
                if (hasB) PREP_ROW(rowB, rb);
            }
#undef PREP_LOAD
#undef PREP_ROW
#undef HEADNORM
#undef ROPE8
#undef PACK8
            if (layer == 0) { LAS bf16_t* tscr = (LAS bf16_t*)(lds + wave * 8704);
              CDF_WAIT(4, 16);
              for (int item = (RL / 64) * 16 + gw; item < (RT / 64) * 16; item += NGW) {
                  const int rb = item >> 4, cb = item & 15, r0 = rb * 64, c0 = cb * 64;
#pragma unroll
                  for (int i = 0; i < 8; ++i) { const int rr = 8 * i + (lane >> 3), c8 = (lane & 7) * 8; const u32x4 v = *(const u32x4*)(PF + (size_t)(r0 + rr) * PFW + c0 + c8);
#pragma unroll
                      for (int k = 0; k < 4; ++k) { tscr[(c8 + 2 * k) * 66 + rr] = (bf16_t)(v[k] & 0xffffu); tscr[(c8 + 2 * k + 1) * 66 + rr] = (bf16_t)(v[k] >> 16); } }
                  LDS_WAIT();
#pragma unroll
                  for (int i = 0; i < 8; ++i) { const int cc = 8 * i + (lane >> 3), l8 = (lane & 7) * 8; const LAS unsigned* s = (const LAS unsigned*)(tscr + cc * 66 + l8);
                      u32x4 w; w.x = s[0]; w.y = s[1]; w.z = s[2]; w.w = s[3];
                      const int cg = c0 + cc; const int cm = cg & 511, sn = cg >> 9;
                      const int rc0 = r0 - RL, b = rc0 >> 8, l0 = rc0 & 255; *(u32x4*)(PTC + ((size_t)b * 512 + cm) * 512 + sn * 256 + l0 + l8) = w; }
                  LDS_WAIT();
              } }
            __syncthreads();
            for (int u = wg; u < NB * 64; u += G) {
                const int b = u >> 6, l2 = u & 63;
                const bf16_t* M1 = (const bf16_t*)(wsb + WS_FFT); const float* TW = (const float*)(wsb + WS_FFT + 49152); bf16_t* O1 = (bf16_t*)(wsb + WS_T);
                __syncthreads();
                cdft_to_slab(lds, P + ((size_t)b * SEQ + l2) * NP, (size_t)64 * NP, (const bf16_t*)(wsb + WS_MB) + (size_t)layer * PFW * NP, NP);
                auto rowp = [=](int) -> const bf16_t* { return nullptr; };
                auto epi = [=](int mbp, const f32x16 (&acc)[2][2], int wid, int r32, int hi) {
#pragma unroll
                        for (int r = 0; r < 16; ++r) { const int k1 = 32 * mbp + att::crow(r, hi); const f32x2 tw = *(const f32x2*)(TW + 2 * ((k1 * l2) & 4095));
                            bf16_t* o = O1 + ((((size_t)b * 64 + k1) * 2) * 64 + l2) * 512 + 64 * wid + r32;
#pragma unroll
                            for (int nb = 0; nb < 2; ++nb) { const float ur = acc[0][nb][r], ui = acc[1][nb][r]; const float vr = ur * tw.x + ui * tw.y, vi = ui * tw.x - ur * tw.y;
                                o[32 * nb] = (bf16_t)(cvt_pk_bf16(vr, vr) & 0xffffu); o[64 * 512 + 32 * nb] = (bf16_t)(cvt_pk_bf16(vi, vi) & 0xffffu); } } };
                fft_stage<2, false>(lds, M1, rowp, epi);
            }
#undef CDF_WAIT
        }
        SEAM(pb + 2);

        DUP(3) if (EN(3) && IN(pb + 3)) {
            PHASE_IDS();
            unsigned char* wsb = WSB(); bf16_t* Y = (bf16_t*)(wsb + WS_Y);
            const bf16_t* NQ = (const bf16_t*)(wsb + WS_NQ); const bf16_t* NK = (const bf16_t*)(wsb + WS_NK); const bf16_t* NV = (const bf16_t*)(wsb + WS_NV); const bf16_t* GQ = (const bf16_t*)(wsb + WS_GQ); const bf16_t* GK = (const bf16_t*)(wsb + WS_GK); const bf16_t* GV = (const bf16_t*)(wsb + WS_GV);
            const bf16_t* PTC = (const bf16_t*)(wsb + WS_PTC); const bf16_t* Tc = (const bf16_t*)(wsb + WS_TC);
            LAS float* rpbL = (LAS float*)(lds + RPB_OFF);
            if (MX(0)) for (int u = wg; u < NB * 64; u += G) {
                const int b = u >> 6, k1 = u & 63;
                const bf16_t* M2 = (const bf16_t*)(wsb + WS_FFT) + 128 * 128; const bf16_t* O1 = (const bf16_t*)(wsb + WS_T) + ((size_t)b * 64 + k1) * 2 * 64 * 512;
                auto rowp = [=](int kk) -> const bf16_t* { return O1 + (size_t)kk * 512; };
                auto epi = [=](int, const f32x16 (&acc)[2][2], int wid, int r32, int hi) {
#pragma unroll
                    for (int mb = 0; mb < 2; ++mb)
#pragma unroll
                        for (int r = 0; r < 16; ++r) { const int k2 = 32 * mb + att::crow(r, hi); bf16_t* o = Y + ((size_t)b * SEQ + k1 + 64 * k2) * DM + 64 * wid + r32;
#pragma unroll
                            for (int nb = 0; nb < 2; ++nb) { const float v = acc[mb][nb][r]; o[32 * nb] = (bf16_t)(cvt_pk_bf16(v, v) & 0xffffu); } } };
                fft_stage<1>(lds, M2, rowp, epi);
            }
            if (MX(5) && layer == 0) { pg8::Gemm g{Tc, PTC, 2 * 512}; pg8::DftOrder S{wg, 1}; pg8::EpiStoreBf16 E{Y, DM}; pg8::gemm_phase<pg8::EpiStoreBf16, pg8::DftOrder>(lds, g, S, E); }
            __syncthreads();
            if (MX(1)) for (int uu = wg; uu < 256; uu += G) {
                const int qb = uu & 15, h = (uu >> 4) & 3, b = uu >> 6;
                __syncthreads();
                for (int i = tid; i < 465; i += 512) rpbL[i] = INP(I_RPB)[(size_t)(layer * 4 + h) * 465 + i] * att::LOG2E;
                __syncthreads();
                const int r0 = qb * 4;
                const int rs_lo = min(max(r0 - 4, 0), 56), rs_hi = min(max(r0 + 3 - 4, 0), 56);
                int rlo = rs_lo, rhi = rs_hi + 7; if (((rhi - rlo + 1) & 1) != 0) { if (rhi < 63) ++rhi; else --rlo; }
                const int NT = 4 + (rhi - rlo + 1);
                attn_na_call(NQ + ((size_t)b * SEQ + qb * 256) * 512 + h * 128, NK + (size_t)b * KVL * 512 + h * 128, NV + (size_t)b * KVL * 512 + h * 128, Y + ((size_t)b * SEQ + qb * 256) * DM + 1024 + h * 128, NT, r0, rlo);
            }
            if (MX(2)) {
                const int w2 = (wg & 15) == 0 ? 2 * (wg >> 4) : (wg & 15) == 15 ? 2 * (wg >> 4) + 1 : -1;
                const int nun = 1 + ((layer == 0 && w2 >= 0) ? 1 : 0);
                for (int i = 0; i < nun; ++i) {
                    const bf16_t *qp, *kp, *vp; bf16_t* op; int ldk, nt;
                    if (i < 1) { const int uu = wg & 255, qb = uu & 15, h = (uu >> 4) & 3, b = uu >> 6, kvh = h >> 1;
                        qp = GQ + ((size_t)b * SEQ + qb * 256) * 512 + h * 128; kp = GK + (size_t)b * KVL * 256 + kvh * 128; vp = GV + (size_t)b * KVL * 256 + kvh * 128;
                        op = Y + ((size_t)b * SEQ + qb * 256) * DM + 1536 + h * 128; ldk = 256; nt = KVL / 64; }
                    else if (w2 < 16) { const int h = w2 & 3, b = w2 >> 2, kvh = h >> 1;
                        qp = GQ + ((size_t)RL + b * CTXL) * 512 + h * 128; kp = GK + (size_t)b * KVL * 256 + kvh * 128; vp = GV + (size_t)b * KVL * 256 + kvh * 128;
                        op = Y + ((size_t)RL + b * CTXL) * DM + 1536 + h * 128; ldk = 256; nt = CTXL / 64; }
                    else { const int h = w2 & 3, b = (w2 - 16) >> 2;
                        qp = NQ + ((size_t)RL + b * CTXL) * 512 + h * 128; kp = NK + (size_t)b * KVL * 512 + h * 128; vp = NV + (size_t)b * KVL * 512 + h * 128;
                        op = Y + ((size_t)RL + b * CTXL) * DM + 1024 + h * 128; ldk = 512; nt = CTXL / 64; }
                    attn_dense_call(qp, kp, vp, op, nt, ldk);
                }
            }
        }
        SEAM(pb + 3);

        DUP(4) if (EN(4) && IN(pb + 4)) {
            LAYER_PTRS(); XIN_PTRS(); const bf16_t* Y = (const bf16_t*)(wsb + WS_Y); const bf16_t* Wout_t = (const bf16_t*)(wsb + WS_WOUT); bf16_t* Xmid = (bf16_t*)(wsb + WS_X1);
            pg8::Gemm g{Y, Wout_t + (size_t)layer * DM * DM, 2 * DM};
            pg8::GridOrder S; S.init((layer == 0 ? RT : RL) / 256, DM / 256, G, wg, 0, 0, 0, 0, 256);
            pg8::EpiResid E{xin_lat, xin_ctx, xin_b, Xmid, modl + 2 * 2048, 1.0f};
            pg8::gemm_phase<pg8::EpiResid, pg8::GridOrder>(lds, g, S, E);
            { const int def_ = DEFICIT(((layer == 0 ? RT : RL) / 256) * (DM / 256)); if (def_ > 0) MOE_GRAB(def_ * 14); }
        }
        SEAM(pb + 4);

        if (EN(5) && IN(pb + 5)) {
            PHASE_IDS();
            LAYER_PTRS(); const bf16_t* Xmid = (const bf16_t*)(wsb + WS_X1); unsigned char* HB8 = (unsigned char*)(wsb + WS_HB);
            int* route_pos = (int*)(wsb + WS_ROUTE + 256 * 1024);
            const float* gn = INP(I_N2G) + layer * DM;
            LAS float* wrL = (LAS float*)(lds + ROUTER_LDS);
            if (layer == 1) { for (int i = tid; i < 2048 * 8; i += 512) wrL[i] = INP(I_ROUTER)[i]; __syncthreads(); }
            const int nrows = layer == 0 ? RT : RL;
            f32x4 gv[8];
#pragma unroll
            for (int j = 0; j < 8; ++j) gv[j] = *(const f32x4*)(gn + lane * 4 + 256 * j);
            for (int row0 = gw; row0 < nrows; row0 += 2 * NGW) {
                const int rowB = row0 + NGW; const bool hasB = rowB < nrows; const int rb_ = hasB ? rowB : row0;
                u32x2 va[8], vb[8];
#pragma unroll
                for (int j = 0; j < 8; ++j) va[j] = *(const u32x2*)(Xmid + (size_t)row0 * DM + lane * 4 + 256 * j);
#pragma unroll
                for (int j = 0; j < 8; ++j) vb[j] = *(const u32x2*)(Xmid + (size_t)rb_ * DM + lane * 4 + 256 * j);
#pragma unroll 1
                for (int half = 0; half < 2; ++half) {
                if (half == 1 && !hasB) break;
                const int row = half ? rowB : row0;
                f32x4 v[8];
#pragma unroll
                for (int j = 0; j < 8; ++j) v[j] = bf4(half ? vb[j] : va[j]);
                const int mr = row < RL ? (row >> 12) : 4;
                const float* sh = modl + (size_t)mr * 12288 + 3 * 2048; const float* sc = sh + 2048;
                float ss = 0.f;
#pragma unroll
                for (int j = 0; j < 8; ++j) ss += (v[j][0] * v[j][0] + v[j][1] * v[j][1]) + (v[j][2] * v[j][2] + v[j][3] * v[j][3]);
                const float rinv = rsqrtf(wave_sum(ss) * (1.0f / DM) + NORM_EPS);
                float lg[8] = {0.f, 0.f, 0.f, 0.f, 0.f, 0.f, 0.f, 0.f};
                unsigned hq[8];
#pragma unroll
                for (int j = 0; j < 8; ++j) { const int c = lane * 4 + 256 * j; const f32x4 g = gv[j], s1 = *(const f32x4*)(sc + c), s0 = *(const f32x4*)(sh + c);
                    const f32x4 h = v[j] * rinv * g * (s1 + 1.0f) + s0;
                    hq[j] = pk4_fp8(h[0] * F8_SH, h[1] * F8_SH, h[2] * F8_SH, h[3] * F8_SH);
                    if (layer == 0) *(unsigned*)(HB8 + (size_t)row * DM + c) = hq[j];
                    if (layer == 1) {
#pragma unroll
                        for (int k = 0; k < 4; ++k) { const f32x4 wa = *(const LAS f32x4*)(wrL + (c + k) * 8), wb = *(const LAS f32x4*)(wrL + (c + k) * 8 + 4);
                            lg[0] += h[k] * wa[0]; lg[1] += h[k] * wa[1]; lg[2] += h[k] * wa[2]; lg[3] += h[k] * wa[3]; lg[4] += h[k] * wb[0]; lg[5] += h[k] * wb[1]; lg[6] += h[k] * wb[2]; lg[7] += h[k] * wb[3]; } } }
                if (layer == 1) {
#pragma unroll
                    for (int e = 0; e < 8; ++e) lg[e] = wave_sum(lg[e]);
                    int i0 = 0; float v0 = lg[0];
#pragma unroll
                    for (int e = 1; e < 8; ++e) if (lg[e] > v0) { v0 = lg[e]; i0 = e; }
                    int i1 = -1; float v1 = -3.0e38f;
#pragma unroll
                    for (int e = 0; e < 8; ++e) if (e != i0 && lg[e] > v1) { v1 = lg[e]; i1 = e; }
                    const float w0 = 1.0f / (1.0f + __expf(v1 - v0)), w1 = 1.0f - w0;
                    int d0 = 0, d1 = 0;
                    if (lane == 0) {
                        const unsigned p0 = atomicAdd(ctl + CW_CNT + 64 * i0, 1u), p1 = atomicAdd(ctl + CW_CNT + 64 * i1, 1u);
                        unsigned* t0w = ctl + CW_TILE + 64 * i0 + (p0 >> 8); unsigned* t1w = ctl + CW_TILE + 64 * i1 + (p1 >> 8);
                        unsigned q0 = 0, q1 = 0;
                        if ((p0 & 255u) == 0u) { q0 = atomicAdd(ctl + CW_POOL, 1u) + 1u; __hip_atomic_store(t0w, q0, RLX_AGENT); }
                        if ((p1 & 255u) == 0u) { q1 = atomicAdd(ctl + CW_POOL, 1u) + 1u; __hip_atomic_store(t1w, q1, RLX_AGENT); }
                        while (q0 == 0u) { q0 = __hip_atomic_load(t0w, RLX_AGENT); if (q0 == 0u) __builtin_amdgcn_s_sleep(1); }
                        while (q1 == 0u) { q1 = __hip_atomic_load(t1w, RLX_AGENT); if (q1 == 0u) __builtin_amdgcn_s_sleep(1); }
                        d0 = (int)((q0 - 1u) * 256u + (p0 & 255u)); d1 = (int)((q1 - 1u) * 256u + (p1 & 255u));
                        route_pos[2 * row] = d0; route_pos[2 * row + 1] = d1; }
                    d0 = __builtin_amdgcn_readfirstlane(d0); d1 = __builtin_amdgcn_readfirstlane(d1);
                    unsigned char* APERM8 = wsb + WS_APERM; float* roww = (float*)(wsb + WS_ROUTE + 384 * 1024);
                    { const size_t d = (size_t)d0;
#pragma unroll
                        for (int j = 0; j < 8; ++j) *(unsigned*)(APERM8 + d * DM + lane * 4 + 256 * j) = hq[j];
                        if (lane == 0) roww[d] = w0; }
                    { const size_t d = (size_t)d1;
#pragma unroll
                        for (int j = 0; j < 8; ++j) *(unsigned*)(APERM8 + d * DM + lane * 4 + 256 * j) = hq[j];
                        if (lane == 0) roww[d] = w1; }
                }
                }
            }
            if (layer == 1) MOE_DRAIN(CW_QUP, 0, NT_MUP);
            __syncthreads();
        }
        SEAM(pb + 5);

        if (layer == 0) {
            DUP(7) if (EN(7) && IN(pb + 7)) {
                unsigned char* wsb = WSB(); const unsigned char* HB8 = wsb + WS_HB; const unsigned char* Wup8 = wsb + WS_WUP; unsigned char* ACT8 = wsb + WS_ACT;
                pg8::Gemm g{HB8, Wup8, DM};
                pg8::GridOrder S; S.init(RT / 256, 2 * DFF / 256, G, wg, 0, 0, 0, 0, 128);
                pg8::EpiSwiglu8 E{ACT8, DFF, 1.0f / (F8_SW * F8_SH), F8_SA};
                pg8::gemm_phase<pg8::EpiSwiglu8, pg8::GridOrder, true>(lds, g, S, E);
                { const int def_ = DEFICIT((RT / 256) * (2 * DFF / 256)); if (def_ > 0) MOE_GRAB(def_ * 7); }
            }
            SEAM(pb + 7);
            DUP(8) if (EN(8) && IN(pb + 8)) {
                LAYER_PTRS(); const unsigned char* ACT8 = wsb + WS_ACT; const unsigned char* Wdn8 = wsb + WS_WDN; const bf16_t* Xmid = (const bf16_t*)(wsb + WS_X1); bf16_t* X2 = (bf16_t*)(wsb + WS_X2);
                pg8::Gemm g{ACT8, Wdn8, DFF};
                pg8::GridOrder S; S.init(RT / 256, DM / 256, G, wg, 0, 0, 0, 0, 256);
                pg8::EpiResid E{nullptr, nullptr, Xmid, X2, modl + 5 * 2048, 1.0f / (F8_SW * F8_SA)};
                pg8::gemm_phase<pg8::EpiResid, pg8::GridOrder, true>(lds, g, S, E);
                { const int def_ = DEFICIT((RT / 256) * (DM / 256)); if (def_ > 0) MOE_GRAB(def_ * 20); }
            }
            SEAM(pb + 8);
        } else {
            volatile LAS int* tb = (volatile LAS int*)(MISC + 16); volatile LAS int* tl = (volatile LAS int*)(lds + TL_OFF);
            if (IN(pb + 7) || IN(pb + 8) || IN(pb + 9)) {
                __syncthreads();
                if (tid == 0) { int acc = 0; for (int e = 0; e < 8; ++e) { tb[e] = acc; const int c = (int)__hip_atomic_load(ctl + CW_CNT + 64 * e, RLX_AGENT); acc += (c + 255) >> 8; } tb[8] = acc; }
                __syncthreads();
                { int t_ = (int)threadIdx.x; asm volatile("" : "+v"(t_)); const int e = t_ >> 6, j = t_ & 63; if (j < tb[e + 1] - tb[e]) tl[tb[e] + j] = (int)__hip_atomic_load(ctl + CW_TILE + 64 * e + j, RLX_AGENT) - 1; }
                __syncthreads();
            }
            DUP(11) if (EN(11) && IN(pb + 7)) {
                unsigned char* wsb = WSB(); const unsigned char* APERM8 = wsb + WS_APERM; const unsigned char* Mup8 = wsb + WS_MUP; unsigned char* ACTM8 = wsb + WS_ACTM;
                pg8::Gemm g{APERM8, Mup8, DM};
                pg8::MoeOrder S{G, wg, 2 * DFE / 256, 128, 2 * DFE, tb, tl};
                pg8::EpiSwiglu8 E{ACTM8, DFE, 1.0f / (F8_SW * F8_SH), F8_SA};
                pg8::gemm_phase<pg8::EpiSwiglu8, pg8::MoeOrder, true>(lds, g, S, E);
                MOE_DRAIN(CW_QDN, NT_MUP, NT_MDN);
            }
            SEAM(pb + 7);
            DUP(12) if (EN(12) && IN(pb + 8)) {
                unsigned char* wsb = WSB(); const unsigned char* ACTM8 = wsb + WS_ACTM; const unsigned char* Mdn8 = wsb + WS_MDN; bf16_t* OPERM = (bf16_t*)(wsb + WS_OPERM); const float* roww = (const float*)(wsb + WS_ROUTE + 384 * 1024);
                pg8::Gemm g{ACTM8, Mdn8, DFE};
                const int T_ = tb[8] * (DM / 256), F_ = T_ / G, rem_ = T_ % G;
                const int KS = (rem_ > 0 && rem_ * 4 <= G) ? 4 : (rem_ > 0 && rem_ * 2 <= G) ? 2 : 1;
                pg8::MoeOrder S{G, wg, DM / 256, 256, DM, tb, tl, KS > 1 ? F_ * G : 0x7fffffff};
                pg8::EpiMoeDown E{OPERM, roww, 1.0f / (F8_SW * F8_SA)};
                pg8::gemm_phase<pg8::EpiMoeDown, pg8::MoeOrder, true>(lds, g, S, E);
                if (KS > 1) {
                    const int j = wg / KS, q = wg % KS; const bool mine = j < rem_;
                    float* slab = (float*)(wsb + WS_APERM) + (size_t)(j * KS + q) * 65536;
                    pg8::MoeTailOrder TS{S, mine ? F_ * G + j : -1};
                    pg8::Gemm g2{ACTM8 + q * (DFE / KS), Mdn8 + q * (DFE / KS), DFE, DFE / KS};
                    pg8::EpiPartial E2{slab};
                    pg8::gemm_phase<pg8::EpiPartial, pg8::MoeTailOrder, true>(lds, g2, TS, E2);
                    if (mine) {
                        if (threadIdx.x == 0) { __builtin_amdgcn_fence(__ATOMIC_RELEASE, "agent"); asm volatile("s_waitcnt vmcnt(0)" ::: "memory");
                            (void)xb_add(ctl + CW_KS + j, 1u);
                            while (xb_ld(ctl + CW_KS + j) < (unsigned)KS) __builtin_amdgcn_s_sleep(1);
                            __builtin_amdgcn_fence(__ATOMIC_ACQUIRE, "agent"); asm volatile("s_waitcnt vmcnt(0)" ::: "memory"); }
                        __syncthreads();
                        {   pg8::Unit u; (void)S.unit(F_ * G + j, u);
                            int t_ = (int)threadIdx.x; asm volatile("" : "+v"(t_));
                            const int rpw = 256 / KS;
                            const int r = q * rpw + t_ / (512 / rpw), ncol = 256 / (512 / rpw), hc = (t_ % (512 / rpw)) * ncol;
                            const float rw = roww[u.orow + r] * (1.0f / (F8_SW * F8_SA));
                            const float* sp = (const float*)(wsb + WS_APERM) + (size_t)(j * KS) * 65536 + (size_t)r * 256 + hc; bf16_t* op = OPERM + (size_t)(u.orow + r) * DM + u.ocol + hc;
#pragma unroll 4
                            for (int c8 = 0; c8 < ncol / 8; ++c8) { f32x4 a0 = {0.f, 0.f, 0.f, 0.f}, a1 = {0.f, 0.f, 0.f, 0.f};
                                for (int qq = 0; qq < KS; ++qq) { a0 += *(const f32x4*)(sp + (size_t)qq * 65536 + c8 * 8); a1 += *(const f32x4*)(sp + (size_t)qq * 65536 + c8 * 8 + 4); }
                                a0 *= rw; a1 *= rw;
                                u32x4 w; w.x = cvt_pk_bf16(a0[0], a0[1]); w.y = cvt_pk_bf16(a0[2], a0[3]); w.z = cvt_pk_bf16(a1[0], a1[1]); w.w = cvt_pk_bf16(a1[2], a1[3]);
                                *(u32x4*)(op + c8 * 8) = w; }
                        }
                        __syncthreads();
                    }
                }
            }
            SEAM(pb + 8);
            DUP(9) if (EN(9) && IN(pb + 9)) {
            PHASE_IDS();
                LAYER_PTRS(); const bf16_t* Xmid = (const bf16_t*)(wsb + WS_X1); const bf16_t* OPERM = (const bf16_t*)(wsb + WS_OPERM); float* outp = OUTP();
                const int* route_pos = (const int*)(wsb + WS_ROUTE + 256 * 1024);
                for (int t = gw; t < RL; t += 2 * NGW) {
                    const int tB = t + NGW; const bool hasB = tB < RL; const int tb_ = hasB ? tB : t;
                    const int a0 = route_pos[2 * t], a1 = route_pos[2 * t + 1];
                    const int c0 = route_pos[2 * tb_], c1 = route_pos[2 * tb_ + 1];
                    u32x2 xa[8], xb[8]; u32x2 pa0[8], pa1[8], pb0[8], pb1[8];
#pragma unroll
                    for (int j = 0; j < 8; ++j) { const int c = lane * 4 + 256 * j; xa[j] = *(const u32x2*)(Xmid + (size_t)t * DM + c); pa0[j] = *(const u32x2*)(OPERM + (size_t)a0 * DM + c); pa1[j] = *(const u32x2*)(OPERM + (size_t)a1 * DM + c); }
#pragma unroll
                    for (int j = 0; j < 8; ++j) { const int c = lane * 4 + 256 * j; xb[j] = *(const u32x2*)(Xmid + (size_t)tb_ * DM + c); pb0[j] = *(const u32x2*)(OPERM + (size_t)c0 * DM + c); pb1[j] = *(const u32x2*)(OPERM + (size_t)c1 * DM + c); }
                    { const float* g2 = modl + (size_t)(t >> 12) * 12288 + 5 * 2048;
#pragma unroll
                      for (int j = 0; j < 8; ++j) { const int c = lane * 4 + 256 * j; const f32x4 gg = *(const f32x4*)(g2 + c); const u32x2 a = pa0[j], b = pa1[j]; const f32x4 x = bf4(xa[j]);
                        f32x4 o; o[0] = x[0] + gg[0] * (bf_lo(a.x) + bf_lo(b.x)); o[1] = x[1] + gg[1] * (bf_hi(a.x) + bf_hi(b.x)); o[2] = x[2] + gg[2] * (bf_lo(a.y) + bf_lo(b.y)); o[3] = x[3] + gg[3] * (bf_hi(a.y) + bf_hi(b.y));
                        *(f32x4*)(outp + (size_t)t * DM + c) = o; } }
                    if (hasB) { const float* g2 = modl + (size_t)(tB >> 12) * 12288 + 5 * 2048;
#pragma unroll
                      for (int j = 0; j < 8; ++j) { const int c = lane * 4 + 256 * j; const f32x4 gg = *(const f32x4*)(g2 + c); const u32x2 a = pb0[j], b = pb1[j]; const f32x4 x = bf4(xb[j]);
                        f32x4 o; o[0] = x[0] + gg[0] * (bf_lo(a.x) + bf_lo(b.x)); o[1] = x[1] + gg[1] * (bf_hi(a.x) + bf_hi(b.x)); o[2] = x[2] + gg[2] * (bf_lo(a.y) + bf_lo(b.y)); o[3] = x[3] + gg[3] * (bf_hi(a.y) + bf_hi(b.y));
                        *(f32x4*)(outp + (size_t)tB * DM + c) = o; } }
                }
            }
        }
    }
#undef IN
#undef SEAM
}

template <unsigned PM, unsigned MM> static int prep_kernel() {
    if (hipFuncSetAttribute((const void*)mk_fwd<PM, MM>, hipFuncAttributeMaxDynamicSharedMemorySize, LDS_BYTES) != hipSuccess) { fprintf(stderr, "kernel_launch: hipFuncSetAttribute failed\n"); return -1; }
    return 0;
}
template <unsigned PM, unsigned MM> static void launch_ph(int grid, Args a, int lo, int hi, hipStream_t stream) {
    static int ok = 0; if (ok == 0) ok = prep_kernel<PM, MM>() == 0 ? 1 : -1; if (ok < 0) return;
    a.ph_lo = lo; a.ph_hi = hi;
    hipLaunchKernelGGL((mk_fwd<PM, MM>), dim3(grid), dim3(512), LDS_BYTES, stream, a);
}
extern "C" void kernel_launch(void* const* d_in, const int* in_sizes, int n_in, void* d_out, int out_size, void* d_ws, size_t ws_size, hipStream_t stream) {
    static int grid = 0;
    if (grid == 0) {
        if (n_in != 24 || out_size != RL * DM || ws_size < WS_END) { fprintf(stderr, "kernel_launch: unexpected shapes (n_in %d out %d ws %zu need %zu)\n", n_in, out_size, ws_size, (size_t)WS_END); grid = -1; return; }
        int dev = 0, cus = 0;
        if (hipGetDevice(&dev) != hipSuccess || hipDeviceGetAttribute(&cus, hipDeviceAttributeMultiprocessorCount, dev) != hipSuccess) { grid = -1; return; }
        grid = cus;
    }
    if (grid < 0) return;
    (void)hipMemsetAsync((char*)d_ws + WS_CTL, 0, CTL_ZERO_BYTES, stream);
    Args a{};
    for (int i = 0; i < 24; ++i) a.in[i] = (const float*)d_in[i];
    a.out = (float*)d_out; a.ws = (unsigned char*)d_ws;
#if MK_ONE_LAUNCH
    launch_ph<0xFFFFFFFFu, 0xFFu>(grid, a, 0, 21, stream);
#else
    launch_ph<1u << 10, 0>(grid, a, 0, 1, stream);
    for (int l = 0; l < 2; ++l) { const int pb = 1 + 10 * l;
        launch_ph<1u << 0, 0>(grid, a, pb + 0, pb + 1, stream);
        launch_ph<1u << 1, 0>(grid, a, pb + 1, pb + 2, stream);
        launch_ph<1u << 2, 0>(grid, a, pb + 2, pb + 3, stream);
        launch_ph<1u << 3, 1u>(grid, a, pb + 3, pb + 4, stream);
        if (l == 0) launch_ph<1u << 3, 32u>(grid, a, pb + 3, pb + 4, stream);
        launch_ph<1u << 3, 2u>(grid, a, pb + 3, pb + 4, stream);
        launch_ph<1u << 3, 4u>(grid, a, pb + 3, pb + 4, stream);
        launch_ph<1u << 4, 0>(grid, a, pb + 4, pb + 5, stream);
        launch_ph<1u << 5, 0>(grid, a, pb + 5, pb + 6, stream);
        if (l == 0) { launch_ph<1u << 7, 0>(grid, a, pb + 7, pb + 8, stream); launch_ph<1u << 8, 0>(grid, a, pb + 8, pb + 9, stream); }
        else { launch_ph<1u << 11, 0>(grid, a, pb + 7, pb + 8, stream); launch_ph<1u << 12, 0>(grid, a, pb + 8, pb + 9, stream); launch_ph<1u << 9, 0>(grid, a, pb + 9, pb + 10, stream); }
    }
#endif
}
```

```cpp
#include <hip/hip_runtime.h>
#include <hip/hip_bf16.h>
#include <cstdio>
#include <cstdint>

#ifndef PROBE_DUP
#define PROBE_DUP 0u
#endif
#ifndef PROBE_SUB
#define PROBE_SUB 0u
#endif
#define SUBDUP(k) for (int _q = 0; _q < 1 + (int)((PROBE_SUB >> (k)) & 1u); ++_q)
#define DUP(k) for (int _r = 0; _r < 1 + (int)((PROBE_DUP >> (k)) & 1u); ++_r)
#define EN(k) (((PM) >> (k)) & 1u)
#define MX(k) (((MM) >> (k)) & 1u)
#ifndef MK_ONE_LAUNCH
#define MK_ONE_LAUNCH 1
#endif

#define LAS __attribute__((address_space(3)))
typedef unsigned short bf16_t;
typedef short bf16x8 __attribute__((ext_vector_type(8)));
typedef short s16x4 __attribute__((ext_vector_type(4)));
typedef float f32x4 __attribute__((ext_vector_type(4)));
typedef float f32x2 __attribute__((ext_vector_type(2)));
typedef float f32x16 __attribute__((ext_vector_type(16)));
typedef unsigned u32x4 __attribute__((ext_vector_type(4)));
typedef unsigned u32x2 __attribute__((ext_vector_type(2)));

constexpr int DM = 2048, NB = 4, SEQ = 4096, CTXL = 256;
constexpr int RL = NB * SEQ, RC = NB * CTXL, RT = RL + RC;
constexpr int NP = 4608;
constexpr int INW = 4608;
constexpr int KVL = CTXL + SEQ;
constexpr int DFF = 5632, NEXP = 8, DFE = 7168;
constexpr int MOE_TILES_MAX = 2 * RL / 256 + NEXP;
constexpr int MOE_ROWS_MAX = MOE_TILES_MAX * 256;
constexpr float NORM_EPS = 1e-6f;
constexpr int PC_V = 0, PC_CB = 512, PC_CC = 1024, PC_CV = 1536, PC_NQ = 2048, PC_NK = 2560, PC_NV = 3072, PC_GQ = 3584, PC_GK = 4096, PC_GV = 4352;
constexpr int PFW = 1024;

constexpr size_t MiB = 1u << 20;
constexpr size_t WS_CTL = 0, CTL_ZERO_BYTES = 1 * MiB;
constexpr size_t WS_MOD = 1 * MiB;
constexpr size_t WS_ROPE = 1 * MiB + 512 * 1024;
constexpr size_t WS_ROUTE = 2 * MiB;
constexpr size_t WS_T = 3 * MiB;
constexpr size_t WS_MB = 37 * MiB;
constexpr size_t WS_FFT = 1 * MiB + 768 * 1024;
constexpr size_t WS_TC = 67 * MiB;
constexpr size_t WS_WIN = 68 * MiB;
constexpr size_t WS_WOUT = 108 * MiB;
constexpr size_t WS_WUP = 124 * MiB;
constexpr size_t WS_WDN = 168 * MiB;
constexpr size_t WS_MUP = 190 * MiB;
constexpr size_t WS_MDN = 638 * MiB;
constexpr size_t WS_X1 = 862 * MiB;
constexpr size_t WS_X2 = 998 * MiB;
constexpr size_t WS_HB = 1134 * MiB;
constexpr size_t WS_S = 1202 * MiB;
constexpr size_t WS_P = WS_S;
constexpr size_t WS_NQ = WS_S + 170 * MiB;
constexpr size_t WS_NK = WS_NQ + 17 * MiB;
constexpr size_t WS_NV = WS_NK + 17 * MiB;
constexpr size_t WS_GQ = WS_NV + 17 * MiB;
constexpr size_t WS_GK = WS_GQ + 17 * MiB;
constexpr size_t WS_GV = WS_GK + 9 * MiB;
constexpr size_t WS_PF = WS_GV + 9 * MiB;
constexpr size_t WS_PTC = WS_PF + 34 * MiB;
constexpr size_t WS_Y = WS_PTC + 2 * MiB;
constexpr size_t WS_ACT = WS_S;
constexpr size_t WS_APERM = WS_S;
constexpr size_t WS_ACTM = WS_S + 136 * MiB;
constexpr size_t WS_OPERM = WS_X2;
constexpr size_t WS_END = WS_ACTM + 240 * MiB;
static_assert(WS_Y + 68 * MiB <= WS_END && WS_ACT + 187 * MiB <= WS_Y, "ws map");

constexpr int CW_BAR = 4096;
constexpr int CW_CNT = 8192;
constexpr int CW_POOL = 9344;
constexpr int CW_KS = 11264;
constexpr int CW_CDF = 9408;
constexpr int CW_TILE = 10240;

constexpr int LDS_BYTES = 147456;
constexpr int MISC_OFF = 131072;
constexpr int TL_OFF = MISC_OFF + 12288;
constexpr int RPB_OFF = MISC_OFF + 1024 + 512;
constexpr int ROUTER_LDS = 0;

#define GAS __attribute__((address_space(1)))
#define RLX_AGENT __ATOMIC_RELAXED, __HIP_MEMORY_SCOPE_AGENT
#define LDS_WAIT() asm volatile("s_waitcnt lgkmcnt(0)" ::: "memory")
#define VM_WAIT() asm volatile("s_waitcnt vmcnt(0)" ::: "memory")

__device__ __forceinline__ unsigned cvt_pk_bf16(float lo, float hi) { unsigned r; asm volatile("v_cvt_pk_bf16_f32 %0, %1, %2" : "=v"(r) : "v"(lo), "v"(hi)); return r; }
__device__ __forceinline__ float bf_lo(unsigned w) { return __uint_as_float(w << 16); }
__device__ __forceinline__ float bf_hi(unsigned w) { return __uint_as_float(w & 0xffff0000u); }
__device__ __forceinline__ f32x4 bf4(u32x2 w) { f32x4 r; r[0] = bf_lo(w.x); r[1] = bf_hi(w.x); r[2] = bf_lo(w.y); r[3] = bf_hi(w.y); return r; }
__device__ __forceinline__ float wave_sum(float v) {
#pragma unroll
    for (int o = 1; o < 64; o <<= 1) v += __shfl_xor(v, o);
    return v;
}
constexpr float F8_SW = 64.0f, F8_SH = 2.0f, F8_SA = 4.0f;
__device__ __forceinline__ float clamp448(float x) { return __builtin_amdgcn_fmed3f(x, -448.0f, 448.0f); }
__device__ __forceinline__ unsigned pk4_fp8(float a, float b, float c, float d) { int w = 0; w = __builtin_amdgcn_cvt_pk_fp8_f32(clamp448(a), clamp448(b), w, false); w = __builtin_amdgcn_cvt_pk_fp8_f32(clamp448(c), clamp448(d), w, true); return (unsigned)w; }
__device__ __forceinline__ float silu_f(float a) { return a / (1.0f + __expf(-a)); }

namespace pg8 {
constexpr int BM = 256, BK = 64, HALF = 128, HTB = HALF * BK * 2, STAGE_BYTES = 8 * HTB, NXCD = 8, WGM = 8;
__host__ __device__ __forceinline__ int lds_byte(int r, int c) { const int st = (r >> 4) * 2 + (c >> 5), rr = r & 15, cc = c & 31, ob = rr * 64 + cc * 2; return st * 1024 + (ob ^ (((ob >> 9) & 1) << 5)); }
__host__ __device__ __forceinline__ void stage_rc(int b, int& R, int& C) { const int st = b / 1024, sb = b % 1024, swz = sb ^ (((sb >> 9) & 1) << 5); R = (st >> 1) * 16 + swz / 64; C = (st & 1) * 32 + (swz % 64) / 2; }
__host__ __device__ __forceinline__ int perm32(int rho) { const int n = rho >> 4, i = rho & 15; return 8 * (i >> 2) + 4 * n + (i & 3); }

typedef int i32x4 __attribute__((ext_vector_type(4)));
typedef int i32x8 __attribute__((ext_vector_type(8)));
__device__ __forceinline__ i32x8 cat8(bf16x8 a, bf16x8 b) { const i32x4 x = __builtin_bit_cast(i32x4, a), y = __builtin_bit_cast(i32x4, b); return __builtin_shufflevector(x, y, 0, 1, 2, 3, 4, 5, 6, 7); }
struct Unit { int arow, brow, orow, ocol; };
struct Gemm { const void* A; const void* Bt; int rb; int kb = 0; };

struct GridOrder {
    int nM, nN, nwg, G, c, arow0, brow0, orow0, ocol0, ocstep;
    __device__ void init(int nM_, int nN_, int G_, int c_, int arow0_, int brow0_, int orow0_, int ocol0_, int ocstep_) { nM = nM_; nN = nN_; nwg = nM * nN; G = G_; c = c_; asm volatile("" : "+s"(c)); arow0 = arow0_; brow0 = brow0_; orow0 = orow0_; ocol0 = ocol0_; ocstep = ocstep_; }
    __device__ __forceinline__ bool next(int i, Unit& u) const {
        const long L = (long)i * G + c; if (L >= nwg) return false;
        int wgid = (int)L; { const int q = nwg / NXCD, r = nwg % NXCD, xcd = wgid % NXCD, off = wgid / NXCD; wgid = (xcd < r ? xcd * (q + 1) : r * (q + 1) + (xcd - r) * q) + off; }
        const int nig = WGM * nN, gid = wgid / nig, fm = gid * WGM, gsz = (nM - fm) < WGM ? (nM - fm) : WGM;
        const int pm = __builtin_amdgcn_readfirstlane(fm + ((wgid % nig) % gsz)), pn = __builtin_amdgcn_readfirstlane((wgid % nig) / gsz);
        u.arow = arow0 + 256 * pm; u.brow = brow0 + 256 * pn; u.orow = orow0 + 256 * pm; u.ocol = ocol0 + ocstep * pn; return true;
    }
};
struct InProjOrder {
    GridOrder go; int nctxcols;
    __device__ void init(int G_, int c_, int kv_only) { go.init(RL / 256, NP / 256, G_, c_, 0, 0, 0, 0, 256); nctxcols = kv_only ? 6 : NP / 256; }
    __device__ __forceinline__ bool next(int i, Unit& u) const {
        const int L = i * go.G + go.c, nlat = (RL / 256) * (NP / 256);
        if (L < nlat) return go.next(i, u);
        const int q = L - nlat; if (q >= 4 * nctxcols) return false;
        const int pm = RL / 256 + q / nctxcols, j = q % nctxcols; const int pn = nctxcols == 6 ? (j < 4 ? 10 + j : 12 + j) : j;
        u.arow = 256 * pm; u.brow = 256 * pn; u.orow = 256 * pm; u.ocol = 256 * pn; return true;
    }
};
struct DftOrder {
    int c, ctx;
    __device__ __forceinline__ bool next(int i, Unit& u) const {
        if (i > 0) return false;
        if (!ctx) { if (c >= 128) return false; const int b = c >> 5, pm = (c & 31) >> 1, pn = c & 1; u.arow = 256 * pm; u.brow = b * 512 + 256 * pn; u.orow = b * SEQ + 256 * pm; u.ocol = 256 * pn; return true; }
        if (c >= 8) return false; const int b = c >> 1, pn = c & 1; u.arow = 0; u.brow = b * 512 + 256 * pn; u.orow = RL + b * CTXL; u.ocol = 256 * pn; return true;
    }
};
struct MoeOrder {
    int G, c, nN, ocstep, brow_per_exp; const volatile LAS int* tb; const volatile LAS int* tl; int lmax = 0x7fffffff;
    __device__ __forceinline__ bool next(int i, Unit& u) const { const int L = i * G + c; if (L >= lmax) return false; return unit(L, u); }
    __device__ __forceinline__ bool unit(int L, Unit& u) const {
        const int total = tb[8] * nN; if (L >= total) return false;
        int w; { const int q = total / NXCD, r = total % NXCD, xcd = L % NXCD, off = L / NXCD; w = (xcd < r ? xcd * (q + 1) : r * (q + 1) + (xcd - r) * q) + off; }
        int e = 0;
#pragma unroll
        for (int j = 1; j < 8; ++j) if (w >= tb[j] * nN) e = j;
        const int t0 = tb[e], nt = tb[e + 1] - t0, q2 = w - t0 * nN;
        const int nig = WGM * nN, gid = q2 / nig, fm = gid * WGM, gsz = (nt - fm) < WGM ? (nt - fm) : WGM;
        const int pml = fm + ((q2 % nig) % gsz), pn = (q2 % nig) / gsz;
        u.arow = __builtin_amdgcn_readfirstlane(tl[t0 + pml] * 256); u.brow = __builtin_amdgcn_readfirstlane(e * brow_per_exp + pn * 256); u.orow = u.arow; u.ocol = __builtin_amdgcn_readfirstlane(pn * ocstep); return true;
    }
};

struct MoeTailOrder { MoeOrder mo; int L; __device__ __forceinline__ bool next(int i, Unit& u) const { if (i > 0 || L < 0) return false; return mo.unit(L, u); } };

struct EpiStoreBf16 {
    static constexpr bool PERM = true;
    bf16_t* O; int ldc; int bjstep = HALF;
    __device__ __forceinline__ void operator()(const f32x4 (&acc)[2][2][4][2], const Unit& u, int wr, int wc, int fr, int fq) const {
        const int row0 = u.orow + wr * 64 + fr, col0 = u.ocol + wc * 32 + 8 * fq;
#pragma unroll
        for (int ai = 0; ai < 2; ++ai)
#pragma unroll
            for (int m = 0; m < 4; ++m) { bf16_t* rowp = O + (size_t)(row0 + ai * HALF + m * 16) * ldc + col0;
#pragma unroll
                for (int bj = 0; bj < 2; ++bj) { const f32x4 v0 = acc[ai][bj][m][0], v1 = acc[ai][bj][m][1];
                    u32x4 w; w.x = cvt_pk_bf16(v0[0], v0[1]); w.y = cvt_pk_bf16(v0[2], v0[3]); w.z = cvt_pk_bf16(v1[0], v1[1]); w.w = cvt_pk_bf16(v1[2], v1[3]);
                    *(u32x4*)(rowp + bj * bjstep) = w; } }
    }
};
struct EpiInProj {
    static constexpr bool PERM = true;
    bf16_t* P; bf16_t* NV; bf16_t* GV;
    __device__ __forceinline__ void operator()(const f32x4 (&acc)[2][2][4][2], const Unit& u, int wr, int wc, int fr, int fq) const {
        bf16_t* O = P; int ldc = NP, orow = u.orow, ocol = u.ocol;
        const int kvr = u.orow < RL ? (u.orow >> 12) * KVL + CTXL + (u.orow & 4095) : ((u.orow - RL) >> 8) * KVL;
        if (ocol >= PC_NV && ocol < PC_NV + 512) { O = NV; ldc = 512; orow = kvr; ocol -= PC_NV; }
        else if (ocol >= PC_GV) { O = GV; ldc = 256; orow = kvr; ocol -= PC_GV; }
        const int row0 = orow + wr * 64 + fr, col0 = ocol + wc * 32 + 8 * fq;
#pragma unroll
        for (int ai = 0; ai < 2; ++ai)
#pragma unroll
            for (int m = 0; m < 4; ++m) { bf16_t* rowp = O + (size_t)(row0 + ai * HALF + m * 16) * ldc + col0;
#pragma unroll
                for (int bj = 0; bj < 2; ++bj) { const f32x4 v0 = acc[ai][bj][m][0], v1 = acc[ai][bj][m][1];
                    u32x4 w; w.x = cvt_pk_bf16(v0[0], v0[1]); w.y = cvt_pk_bf16(v0[2], v0[3]); w.z = cvt_pk_bf16(v1[0], v1[1]); w.w = cvt_pk_bf16(v1[2], v1[3]);
                    *(u32x4*)(rowp + bj * HALF) = w; } }
    }
};
struct EpiResid {
    static constexpr bool PERM = true;
    const float* res_lat; const float* res_ctx; const bf16_t* res_b; bf16_t* out; const float* gate; float sc;
    __device__ __forceinline__ void operator()(const f32x4 (&acc)[2][2][4][2], const Unit& u, int wr, int wc, int fr, int fq) const {
        const int col0 = u.ocol + wc * 32 + 8 * fq; const int mrow = u.orow < RL ? (u.orow >> 12) : 4;
        const float* rf = u.orow < RL ? res_lat + (size_t)u.orow * DM : res_ctx + (size_t)(u.orow - RL) * DM;
        const bool rbf = res_b != nullptr;
        f32x4 gv[2][2];
#pragma unroll
        for (int bj = 0; bj < 2; ++bj)
#pragma unroll
            for (int n = 0; n < 2; ++n) gv[bj][n] = *(const f32x4*)(gate + (size_t)mrow * 12288 + col0 + bj * HALF + n * 4);
#pragma unroll
        for (int ai = 0; ai < 2; ++ai)
#pragma unroll
            for (int m = 0; m < 4; ++m) { const size_t off = (size_t)(wr * 64 + fr + ai * HALF + m * 16) * DM + col0;
#pragma unroll
                for (int bj = 0; bj < 2; ++bj) { f32x4 r0, r1;
                    if (rbf) { const u32x4 rr = *(const u32x4*)(res_b + (size_t)u.orow * DM + off + bj * HALF);
                        r0[0] = bf_lo(rr.x); r0[1] = bf_hi(rr.x); r0[2] = bf_lo(rr.y); r0[3] = bf_hi(rr.y); r1[0] = bf_lo(rr.z); r1[1] = bf_hi(rr.z); r1[2] = bf_lo(rr.w); r1[3] = bf_hi(rr.w); }
                    else { r0 = *(const f32x4*)(rf + off + bj * HALF); r1 = *(const f32x4*)(rf + off + bj * HALF + 4); }
                    const f32x4 v0 = r0 + gv[bj][0] * (acc[ai][bj][m][0] * sc), v1 = r1 + gv[bj][1] * (acc[ai][bj][m][1] * sc);
                    u32x4 w; w.x = cvt_pk_bf16(v0[0], v0[1]); w.y = cvt_pk_bf16(v0[2], v0[3]); w.z = cvt_pk_bf16(v1[0], v1[1]); w.w = cvt_pk_bf16(v1[2], v1[3]);
                    *(u32x4*)(out + (size_t)u.orow * DM + off + bj * HALF) = w; } }
    }
};
struct EpiSwiglu8 {
    static constexpr bool PERM = true;
    unsigned char* O; int ldc; float inv, osc;
    __device__ __forceinline__ void operator()(const f32x4 (&acc)[2][2][4][2], const Unit& u, int wr, int wc, int fr, int fq) const {
        const int row0 = u.orow + wr * 64 + fr, col0 = u.ocol + wc * 32 + 8 * fq;
        const float io = inv * osc, c1 = -1.4426950408889634f * inv, kk = 1.0f / (inv * io);
#pragma unroll
        for (int ai = 0; ai < 2; ++ai)
#pragma unroll
            for (int m = 0; m < 4; ++m) { unsigned char* rowp = O + (size_t)(row0 + ai * HALF + m * 16) * ldc + col0;
                float v[8];
#pragma unroll
                for (int n = 0; n < 2; ++n)
#pragma unroll
                    for (int j = 0; j < 4; ++j) { const float x0 = acc[ai][0][m][n][j], x1 = acc[ai][1][m][n][j];
                        const float t = __builtin_amdgcn_exp2f(x0 * c1); v[n * 4 + j] = (x0 * x1) * __builtin_amdgcn_rcpf(__builtin_fmaf(t, kk, kk)); }
                u32x2 w; w.x = pk4_fp8(v[0], v[1], v[2], v[3]); w.y = pk4_fp8(v[4], v[5], v[6], v[7]);
                *(u32x2*)rowp = w; }
    }
};
struct EpiMoeDown {
    static constexpr bool PERM = true;
    bf16_t* O; const float* roww; float sc;
    __device__ __forceinline__ void operator()(const f32x4 (&acc)[2][2][4][2], const Unit& u, int wr, int wc, int fr, int fq) const {
        const int row0 = u.orow + wr * 64 + fr, col0 = u.ocol + wc * 32 + 8 * fq;
#pragma unroll
        for (int ai = 0; ai < 2; ++ai)
#pragma unroll
            for (int m = 0; m < 4; ++m) { const int row = row0 + ai * HALF + m * 16; const float rw = roww[row] * sc; bf16_t* rowp = O + (size_t)row * DM + col0;
#pragma unroll
                for (int bj = 0; bj < 2; ++bj) { const f32x4 v0 = acc[ai][bj][m][0] * rw, v1 = acc[ai][bj][m][1] * rw;
                    u32x4 w; w.x = cvt_pk_bf16(v0[0], v0[1]); w.y = cvt_pk_bf16(v0[2], v0[3]); w.z = cvt_pk_bf16(v1[0], v1[1]); w.w = cvt_pk_bf16(v1[2], v1[3]);
                    *(u32x4*)(rowp + bj * HALF) = w; } }
    }
};

struct EpiPartial {
    static constexpr bool PERM = true;
    float* slab;
    __device__ __forceinline__ void operator()(const f32x4 (&acc)[2][2][4][2], const Unit&, int wr, int wc, int fr, int fq) const {
        const int row0 = wr * 64 + fr, col0 = wc * 32 + 8 * fq;
#pragma unroll
        for (int ai = 0; ai < 2; ++ai)
#pragma unroll
            for (int m = 0; m < 4; ++m) { float* rowp = slab + (size_t)(row0 + ai * HALF + m * 16) * 256 + col0;
#pragma unroll
                for (int bj = 0; bj < 2; ++bj) { *(f32x4*)(rowp + bj * HALF) = acc[ai][bj][m][0]; *(f32x4*)(rowp + bj * HALF + 4) = acc[ai][bj][m][1]; } }
    }
};

template <class Epi, class Sched, bool F8 = false, bool ALIGN_EPI = true, bool SP2 = true>
__device__ __forceinline__ void gemm_phase(LAS unsigned char* lds, const Gemm g, const Sched& S, const Epi& E) {
    int tid = threadIdx.x; asm volatile("" : "+v"(tid));
    const int wid = __builtin_amdgcn_readfirstlane(tid >> 6), lane = tid & 63, wr = wid >> 2, wc = wid & 3, fr = lane & 15, fq = lane >> 4;
    int RB = g.rb; asm volatile("" : "+s"(RB)); int KB_ = g.kb ? g.kb : g.rb; asm volatile("" : "+s"(KB_)); const int nt = KB_ / (2 * BK);
    unsigned voffA[2], voffB[2];
#pragma unroll
    for (int i = 0; i < 2; ++i) { int R, C; stage_rc(tid * 16 + i * 8192, R, C); const int Rb = Epi::PERM ? ((R & ~31) + perm32(R & 31)) : R;
        voffA[i] = (unsigned)(R * RB + C * 2); voffB[i] = (unsigned)(Rb * RB + C * 2); }
    const size_t kstep = (size_t)(BK * 2);
    const size_t hstep = (size_t)HALF * RB;
    const size_t rstep = (size_t)RB;
    const unsigned ldsw = (unsigned)wid * 1024u;
    const int aoff = lds_byte(wr * 64 + fr, fq * 8), boff = lds_byte(wc * 32 + fr, fq * 8);
#define PG8_SA(b, h) (((b) * 2 + (h)) * HTB)
#define PG8_SB(b, h) ((4 + (b) * 2 + (h)) * HTB)
#define PG8_STAGE(bufoff, gbase, voff) do { _Pragma("unroll") for (int _i = 0; _i < 2; ++_i) \
        __builtin_amdgcn_global_load_lds((const unsigned*)((const char*)(gbase) + (voff)[_i]), (LAS unsigned*)(lds + (bufoff) + ldsw + _i * 8192), 16, 0, 0); } while (0)
#define PG8_LDA(dst, b, h) do { _Pragma("unroll") for (int m = 0; m < 4; ++m) _Pragma("unroll") for (int k = 0; k < 2; ++k) dst[m][k] = *(const LAS bf16x8*)(lds + PG8_SA(b, h) + aoff + m * 2048 + k * 1024); } while (0)
#define PG8_LDB(dst, b, h) do { _Pragma("unroll") for (int n = 0; n < 2; ++n) _Pragma("unroll") for (int k = 0; k < 2; ++k) dst[n][k] = *(const LAS bf16x8*)(lds + PG8_SB(b, h) + boff + n * 2048 + k * 1024); } while (0)
#define PG8_MMA(ai, bj, At, Bt) do { __builtin_amdgcn_s_setprio(1); _Pragma("unroll") for (int m = 0; m < 4; ++m) _Pragma("unroll") for (int n = 0; n < 2; ++n) { \
        if constexpr (F8) { asm volatile("v_mfma_scale_f32_16x16x128_f8f6f4 %0, %1, %2, %0, %3, %3 op_sel_hi:[0,0,0]" : "+v"(acc[ai][bj][m][n]) : "v"(cat8(Bt[n][0], Bt[n][1])), "v"(cat8(At[m][0], At[m][1])), "v"(f8scale)); } \
        else { _Pragma("unroll") for (int k = 0; k < 2; ++k) acc[ai][bj][m][n] = __builtin_amdgcn_mfma_f32_16x16x32_bf16(Bt[n][k], At[m][k], acc[ai][bj][m][n], 0, 0, 0); } } __builtin_amdgcn_s_setprio(0); } while (0)
#define PG8_WAIT_V(n) asm volatile("s_waitcnt vmcnt(" #n ")" ::: "memory")
#define PG8_WAIT_L(n) asm volatile("s_waitcnt lgkmcnt(" #n ")" ::: "memory")
#define PG8_BAR __builtin_amdgcn_s_barrier()
#define PG8_SCHED __builtin_amdgcn_sched_barrier(0)
    Unit cur, nxt; int ui = 0;
    if (!S.next(0, cur)) return;
    f32x4 acc[2][2][4][2];
#pragma unroll
    for (int a = 0; a < 2; ++a)
#pragma unroll
        for (int b = 0; b < 2; ++b)
#pragma unroll
            for (int m = 0; m < 4; ++m)
#pragma unroll
                for (int n = 0; n < 2; ++n) acc[a][b][m][n] = (f32x4){0.f, 0.f, 0.f, 0.f};
    bf16x8 At[4][2], B0[2][2], B1[2][2];
    int f8scale = 0x7f7f7f7f; asm volatile("" : "+v"(f8scale));
    const char* cA = (const char*)g.A + (size_t)cur.arow * rstep; const char* cB = (const char*)g.Bt + (size_t)cur.brow * rstep;
    if constexpr (SP2) {
        PG8_STAGE(PG8_SB(0, 0), cB, voffB); PG8_STAGE(PG8_SB(0, 1), cB + hstep, voffB); PG8_STAGE(PG8_SA(0, 0), cA, voffA); PG8_STAGE(PG8_SA(0, 1), cA + hstep, voffA);
        if (wr == 1) PG8_BAR;
        PG8_WAIT_V(2); PG8_BAR;
        PG8_STAGE(PG8_SB(1, 0), cB + kstep, voffB); PG8_STAGE(PG8_SA(1, 0), cA + kstep, voffA); PG8_STAGE(PG8_SB(1, 1), cB + hstep + kstep, voffB);
        PG8_WAIT_V(6); PG8_BAR;
    } else {
        PG8_STAGE(PG8_SB(0, 0), cB, voffB); PG8_STAGE(PG8_SA(0, 0), cA, voffA); PG8_STAGE(PG8_SB(0, 1), cB + hstep, voffB); PG8_STAGE(PG8_SA(0, 1), cA + hstep, voffA);
        if (wr == 1) PG8_BAR;
        PG8_WAIT_V(4); PG8_BAR;
        PG8_STAGE(PG8_SB(1, 0), cB + kstep, voffB); PG8_STAGE(PG8_SA(1, 0), cA + kstep, voffA); PG8_STAGE(PG8_SB(1, 1), cB + hstep + kstep, voffB);
        PG8_WAIT_V(6); PG8_BAR;
    }
    for (;;) {
        const bool has_next = S.next(ui + 1, nxt);
        const char* nA = has_next ? (const char*)g.A + (size_t)nxt.arow * rstep : cA; const char* nB = has_next ? (const char*)g.Bt + (size_t)nxt.brow * rstep : cB;
        for (int t = 0; t < nt; t += 2) {
            const bool last = (t == nt - 2);
            const char* a1 = cA + (size_t)(t + 1) * kstep;
            const char* a2 = last ? nA : cA + (size_t)(t + 2) * kstep; const char* b2 = last ? nB : cB + (size_t)(t + 2) * kstep;
            const char* a3 = a2 + kstep; const char* b3 = b2 + kstep;
            if constexpr (SP2) {
            PG8_LDB(B0, 0, 0); PG8_LDB(B1, 0, 1); PG8_SCHED; PG8_LDA(At, 0, 0); PG8_STAGE(PG8_SA(1, 1), a1 + hstep, voffA);
            PG8_WAIT_V(8); PG8_WAIT_L(0); PG8_BAR; PG8_MMA(0, 0, At, B0); PG8_MMA(0, 1, At, B1); PG8_BAR; PG8_SCHED;
            PG8_LDA(At, 0, 1); PG8_STAGE(PG8_SB(0, 0), b2, voffB); PG8_STAGE(PG8_SB(0, 1), b2 + hstep, voffB); PG8_STAGE(PG8_SA(0, 0), a2, voffA);
            PG8_WAIT_V(8); PG8_WAIT_L(0); PG8_BAR; PG8_MMA(1, 0, At, B0); PG8_MMA(1, 1, At, B1); PG8_BAR; PG8_SCHED;
            PG8_LDB(B0, 1, 0); PG8_LDB(B1, 1, 1); PG8_SCHED; PG8_LDA(At, 1, 0); PG8_STAGE(PG8_SA(0, 1), a2 + hstep, voffA);
            PG8_WAIT_V(8); PG8_WAIT_L(0); PG8_BAR; PG8_MMA(0, 0, At, B0); PG8_MMA(0, 1, At, B1); PG8_BAR; PG8_SCHED;
            PG8_LDA(At, 1, 1); PG8_STAGE(PG8_SB(1, 0), b3, voffB); PG8_STAGE(PG8_SB(1, 1), b3 + hstep, voffB); PG8_STAGE(PG8_SA(1, 0), a3, voffA);
            PG8_WAIT_V(8); PG8_WAIT_L(0); PG8_BAR; PG8_MMA(1, 0, At, B0); PG8_MMA(1, 1, At, B1); PG8_BAR; PG8_SCHED;
            } else {
            PG8_LDB(B0, 0, 0); PG8_SCHED; PG8_LDA(At, 0, 0); PG8_STAGE(PG8_SA(1, 1), a1 + hstep, voffA);
            PG8_WAIT_L(8); PG8_BAR; PG8_WAIT_L(0); PG8_MMA(0, 0, At, B0); PG8_BAR; PG8_SCHED;
            PG8_LDB(B1, 0, 1); PG8_STAGE(PG8_SB(0, 0), b2, voffB);
            PG8_BAR; PG8_WAIT_L(0); PG8_MMA(0, 1, At, B1); PG8_BAR;
            PG8_LDA(At, 0, 1); PG8_STAGE(PG8_SA(0, 0), a2, voffA);
            PG8_BAR; PG8_WAIT_L(0); PG8_MMA(1, 0, At, B0); PG8_BAR; PG8_SCHED;
            PG8_STAGE(PG8_SB(0, 1), b2 + hstep, voffB);
            PG8_WAIT_V(6); PG8_BAR; PG8_MMA(1, 1, At, B1); PG8_BAR;
            PG8_LDB(B0, 1, 0); PG8_SCHED; PG8_LDA(At, 1, 0); PG8_STAGE(PG8_SA(0, 1), a2 + hstep, voffA);
            PG8_WAIT_L(8); PG8_BAR; PG8_WAIT_L(0); PG8_MMA(0, 0, At, B0); PG8_BAR; PG8_SCHED;
            PG8_LDB(B1, 1, 1); PG8_STAGE(PG8_SB(1, 0), b3, voffB);
            PG8_BAR; PG8_WAIT_L(0); PG8_MMA(0, 1, At, B1); PG8_BAR;
            PG8_LDA(At, 1, 1); PG8_STAGE(PG8_SA(1, 0), a3, voffA);
            PG8_BAR; PG8_WAIT_L(0); PG8_MMA(1, 0, At, B0); PG8_BAR; PG8_SCHED;
            PG8_STAGE(PG8_SB(1, 1), b3 + hstep, voffB);
            PG8_WAIT_V(6); PG8_BAR; PG8_MMA(1, 1, At, B1); PG8_BAR;
            }
        }
        if constexpr (F8) { asm volatile("s_nop 15\n\ts_nop 15" ::: "memory"); }
        else { asm volatile("s_nop 15\n\ts_nop 15" : "+v"(acc[1][1][3][1]) :: "memory"); }
        if constexpr (ALIGN_EPI) { if (wr == 0) PG8_BAR; }
        E(acc, cur, wr, wc, fr, fq);
        if (!has_next) break;
#pragma unroll
        for (int a = 0; a < 2; ++a)
#pragma unroll
            for (int b = 0; b < 2; ++b)
#pragma unroll
                for (int m = 0; m < 4; ++m)
#pragma unroll
                    for (int n = 0; n < 2; ++n) acc[a][b][m][n] = (f32x4){0.f, 0.f, 0.f, 0.f};
        cur = nxt; cA = nA; cB = nB; ++ui;
        if constexpr (ALIGN_EPI) { if (wr == 1) PG8_BAR; }
    }
    PG8_WAIT_V(0);
    if constexpr (!ALIGN_EPI) { if (wr == 0) PG8_BAR; }
    PG8_BAR;
#undef PG8_SA
#undef PG8_SB
#undef PG8_STAGE
#undef PG8_LDA
#undef PG8_LDB
#undef PG8_MMA
#undef PG8_WAIT_V
#undef PG8_WAIT_L
#undef PG8_BAR
#undef PG8_SCHED
}
}

namespace att {
constexpr int D = 128, NW = 8, QBLK = 32, KVBLK = 64;
constexpr float SCALE = 0.088388347648318440f;
constexpr float THR = 8.f;
constexpr float LOG2E = 1.4426950408889634f;
constexpr size_t SHM_V = KVBLK * D * 2, SHM_K = KVBLK * D * 2, SHM_ATTN = 2 * SHM_V + 2 * SHM_K + NW * 64 * 4;
#define KSWZ(row, colB) ((row) * 256 + ((colB) ^ (((row) & 7) << 4)))
#define SBAR() __builtin_amdgcn_sched_barrier(0)
__device__ __forceinline__ int crow(int r, int hi) { return (r & 3) + 8 * (r >> 2) + 4 * hi; }
__device__ __forceinline__ unsigned cvtpk(float lo, float hi) { unsigned r; asm volatile("v_cvt_pk_bf16_f32 %0, %1, %2" : "=v"(r) : "v"(lo), "v"(hi)); return r; }

struct NaInfo { const LAS float* rpb; int qrow, rs, c, cs, rlo; };

__device__ __forceinline__ void partialSM(f32x16& p0, f32x16& p1, float& m_reg, float& mn, float& alpha) {
  constexpr float C = SCALE * LOG2E;
  float pmax = p0[0];
#pragma unroll
  for (int r = 1; r < 16; ++r) pmax = fmaxf(pmax, p0[r]);
#pragma unroll
  for (int r = 0; r < 16; ++r) pmax = fmaxf(pmax, p1[r]);
  { auto rr = __builtin_amdgcn_permlane32_swap(__float_as_uint(pmax), __float_as_uint(pmax), false, false);
    pmax = fmaxf(__uint_as_float(rr[0]), __uint_as_float(rr[1])); }
  if (__builtin_expect(__all(pmax - m_reg <= THR / SCALE), 1)) { mn = m_reg; alpha = 1.f; }
  else { mn = fmaxf(m_reg, pmax); alpha = __builtin_amdgcn_exp2f((m_reg - mn) * C); m_reg = mn; }
  float mnC = -mn * C;
#pragma unroll
  for (int r = 0; r < 16; ++r) p0[r] = fmaf(p0[r], C, mnC);
#pragma unroll
  for (int r = 0; r < 16; ++r) p1[r] = fmaf(p1[r], C, mnC);
#pragma unroll
  for (int r = 0; r < 16; ++r) p0[r] = __builtin_amdgcn_exp2f(p0[r]);
}
__device__ __forceinline__ void partialSM_na(f32x16& p0, f32x16& p1, float& m_reg, float& mn, float& alpha, int tile, const NaInfo& na, int hi) {
  constexpr float C = SCALE * LOG2E;
  if (tile < 4) {
#pragma unroll
    for (int r = 0; r < 16; ++r) { p0[r] *= C; p1[r] *= C; }
  } else {
    const int krow = na.rlo + tile - 4;
    const bool rowvalid = (krow >= na.rs) && (krow < na.rs + 8);
    if (rowvalid) {
      const int dr = krow - na.qrow + 7;
      const LAS float* bp = na.rpb + dr * 31 + (15 - na.c + 4 * hi);
      const int kc0 = 4 * hi;
#pragma unroll
      for (int r = 0; r < 16; ++r) { const int ko = (r & 3) + 8 * (r >> 2);
        const int kcA = kc0 + ko, kcB = kcA + 32;
        const float bA = bp[ko], bB = bp[ko + 32];
        const bool vA = (kcA >= na.cs) && (kcA < na.cs + 16), vB = (kcB >= na.cs) && (kcB < na.cs + 16);
        p0[r] = vA ? fmaf(p0[r], C, bA) : -1e30f; p1[r] = vB ? fmaf(p1[r], C, bB) : -1e30f; }
    } else {
#pragma unroll
      for (int r = 0; r < 16; ++r) { p0[r] = -1e30f; p1[r] = -1e30f; }
    }
  }
  float pmax = p0[0];
#pragma unroll
  for (int r = 1; r < 16; ++r) pmax = fmaxf(pmax, p0[r]);
#pragma unroll
  for (int r = 0; r < 16; ++r) pmax = fmaxf(pmax, p1[r]);
  { auto rr = __builtin_amdgcn_permlane32_swap(__float_as_uint(pmax), __float_as_uint(pmax), false, false);
    pmax = fmaxf(__uint_as_float(rr[0]), __uint_as_float(rr[1])); }
  if (__builtin_expect(__all(pmax - m_reg <= THR * LOG2E), 1)) { mn = m_reg; alpha = 1.f; }
  else { mn = fmaxf(m_reg, pmax); alpha = __builtin_amdgcn_exp2f(m_reg - mn); m_reg = mn; }
#pragma unroll
  for (int r = 0; r < 16; ++r) p0[r] = __builtin_amdgcn_exp2f(p0[r] - mn);
#pragma unroll
  for (int r = 0; r < 16; ++r) p1[r] = p1[r] - mn;
}
__device__ __forceinline__ void finishSM(f32x16& p0, f32x16& p1, float alpha, float& l_reg, bf16x8& pa0, bf16x8& pa1, bf16x8& pa2, bf16x8& pa3) {
#pragma unroll
  for (int r = 0; r < 16; ++r) p1[r] = __builtin_amdgcn_exp2f(p1[r]);
  float ps = 0;
#pragma unroll
  for (int r = 0; r < 16; ++r) ps += p0[r];
#pragma unroll
  for (int r = 0; r < 16; ++r) ps += p1[r];
  { auto rr = __builtin_amdgcn_permlane32_swap(__float_as_uint(ps), __float_as_uint(ps), false, false);
    ps = __uint_as_float(rr[0]) + __uint_as_float(rr[1]); }
  l_reg = l_reg * alpha + ps;
#define PK4(P, BASE, OUT) do { unsigned a0 = cvtpk(P[BASE + 0], P[BASE + 1]), a1 = cvtpk(P[BASE + 2], P[BASE + 3]);   \
    unsigned b0 = cvtpk(P[BASE + 4], P[BASE + 5]), b1 = cvtpk(P[BASE + 6], P[BASE + 7]);                              \
    auto r0 = __builtin_amdgcn_permlane32_swap(a0, b0, false, false); auto r1 = __builtin_amdgcn_permlane32_swap(a1, b1, false, false); \
    u32x4 w = {r0[0], r1[0], r0[1], r1[1]}; OUT = *reinterpret_cast<bf16x8*>(&w); } while (0)
  PK4(p0, 0, pa0); PK4(p0, 8, pa1); PK4(p1, 0, pa2); PK4(p1, 8, pa3);
#undef PK4
}
__device__ __forceinline__ void qkt(f32x16& p0, f32x16& p1, const bf16_t* Ks, const bf16x8* qr, int r32, int hi) {
  p0 = f32x16{}; p1 = f32x16{};
#pragma unroll
  for (int d0 = 0; d0 < 8; ++d0) { int cb = (d0 * 16 + hi * 8) * 2;
    bf16x8 b0 = *reinterpret_cast<const bf16x8*>((const char*)Ks + KSWZ(r32, cb));
    bf16x8 b1 = *reinterpret_cast<const bf16x8*>((const char*)Ks + KSWZ(32 + r32, cb));
    p0 = __builtin_amdgcn_mfma_f32_32x32x16_bf16(b0, qr[d0], p0, 0, 0, 0);
    p1 = __builtin_amdgcn_mfma_f32_32x32x16_bf16(b1, qr[d0], p1, 0, 0, 0); }
}
__device__ __forceinline__ int v_st(int k, int c) { const int kk = (k & ~0xC) | ((k & 4) << 1) | ((k & 8) >> 1); return ((kk >> 3) * 4 + (c >> 5)) * 512 + ((kk & 7) * 32 + (c & 31)) * 2; }
__device__ __forceinline__ int v_rd_base(int lane) { return ((lane & 3) << 3) | (((lane >> 2) & 3) << 6) | (((lane >> 4) & 1) << 5) | (((lane >> 5) & 1) << 8); }
constexpr int v_rd_off(int d0, int ks, int half) { return d0 * 512 + ks * 4096 + half * 2048; }
template <int OFF> __device__ __forceinline__ s16x4 tr_read(int vb) {
  s16x4 r; asm volatile("ds_read_b64_tr_b16 %0, %1 offset:%2" : "=&v"(r) : "v"(vb), "i"(OFF) : "memory"); return r;
}
template <int D0> __device__ __forceinline__ void pv_one(f32x16& od, int vb, bf16x8 pa0, bf16x8 pa1, bf16x8 pa2, bf16x8 pa3) {
  const s16x4 l0 = tr_read<v_rd_off(D0, 0, 0)>(vb), h0 = tr_read<v_rd_off(D0, 0, 1)>(vb), l1 = tr_read<v_rd_off(D0, 1, 0)>(vb), h1 = tr_read<v_rd_off(D0, 1, 1)>(vb);
  const s16x4 l2 = tr_read<v_rd_off(D0, 2, 0)>(vb), h2 = tr_read<v_rd_off(D0, 2, 1)>(vb), l3 = tr_read<v_rd_off(D0, 3, 0)>(vb), h3 = tr_read<v_rd_off(D0, 3, 1)>(vb);
  asm volatile("s_waitcnt lgkmcnt(0)" ::: "memory"); SBAR();
#define PK(L, H) (bf16x8){L[0], L[1], L[2], L[3], H[0], H[1], H[2], H[3]}
  od = __builtin_amdgcn_mfma_f32_32x32x16_bf16(pa0, PK(l0, h0), od, 0, 0, 0);
  od = __builtin_amdgcn_mfma_f32_32x32x16_bf16(pa1, PK(l1, h1), od, 0, 0, 0);
  od = __builtin_amdgcn_mfma_f32_32x32x16_bf16(pa2, PK(l2, h2), od, 0, 0, 0);
  od = __builtin_amdgcn_mfma_f32_32x32x16_bf16(pa3, PK(l3, h3), od, 0, 0, 0);
#undef PK
}
__device__ __forceinline__ void pv_d0(f32x16* o, int vb, bf16x8 pa0, bf16x8 pa1, bf16x8 pa2, bf16x8 pa3) {
  pv_one<0>(o[0], vb, pa0, pa1, pa2, pa3); pv_one<1>(o[1], vb, pa0, pa1, pa2, pa3); pv_one<2>(o[2], vb, pa0, pa1, pa2, pa3); pv_one<3>(o[3], vb, pa0, pa1, pa2, pa3);
}

template <int LDQ, int LDO, bool NA, int SDEPTH>
__device__ __forceinline__ void attn_body(const bf16_t* __restrict__ Qb, const bf16_t* __restrict__ Kh, const bf16_t* __restrict__ Vh, bf16_t* __restrict__ Ob, int NT, const int LDK, char* lds, const NaInfo& na) {
  int tid = threadIdx.x; asm volatile("" : "+v"(tid));
  const int wid = tid >> 6, lane = tid & 63, r32 = lane & 31, hi = lane >> 5;
  bf16_t* V_lds = (bf16_t*)lds; bf16_t* K_lds = (bf16_t*)(lds + 2 * SHM_V);
  float* ws = (float*)(lds + 2 * SHM_V + 2 * SHM_K) + wid * 64; float* li_l = ws; float* al_l = ws + 32;
  float m_reg = -1e30f, l_reg = 0; f32x16 o[4] = {}; bf16x8 qr[8];
  const bf16_t* Qw = Qb + (long)(wid * QBLK + r32) * LDQ + hi * 8;
#pragma unroll
  for (int d0 = 0; d0 < 8; ++d0) qr[d0] = *reinterpret_cast<const bf16x8*>(Qw + d0 * 16);
  const int sr = tid >> 4, sc = (tid & 15) * 8, vst0 = v_st(sr, sc), vst1 = v_st(32 + sr, sc);
  const int vb0 = (int)(uintptr_t)V_lds + v_rd_base(lane);
  const int koff = NA ? na.rlo * 64 : 0;
  struct { bf16x8 vs0, vs1, ks0, ks1; } sr_[SDEPTH];
#define KROW(t) ((t) * KVBLK + ((NA && (t) >= 4) ? koff : 0))
#define SLOAD(i, t) do { const long _k0 = KROW(t); sr_[i].vs0 = *reinterpret_cast<const bf16x8*>(&Vh[(_k0 + sr) * LDK + sc]); sr_[i].vs1 = *reinterpret_cast<const bf16x8*>(&Vh[(_k0 + 32 + sr) * LDK + sc]); \
    sr_[i].ks0 = *reinterpret_cast<const bf16x8*>(&Kh[(_k0 + sr) * LDK + sc]); sr_[i].ks1 = *reinterpret_cast<const bf16x8*>(&Kh[(_k0 + 32 + sr) * LDK + sc]); } while (0)
#define SWRITE(b, i) do { *(bf16x8*)((char*)V_lds + (b) * SHM_V + vst0) = sr_[i].vs0;          \
    *(bf16x8*)((char*)V_lds + (b) * SHM_V + vst1) = sr_[i].vs1; int kc = sc * 2;               \
    *(bf16x8*)((char*)K_lds + (b) * SHM_K + KSWZ(sr, kc)) = sr_[i].ks0;                       \
    *(bf16x8*)((char*)K_lds + (b) * SHM_K + KSWZ(32 + sr, kc)) = sr_[i].ks1; } while (0)
#define SWAIT() do { if constexpr (SDEPTH == 2) asm volatile("s_waitcnt vmcnt(4)" ::: "memory"); else asm volatile("s_waitcnt vmcnt(0)" ::: "memory"); } while (0)
#define RESC(a) do { if (__any((a) < 1.f)) { if (hi == 0) al_l[r32] = (a); asm volatile("s_waitcnt lgkmcnt(0)" ::: "memory"); \
    _Pragma("unroll") for (int d = 0; d < 4; ++d) _Pragma("unroll") for (int r = 0; r < 16; ++r) o[d][r] *= al_l[crow(r, hi)]; } } while (0)
#define PSM(P0, P1, MN, AL, T) do { if constexpr (NA) partialSM_na(P0, P1, m_reg, MN, AL, (T), na, hi); else partialSM(P0, P1, m_reg, MN, AL); } while (0)
  f32x16 pA0, pA1, pB0, pB1; float mnA, mnB, alA, alB; bf16x8 pa0, pa1, pa2, pa3;
  constexpr int SE = 0, SO = SDEPTH - 1;
  asm volatile("" : "+s"(NT));
  SLOAD(SE, 0); asm volatile("s_waitcnt vmcnt(0)" ::: "memory"); SWRITE(0, SE); __syncthreads();
  qkt(pA0, pA1, K_lds, qr, r32, hi); PSM(pA0, pA1, mnA, alA, 0);
  SLOAD(SO, 1); if constexpr (SDEPTH == 2) { if (2 < NT) SLOAD(SE, 2); }
  SWAIT(); SWRITE(1, SO); __syncthreads();
  for (int j = 1; j + 1 < NT; j += 2) {
    SBAR(); qkt(pB0, pB1, (bf16_t*)((char*)K_lds + SHM_K), qr, r32, hi);
    finishSM(pA0, pA1, alA, l_reg, pa0, pa1, pa2, pa3); SBAR();
    SLOAD(SO, j + SDEPTH); SBAR();
    pv_d0(o, vb0, pa0, pa1, pa2, pa3); PSM(pB0, pB1, mnB, alB, j);
    __syncthreads(); SWAIT(); SWRITE(0, SE);
    RESC(alB); __syncthreads();
    SBAR(); qkt(pA0, pA1, K_lds, qr, r32, hi);
    finishSM(pB0, pB1, alB, l_reg, pa0, pa1, pa2, pa3); SBAR();
    if (SDEPTH == 1 || j + 3 < NT) SLOAD(SE, j + 1 + SDEPTH); SBAR();
    pv_d0(o, vb0 + (int)SHM_V, pa0, pa1, pa2, pa3); PSM(pA0, pA1, mnA, alA, j + 1);
    __syncthreads(); SWAIT(); SWRITE(1, SO);
    RESC(alA); __syncthreads();
  }
  SBAR(); qkt(pB0, pB1, (bf16_t*)((char*)K_lds + SHM_K), qr, r32, hi);
  finishSM(pA0, pA1, alA, l_reg, pa0, pa1, pa2, pa3); SBAR();
  pv_d0(o, vb0, pa0, pa1, pa2, pa3); PSM(pB0, pB1, mnB, alB, NT - 1);
  __syncthreads(); RESC(alB);
  finishSM(pB0, pB1, alB, l_reg, pa0, pa1, pa2, pa3); SBAR();
  pv_d0(o, vb0 + (int)SHM_V, pa0, pa1, pa2, pa3);
  if (hi == 0) li_l[r32] = l_reg; asm volatile("s_waitcnt lgkmcnt(0)" ::: "memory");
  float rli[16];
#pragma unroll
  for (int r = 0; r < 16; ++r) rli[r] = __builtin_amdgcn_rcpf(li_l[crow(r, hi)]);
  bf16_t* Ow = Ob + (long)(wid * QBLK) * LDO;
#pragma unroll
  for (int r = 0; r < 16; ++r) { int orow = crow(r, hi);
#pragma unroll
    for (int d0 = 0; d0 < 4; ++d0) { const float v = o[d0][r] * rli[r]; Ow[(long)orow * LDO + d0 * 32 + r32] = (bf16_t)(cvtpk(v, v) & 0xffffu); } }
  __syncthreads();
#undef KROW
#undef SLOAD
#undef SWRITE
#undef SWAIT
#undef RESC
#undef PSM
}
#undef KSWZ
}

template <class T> __device__ __forceinline__ T* uni_ptr(T* p) { const unsigned long long v = (unsigned long long)p; const unsigned lo = __builtin_amdgcn_readfirstlane((unsigned)v), hi = __builtin_amdgcn_readfirstlane((unsigned)(v >> 32)); return (T*)(GAS T*)(((unsigned long long)hi << 32) | lo); }
__device__ __forceinline__ void attn_dense_call(const bf16_t* q, const bf16_t* k, const bf16_t* v, bf16_t* o, int nt, int ldk) {
    extern __shared__ __attribute__((aligned(16))) unsigned char lds_raw_[];
    q = uni_ptr(q); k = uni_ptr(k); v = uni_ptr(v); o = uni_ptr(o); nt = __builtin_amdgcn_readfirstlane(nt); ldk = __builtin_amdgcn_readfirstlane(ldk);
    att::NaInfo na0; na0.rpb = (const LAS float*)(LAS unsigned char*)lds_raw_; na0.qrow = 0; na0.rs = 0; na0.c = 0; na0.cs = 0; na0.rlo = 0;
    att::attn_body<512, DM, false, 2>(q, k, v, o, nt, ldk, (char*)lds_raw_, na0);
}
__device__ __forceinline__ void attn_na_call(const bf16_t* q, const bf16_t* k, const bf16_t* v, bf16_t* o, int nt, int r0, int rlo) {
    extern __shared__ __attribute__((aligned(16))) unsigned char lds_raw_[];
    q = uni_ptr(q); k = uni_ptr(k); v = uni_ptr(v); o = uni_ptr(o); nt = __builtin_amdgcn_readfirstlane(nt); r0 = __builtin_amdgcn_readfirstlane(r0); rlo = __builtin_amdgcn_readfirstlane(rlo);
    int tidn = threadIdx.x; asm volatile("" : "+v"(tidn)); const int wave = tidn >> 6, lane = tidn & 63;
    att::NaInfo na; na.rpb = (const LAS float*)((LAS unsigned char*)lds_raw_ + RPB_OFF); na.qrow = r0 + (wave >> 1); na.rs = min(max(na.qrow - 4, 0), 56); na.c = (wave & 1) * 32 + (lane & 31); na.cs = min(max(na.c - 8, 0), 48); na.rlo = rlo;
    att::attn_body<512, DM, true, 1>(q, k, v, o, nt, 512, (char*)lds_raw_, na);
}

__device__ __forceinline__ void cdft_to_slab(LAS unsigned char* lds, const bf16_t* __restrict__ Pv, size_t vstride, const bf16_t* __restrict__ MBl, int mpitch) {
  int tid = threadIdx.x; asm volatile("" : "+v"(tid));
  const int wid = tid >> 6, lane = tid & 63, r32 = lane & 31, hi = lane >> 5, h = wid >> 1, cs = wid & 1;
  const bf16_t* ap = Pv + (size_t)r32 * vstride + h * 128 + hi * 8;
  const bf16_t* bp = MBl + (size_t)(h * 256 + cs * 128 + r32) * mpitch + hi * 8;
  LAS bf16_t* sl = (LAS bf16_t*)lds + (64 * cs) * 512 + h * 128 + r32;
  bf16x8 a[2][8];
#pragma unroll
  for (int i = 0; i < 2; ++i)
#pragma unroll
    for (int k = 0; k < 8; ++k) a[i][k] = *reinterpret_cast<const bf16x8*>(ap + (size_t)(32 * i) * vstride + 16 * k);
#pragma unroll 1
  for (int i = 0; i < 2; ++i) {
    f32x16 acc[4];
#pragma unroll
    for (int j = 0; j < 4; ++j) { acc[j] = f32x16{}; asm volatile("" : "+v"(acc[j])); }
#pragma unroll
    for (int k = 0; k < 8; ++k) {
      bf16x8 bq[4];
#pragma unroll
      for (int j = 0; j < 4; ++j) bq[j] = *reinterpret_cast<const bf16x8*>(bp + (size_t)(32 * j) * mpitch + 16 * k);
      const bf16x8 av = i ? a[1][k] : a[0][k];
#pragma unroll
      for (int j = 0; j < 4; ++j) acc[j] = __builtin_amdgcn_mfma_f32_32x32x16_bf16(av, bq[j], acc[j], 0, 0, 0);
    }
#pragma unroll
    for (int j = 0; j < 4; ++j) asm volatile("s_nop 15\n\ts_nop 15" : "+v"(acc[j]));
#pragma unroll
    for (int r = 0; r < 16; ++r) { const int row = 32 * i + att::crow(r, hi);
#pragma unroll
      for (int j = 0; j < 4; ++j) { const float v = acc[j][r]; sl[row * 512 + 32 * j] = (bf16_t)(cvt_pk_bf16(v, v) & 0xffffu); } }
  }
}
template <int NPASS, bool STAGE = true, class RowPtr, class Epi>
__device__ __forceinline__ void fft_stage(LAS unsigned char* lds, const bf16_t* __restrict__ Mmat, const RowPtr& rowp, const Epi& epi) {
  int tid = threadIdx.x; asm volatile("" : "+v"(tid));
  const int wid = tid >> 6, lane = tid & 63, r32 = lane & 31, hi = lane >> 5;
  if constexpr (STAGE) {
    const int sr = tid >> 6, sc = (tid & 63) * 8;
    bf16x8 st[16];
#pragma unroll
    for (int i = 0; i < 16; ++i) st[i] = *reinterpret_cast<const bf16x8*>(rowp(sr + 8 * i) + sc);
#pragma unroll
    for (int i = 0; i < 16; ++i) *(LAS bf16x8*)(lds + ((sr + 8 * i) * 512 + sc) * 2) = st[i];
  }
  __syncthreads();
  const LAS bf16_t* tb = (const LAS bf16_t*)lds + (8 * hi) * 512 + 64 * wid + r32;
  const bf16_t* Ml = Mmat + r32 * 128 + hi * 8;
#pragma unroll
  for (int p = 0; p < NPASS; ++p) {
    f32x16 acc[2][2];
#pragma unroll
    for (int j = 0; j < 2; ++j) { acc[j][0] = f32x16{}; acc[j][1] = f32x16{}; asm volatile("" : "+v"(acc[j][0]), "+v"(acc[j][1])); }
#pragma unroll 2
    for (int k = 0; k < 8; ++k) {
      bf16x8 b0, b1;
#pragma unroll
      for (int j = 0; j < 8; ++j) { b0[j] = (short)tb[(16 * k + j) * 512]; b1[j] = (short)tb[(16 * k + j) * 512 + 32]; }
      const bf16x8 a0 = *reinterpret_cast<const bf16x8*>(Ml + p * 32 * 128 + k * 16), a1 = *reinterpret_cast<const bf16x8*>(Ml + (p + NPASS) * 32 * 128 + k * 16);
      acc[0][0] = __builtin_amdgcn_mfma_f32_32x32x16_bf16(a0, b0, acc[0][0], 0, 0, 0); acc[0][1] = __builtin_amdgcn_mfma_f32_32x32x16_bf16(a0, b1, acc[0][1], 0, 0, 0);
      acc[1][0] = __builtin_amdgcn_mfma_f32_32x32x16_bf16(a1, b0, acc[1][0], 0, 0, 0); acc[1][1] = __builtin_amdgcn_mfma_f32_32x32x16_bf16(a1, b1, acc[1][1], 0, 0, 0);
    }
#pragma unroll
    for (int j = 0; j < 2; ++j) asm volatile("s_nop 15\n\ts_nop 15" : "+v"(acc[j][0]), "+v"(acc[j][1]));
    epi(p, acc, wid, r32, hi);
  }
  __syncthreads();
}

#define XB_TMO      128
#define XB_XCNT(j)  (256  + 64 * (j))
#define XB_XSUB(j)  (1280 + 64 * (j))
#define XB_XGEN(j)  (2304 + 64 * (j))
#define XB_TOP      3328
#define XB_TOPGEN   3392
#define XCD_BAR_WORDS 3456
#define XB_SPIN_CAP (1u << 18)
__device__ __forceinline__ unsigned xb_ld(unsigned* p)              { return __hip_atomic_load(p, __ATOMIC_RELAXED, __HIP_MEMORY_SCOPE_AGENT); }
__device__ __forceinline__ unsigned xb_add(unsigned* p, unsigned v) { return __hip_atomic_fetch_add(p, v, __ATOMIC_RELAXED, __HIP_MEMORY_SCOPE_AGENT); }
__device__ __forceinline__ unsigned xb_xcc_id() { return (unsigned)__builtin_amdgcn_s_getreg((3 << 11) | 20) & 0xFu; }
#define XB_SPIN(cond, bar) do { unsigned _sp = 0; while (cond) { __builtin_amdgcn_s_sleep(1); \
    if ((++_sp & 255u) == 0u) { if (xb_ld(&(bar)[XB_TMO])) break; if (_sp > XB_SPIN_CAP) { atomicAdd(&(bar)[XB_TMO], 1u); break; } } } } while (0)
struct XcdBarrier { unsigned* bar; unsigned x; volatile LAS unsigned* st; };
__device__ __forceinline__ XcdBarrier xcd_barrier_post(unsigned* bar, volatile LAS unsigned* st) {
    XcdBarrier b; b.bar = bar; b.x = xb_xcc_id(); b.st = st;
    if (threadIdx.x == 0) (void)xb_add(&bar[XB_XCNT(b.x)], 1u);
    return b;
}
__device__ __forceinline__ void xcd_barrier_complete(unsigned* bar, unsigned x, unsigned& nloc, unsigned& nx) {
    const unsigned G = gridDim.x * gridDim.y * gridDim.z;
    unsigned sum, cnt, mine, sp = 0u;
    for (;;) {
        sum = 0u; cnt = 0u; mine = 0u;
#pragma unroll 1
        for (unsigned j = 0; j < 16; ++j) { const unsigned c = xb_ld(&bar[XB_XCNT(j)]); sum += c; cnt += (c > 0u) ? 1u : 0u; mine = (j == x) ? c : mine; }
        if (sum == G) break;
        __builtin_amdgcn_s_sleep(1);
        if ((++sp & 255u) == 0u) { if (xb_ld(&bar[XB_TMO])) break; if (sp > XB_SPIN_CAP) { atomicAdd(&bar[XB_TMO], 1u); break; } }
    }
    nloc = mine > 0u ? mine : 1u; nx = cnt > 0u ? cnt : 1u;
}
__device__ __forceinline__ void xcd_barrier(const XcdBarrier& b) {
    asm volatile("s_waitcnt vmcnt(0)" ::: "memory");
    __syncthreads();
    if (threadIdx.x == 0) {
        unsigned* bar = b.bar;
        __builtin_amdgcn_s_waitcnt(0);
        unsigned nloc = b.st[0], nx = b.st[1];
        if (nloc == 0u) { xcd_barrier_complete(bar, b.x, nloc, nx); b.st[0] = nloc; b.st[1] = nx; }
        const unsigned old = xb_add(&bar[XB_XSUB(b.x)], 1u);
        const unsigned gen = old / nloc;
        if (old + 1u == (gen + 1u) * nloc) {
            __builtin_amdgcn_fence(__ATOMIC_RELEASE, "agent");
            asm volatile("s_waitcnt vmcnt(0)" ::: "memory");
            const unsigned og = xb_add(&bar[XB_TOP], 1u);
            const unsigned tg = og / nx;
            if (og + 1u == (tg + 1u) * nx) xb_add(&bar[XB_TOPGEN], 1u);
            else XB_SPIN(xb_ld(&bar[XB_TOPGEN]) == tg, bar);
            __builtin_amdgcn_fence(__ATOMIC_ACQUIRE, "agent");
            xb_add(&bar[XB_XGEN(b.x)], 1u);
            asm volatile("s_waitcnt vmcnt(0)" ::: "memory");
        } else {
            XB_SPIN(xb_ld(&bar[XB_XGEN(b.x)]) == gen, bar);
            __builtin_amdgcn_fence(__ATOMIC_ACQUIRE, "agent");
            asm volatile("s_waitcnt vmcnt(0)" ::: "memory");
        }
    }
    __syncthreads();
}

struct Args { const float* in[24]; float* out; unsigned char* ws; int ph_lo, ph_hi; };
enum { I_X = 0, I_C, I_CTX, I_CCTX, I_N1G, I_N2G, I_WADA, I_BADA, I_WIN, I_WOUT, I_WFOUR, I_CONVW, I_RPB, I_NAQG, I_NAKG, I_GQG, I_GKG, I_FW1, I_FW3, I_FW2, I_ROUTER, I_MW1, I_MW3, I_MW2 };

__device__ __forceinline__ void transpose_tile(const float* __restrict__ src, int ldw, bf16_t* __restrict__ dst, int ldb, LAS unsigned* scr) {
    const int tid = threadIdx.x;
    const int n4 = (tid & 31) * 4, kq = tid >> 5;
    f32x4 a[4], b[4];
#pragma unroll
    for (int i = 0; i < 4; ++i) { const int kp = kq + 16 * i; a[i] = *(const f32x4*)(src + (size_t)(2 * kp) * ldw + n4); b[i] = *(const f32x4*)(src + (size_t)(2 * kp + 1) * ldw + n4); }
#pragma unroll
    for (int i = 0; i < 4; ++i) { const int kp = kq + 16 * i;
#pragma unroll
        for (int j = 0; j < 4; ++j) scr[(n4 + j) * 65 + kp] = cvt_pk_bf16(a[i][j], b[i][j]); }
    __syncthreads();
    const int n = tid >> 2, q = tid & 3;
#pragma unroll
    for (int i = 0; i < 4; ++i) { u32x4 w; const LAS unsigned* s = scr + n * 65 + q * 16 + i * 4; w.x = s[0]; w.y = s[1]; w.z = s[2]; w.w = s[3];
        *(u32x4*)(dst + (size_t)n * ldb + (q * 16 + i * 4) * 2) = w; }
    __syncthreads();
}

struct T16Regs { f32x4 a[4], b[4]; };
__device__ __forceinline__ void t16_load(const float* __restrict__ src, int ldw, T16Regs& t) {
    const int tid = threadIdx.x; const int n4 = (tid & 31) * 4, kq = tid >> 5;
#pragma unroll
    for (int i = 0; i < 4; ++i) { const int kp = kq + 16 * i; t.a[i] = __builtin_nontemporal_load((const f32x4*)(src + (size_t)(2 * kp) * ldw + n4)); t.b[i] = __builtin_nontemporal_load((const f32x4*)(src + (size_t)(2 * kp + 1) * ldw + n4)); }
}
__device__ __forceinline__ void t16_store(const T16Regs& t, bf16_t* __restrict__ dst, int ldb, LAS unsigned* scr) {
    const int tid = threadIdx.x; const int n4 = (tid & 31) * 4, kq = tid >> 5;
#pragma unroll
    for (int i = 0; i < 4; ++i) { const int kp = kq + 16 * i;
#pragma unroll
        for (int j = 0; j < 4; ++j) scr[(n4 + j) * 65 + kp] = cvt_pk_bf16(t.a[i][j], t.b[i][j]); }
    asm volatile("s_waitcnt lgkmcnt(0)" ::: "memory"); __builtin_amdgcn_s_barrier(); asm volatile("" ::: "memory");
    const int n = tid >> 2, q = tid & 3;
#pragma unroll
    for (int i = 0; i < 4; ++i) { u32x4 w; const LAS unsigned* s = scr + n * 65 + q * 16 + i * 4; w.x = s[0]; w.y = s[1]; w.z = s[2]; w.w = s[3];
        *(u32x4*)(dst + (size_t)n * ldb + (q * 16 + i * 4) * 2) = w; }
    asm volatile("s_waitcnt lgkmcnt(0)" ::: "memory"); __builtin_amdgcn_s_barrier(); asm volatile("" ::: "memory");
}
struct T8Regs { f32x4 r[2][4]; };
__device__ __forceinline__ void t8_load(const float* __restrict__ src, int ldw, T8Regs& t, int tid = threadIdx.x) {
    const int n4 = (tid & 31) * 4, kq = tid >> 5;
#pragma unroll
    for (int i = 0; i < 2; ++i)
#pragma unroll
        for (int q = 0; q < 4; ++q) t.r[i][q] = __builtin_nontemporal_load((const f32x4*)(src + (size_t)(4 * (kq + 16 * i) + q) * ldw + n4));
}
__device__ __forceinline__ void t8_store(const T8Regs& t, unsigned char* __restrict__ dst, int ldb, LAS unsigned* scr, float sc, int tid = threadIdx.x) {
    const int n4 = (tid & 31) * 4, kq = tid >> 5;
#pragma unroll
    for (int i = 0; i < 2; ++i)
#pragma unroll
        for (int j = 0; j < 4; ++j) scr[(n4 + j) * 33 + kq + 16 * i] = pk4_fp8(t.r[i][0][j] * sc, t.r[i][1][j] * sc, t.r[i][2][j] * sc, t.r[i][3][j] * sc);
    asm volatile("s_waitcnt lgkmcnt(0)" ::: "memory"); __builtin_amdgcn_s_barrier(); asm volatile("" ::: "memory");
    const int n = tid >> 2, q = tid & 3;
#pragma unroll
    for (int i = 0; i < 2; ++i) { u32x4 w; const LAS unsigned* s = scr + n * 33 + q * 8 + i * 4; w.x = s[0]; w.y = s[1]; w.z = s[2]; w.w = s[3];
        *(u32x4*)(dst + (size_t)n * ldb + q * 32 + i * 16) = w; }
    asm volatile("s_waitcnt lgkmcnt(0)" ::: "memory"); __builtin_amdgcn_s_barrier(); asm volatile("" ::: "memory");
}

__device__ __forceinline__ const unsigned char* ldptr(volatile LAS unsigned long long* T, int i) {
    const unsigned long long v = T[i]; const unsigned lo = __builtin_amdgcn_readfirstlane((unsigned)v), hi = __builtin_amdgcn_readfirstlane((unsigned)(v >> 32));
    return (const unsigned char*)(const GAS unsigned char*)(((unsigned long long)hi << 32) | lo);
}
constexpr int NT_ME = 16 * 56, NT_MUP = 2 * 8 * NT_ME, NT_MDN = 8 * NT_ME, NT_M = NT_MUP + NT_MDN;
constexpr int CW_QUP = 8192 + 1024, CW_QDN = 8192 + 1088;
__device__ __forceinline__ void moe_tile_decode(int t, volatile LAS unsigned long long* PTRS, const float*& src, int& ldw, unsigned char*& dst, int& ldb) {
    unsigned char* wsb = (unsigned char*)ldptr(PTRS, 25);
    if (t < NT_MUP) { const int which = t / (8 * NT_ME), q2 = t % (8 * NT_ME), e = q2 / NT_ME, r = q2 % NT_ME, kb = r / 56, nb = r % 56;
        src = (const float*)ldptr(PTRS, which ? I_MW3 : I_MW1) + (size_t)e * DM * DFE + (size_t)(kb * 128) * DFE + nb * 128; ldw = DFE; dst = wsb + WS_MUP + (size_t)e * 2 * DFE * DM + (size_t)(nb * 256 + which * 128) * DM + kb * 128; ldb = DM; }
    else { const int q = t - NT_MUP, e = q / NT_ME, r = q % NT_ME, kb = r / 16, nb = r % 16;
        src = (const float*)ldptr(PTRS, I_MW2) + (size_t)e * DFE * DM + (size_t)(kb * 128) * DM + nb * 128; ldw = DM; dst = wsb + WS_MDN + (size_t)e * DM * DFE + (size_t)(nb * 128) * DFE + kb * 128; ldb = DFE; }
}
__device__ __forceinline__ void moe_convert(volatile LAS unsigned long long* PTRS, LAS unsigned* scr, int t, int tend, int step) {
    if (t >= tend) return;
    const int tlast = t + ((tend - 1 - t) / step) * step;
    int tid = threadIdx.x; asm volatile("" : "+v"(tid));
    T8Regs t0, t1, t2; const float* src = nullptr; int ldw = 0; unsigned char *d0 = nullptr, *d1 = nullptr, *d2 = nullptr; int b0 = 0, b1 = 0, b2 = 0;
    moe_tile_decode(t, PTRS, src, ldw, d0, b0); t8_load(src, ldw, t0, tid);
    moe_tile_decode(min(t + step, tlast), PTRS, src, ldw, d1, b1); t8_load(src, ldw, t1, tid);
#define MT8_STEP(TL, DL, BL, TS, DS, BS) { if (t >= tend) break; moe_tile_decode(min(t + 2 * step, tlast), PTRS, src, ldw, DL, BL); t8_load(src, ldw, TL, tid); t8_store(TS, DS, BS, scr, F8_SW, tid); t += step; }
    for (;;) {
        MT8_STEP(t2, d2, b2, t0, d0, b0)
        MT8_STEP(t0, d0, b0, t1, d1, b1)
        MT8_STEP(t1, d1, b1, t2, d2, b2)
    }
#undef MT8_STEP
    asm volatile("s_waitcnt vmcnt(0)" ::: "memory");
}
template <unsigned PM, unsigned MM>
__global__ void __launch_bounds__(512, 2) mk_fwd(Args args) {
    extern __shared__ __attribute__((aligned(16))) unsigned char lds_raw[];
    LAS unsigned char* lds = (LAS unsigned char*)lds_raw;
    volatile LAS unsigned* MISC = (volatile LAS unsigned*)(lds + MISC_OFF);
    const int tid = threadIdx.x, lane = tid & 63, wave = __builtin_amdgcn_readfirstlane(tid >> 6);
    const int G = gridDim.x, wg = blockIdx.x;
    const int NGW = G * 8;
    unsigned* ctl = (unsigned*)(args.ws + WS_CTL);
    if (tid < 64) MISC[tid] = 0u;
    __syncthreads();
    XcdBarrier bar; bar.bar = ctl + CW_BAR; bar.x = 0; bar.st = MISC;
    const bool one_launch = (args.ph_hi - args.ph_lo) > 1;
    if (one_launch) bar = xcd_barrier_post(ctl + CW_BAR, MISC);
    const int lo = args.ph_lo, hi = args.ph_hi;
#define IN(k) (lo <= (k) && (k) < hi)
#define SEAM(k) do { if (IN(k) && IN((k) + 1)) xcd_barrier(bar); } while (0)

    volatile LAS unsigned long long* PTRS = (volatile LAS unsigned long long*)(lds + MISC_OFF + 512);
    if (tid < 24) PTRS[tid] = (unsigned long long)args.in[tid];
    if (tid == 24) PTRS[24] = (unsigned long long)args.out;
    if (tid == 25) PTRS[25] = (unsigned long long)args.ws;
    __syncthreads();
#define PHASE_IDS() int tid = threadIdx.x; asm volatile("" : "+v"(tid)); const int lane = tid & 63, wave = __builtin_amdgcn_readfirstlane(tid >> 6), gw = wg * 8 + wave; (void)lane; (void)gw
#define MOE_GRAB(budget) do { __syncthreads(); if (threadIdx.x == 0) { int t_ = (int)atomicAdd(ctl + CW_QUP, (unsigned)(budget)); if (t_ >= NT_MUP) t_ = NT_MUP + (int)atomicAdd(ctl + CW_QDN, (unsigned)(budget)); MISC[40] = (unsigned)t_; } __syncthreads(); \
    const int t0_ = __builtin_amdgcn_readfirstlane((int)MISC[40]); const int te_ = min(t0_ + (budget), t0_ < NT_MUP ? NT_MUP : NT_M); moe_convert(PTRS, (LAS unsigned*)lds, t0_, te_, 1); } while (0)
#define MOE_DRAIN(cw, base, count) do { __syncthreads(); if (threadIdx.x == 0) MISC[40] = __hip_atomic_load(ctl + (cw), RLX_AGENT); __syncthreads(); \
    const int s0_ = min(__builtin_amdgcn_readfirstlane((int)MISC[40]), (count)); moe_convert(PTRS, (LAS unsigned*)lds, (base) + s0_ + wg, (base) + (count), G); } while (0)
#define DEFICIT(nwg_) ((((nwg_) + G - 1) / G) - (wg < (nwg_) ? ((nwg_) - wg + G - 1) / G : 0))
#define INP(i) ((const float*)ldptr(PTRS, (i)))
#define OUTP() ((float*)ldptr(PTRS, 24))
#define WSB() ((unsigned char*)ldptr(PTRS, 25))

    DUP(10) if (EN(10) && IN(0)) {
            PHASE_IDS();
        constexpr int TR_WIN = 16 * 36, TR_WOUT = 16 * 16, TR_F13 = 16 * 44, TR_F2 = 44 * 16, TR_M13 = 16 * 56, TR_M2 = 56 * 16;
        constexpr int O_WIN = 0, O_WOUT = O_WIN + 2 * TR_WIN, O_F1 = O_WOUT + 2 * TR_WOUT, O_F3 = O_F1 + TR_F13, O_F2 = O_F3 + TR_F13, O_M1 = O_F2 + TR_F2, O_M3 = O_M1 + 8 * TR_M13, O_M2 = O_M3 + 8 * TR_M13, NTR = O_M2 + 8 * TR_M2;
        constexpr int O_T = NTR, N_T = 4096 / 8, O_TC = O_T + N_T, N_TC = 256 / 8, O_FOLD = O_TC + N_TC, N_FOLD = 2 * 4 * 2 * 32, O_MOD = O_FOLD + N_FOLD, N_MOD = 2 * 96, O_ROPE = O_MOD + N_MOD, NITEMS = O_ROPE + 1;
        LAS unsigned* scr = (LAS unsigned*)lds;
        LAS float* cosT = (LAS float*)(lds + 40960);
        LAS float* condL = (LAS float*)(lds + 57344);
        bool have_cond = false;
        unsigned char* wsb = WSB();
        float* mod = (float*)(wsb + WS_MOD); float* ropeT = (float*)(wsb + WS_ROPE); bf16_t* Tc = (bf16_t*)(wsb + WS_TC);
        bf16_t* Win_t = (bf16_t*)(wsb + WS_WIN); bf16_t* Wout_t = (bf16_t*)(wsb + WS_WOUT);
#define T16_DECODE(it_, src_, ldw_, dst_, ldb_) do { \
            if ((it_) < O_WOUT) { const int l = (it_) / TR_WIN, r = (it_) % TR_WIN, kb = r / 36, nb = r % 36; \
                src_ = INP(I_WIN) + (size_t)l * DM * INW + (size_t)(kb * 128) * INW + nb * 128; ldw_ = INW; dst_ = Win_t + (size_t)l * NP * DM + (size_t)(nb * 128) * DM + kb * 128; ldb_ = DM; } \
            else { const int q = (it_) - O_WOUT, l = q / TR_WOUT, r = q % TR_WOUT, kb = r / 16, nb = r % 16; \
                src_ = INP(I_WOUT) + (size_t)l * DM * DM + (size_t)(kb * 128) * DM + nb * 128; ldw_ = DM; dst_ = Wout_t + (size_t)l * DM * DM + (size_t)(nb * 128) * DM + kb * 128; ldb_ = DM; } } while (0)
        SUBDUP(0) {
            int it = wg; T16Regs t0, t1, t2; const float* src = nullptr; int ldw = 0; bf16_t *d0 = nullptr, *d1 = nullptr, *d2 = nullptr; int b0 = 0, b1 = 0, b2 = 0;
            if (it < O_F1) { T16_DECODE(it, src, ldw, d0, b0); t16_load(src, ldw, t0); }
            { const int itn_ = min(it + G, O_F1 - 1); T16_DECODE(itn_, src, ldw, d1, b1); t16_load(src, ldw, t1); }
#define T16_STEP(TL, DL, BL, TS, DS, BS) { if (it >= O_F1) break; { const int itn_ = min(it + 2 * G, O_F1 - 1); T16_DECODE(itn_, src, ldw, DL, BL); t16_load(src, ldw, TL); } t16_store(TS, DS, BS, scr); it += G; }
            for (;;) {
                T16_STEP(t2, d2, b2, t0, d0, b0)
                T16_STEP(t0, d0, b0, t1, d1, b1)
                T16_STEP(t1, d1, b1, t2, d2, b2)
            }
#undef T16_STEP
            asm volatile("s_waitcnt vmcnt(0)" ::: "memory"); __syncthreads();
        }
#undef T16_DECODE
#define T8_DECODE(it_, src_, ldw_, dst_, ldb_) do { \
            if ((it_) < O_F2) { const int q = (it_) - O_F1, which = q / TR_F13, r = q % TR_F13, kb = r / 44, nb = r % 44; \
                src_ = INP(which ? I_FW3 : I_FW1) + (size_t)(kb * 128) * DFF + nb * 128; ldw_ = DFF; dst_ = wsb + WS_WUP + (size_t)(nb * 256 + which * 128) * DM + kb * 128; ldb_ = DM; } \
            else if ((it_) < O_M1) { const int r = (it_) - O_F2, kb = r / 16, nb = r % 16; \
                src_ = INP(I_FW2) + (size_t)(kb * 128) * DM + nb * 128; ldw_ = DM; dst_ = wsb + WS_WDN + (size_t)(nb * 128) * DFF + kb * 128; ldb_ = DFF; } \
            else if ((it_) < O_M2) { const int q = (it_) - O_M1, which = q / (8 * TR_M13), q2 = q % (8 * TR_M13), e = q2 / TR_M13, r = q2 % TR_M13, kb = r / 56, nb = r % 56; \
                src_ = INP(which ? I_MW3 : I_MW1) + (size_t)e * DM * DFE + (size_t)(kb * 128) * DFE + nb * 128; ldw_ = DFE; dst_ = wsb + WS_MUP + (size_t)e * 2 * DFE * DM + (size_t)(nb * 256 + which * 128) * DM + kb * 128; ldb_ = DM; } \
            else { const int q = (it_) - O_M2, e = q / TR_M2, r = q % TR_M2, kb = r / 16, nb = r % 16; \
                src_ = INP(I_MW2) + (size_t)e * DFE * DM + (size_t)(kb * 128) * DM + nb * 128; ldw_ = DM; dst_ = wsb + WS_MDN + (size_t)e * DM * DFE + (size_t)(nb * 128) * DFE + kb * 128; ldb_ = DFE; } } while (0)
        SUBDUP(1) {
            int it = O_F1 + wg; T8Regs t0, t1, t2; const float* src = nullptr; int ldw = 0; unsigned char *d0 = nullptr, *d1 = nullptr, *d2 = nullptr; int b0 = 0, b1 = 0, b2 = 0;
            if (it < O_M1) { T8_DECODE(it, src, ldw, d0, b0); t8_load(src, ldw, t0); }
            { const int itn_ = min(it + G, O_M1 - 1); T8_DECODE(itn_, src, ldw, d1, b1); t8_load(src, ldw, t1); }
#define T8_STEP(TL, DL, BL, TS, DS, BS) { if (it >= O_M1) break; { const int itn_ = min(it + 2 * G, O_M1 - 1); T8_DECODE(itn_, src, ldw, DL, BL); t8_load(src, ldw, TL); } t8_store(TS, DS, BS, scr, F8_SW); it += G; }
            for (;;) {
                T8_STEP(t2, d2, b2, t0, d0, b0)
                T8_STEP(t0, d0, b0, t1, d1, b1)
                T8_STEP(t1, d1, b1, t2, d2, b2)
            }
#undef T8_STEP
        }
#undef T8_DECODE
        {   const int nsl = G >= 128 ? 64 : 1, part = G >= 128 ? wg - 64 : (wg == G - 1 ? 0 : -1);
            if (part >= 0 && part < nsl) {
                auto ctab = [](int j) -> float { return cosf((float)j * (6.283185307179586f / 4096.0f)); };
                bf16_t* M1 = (bf16_t*)(wsb + WS_FFT); bf16_t* M2 = M1 + 128 * 128; float* TW = (float*)(wsb + WS_FFT + 49152);
                for (int sl = part; sl < 64; sl += nsl) {
                    if (tid < 256) { const int k = 4 * sl + (tid >> 6), c8 = (tid & 63) * 8; float v[8];
#pragma unroll
                        for (int q = 0; q < 8; ++q) { const int col = c8 + q, l = col & 255; const int idx = ((k * l) & 255) * 16; v[q] = (col < 256 ? ctab(idx) : -ctab((idx - 1024) & 4095)) * (1.0f / 16.0f); }
                        u32x4 w; w.x = cvt_pk_bf16(v[0], v[1]); w.y = cvt_pk_bf16(v[2], v[3]); w.z = cvt_pk_bf16(v[4], v[5]); w.w = cvt_pk_bf16(v[6], v[7]);
                        *(u32x4*)(Tc + (size_t)k * 512 + c8) = w; }
                    else { const int i = (2 * sl) * 128 + (tid - 256);
                        const int m = i >> 7, kk = i & 127, k1 = m & 63, l1 = kk & 63; const int idx = ((k1 * l1) & 63) * 64; const float c = ctab(idx), sn = ctab((idx - 1024) & 4095);
                        const float v = (m < 64) ? (kk < 64 ? c : -sn) : (kk < 64 ? -sn : -c); M1[i] = (bf16_t)(cvt_pk_bf16(v, v) & 0xffffu); }
                    if (tid < 128) { const int i = sl * 128 + tid;
                        const int k2 = i >> 7, kk = i & 127, l2 = kk & 63; const int idx = ((k2 * l2) & 63) * 64; const float c = ctab(idx), sn = ctab((idx - 1024) & 4095);
                        const float v = (kk < 64 ? c : sn) * (1.0f / 64.0f); M2[i] = (bf16_t)(cvt_pk_bf16(v, v) & 0xffffu); }
                    else if (tid < 192) { const int i = sl * 64 + (tid - 128); TW[2 * i] = ctab(i); TW[2 * i + 1] = ctab((i - 1024) & 4095); }
                    else if (tid < 224) { const int i = sl * 32 + (tid - 192); const int p = i >> 5, f = i & 31; const float inv = 1.0f / powf(10000.0f, (float)f / 32.0f); const float ang = (float)p * inv;
                        ropeT[2 * i] = cosf(ang); ropeT[2 * i + 1] = sinf(ang); }
                }
            }
        }
        SUBDUP(3) for (int it4 = wg - 64; it4 >= 0 && it4 < 64; it4 += G) {
                const int it = it4 >> 2, dq = it4 & 3;
                const int cs = it & 1, h = (it >> 1) & 3, l = it >> 3;
                LAS float* trig = (LAS float*)(lds + MISC_OFF + 8192);
                LAS float* wfL = (LAS float*)lds;
                __syncthreads();
                if (tid < 128) trig[tid] = cs ? sinf((float)tid * (6.283185307179586f / 128.0f)) : cosf((float)tid * (6.283185307179586f / 128.0f));
                { const int r = tid >> 5, c4 = (tid & 31) * 4; const float* wf = INP(I_WFOUR) + (size_t)(l * 4 + h) * 128 * 128;
                  f32x4 v[8];
#pragma unroll
                  for (int i = 0; i < 8; ++i) v[i] = *(const f32x4*)(wf + (size_t)(r + 16 * i) * 128 + c4);
#pragma unroll
                  for (int i = 0; i < 8; ++i) *(LAS f32x4*)(wfL + (r + 16 * i) * 128 + c4) = v[i]; }
                __syncthreads();
                { const int e = tid & 127, dg = tid >> 7; float a[8];
#pragma unroll
                  for (int i = 0; i < 8; ++i) a[i] = 0.f;
                  const int d0 = dq * 32 + dg * 8;
#pragma unroll 4
                  for (int m = 0; m < 128; ++m) { const float wv = wfL[m * 128 + e];
#pragma unroll
                    for (int i = 0; i < 8; ++i) a[i] += trig[(m * (d0 + i)) & 127] * wv; }
                  bf16_t* MBr = (bf16_t*)(wsb + WS_MB) + ((size_t)l * PFW + h * 256 + cs * 128 + e) * NP;
#pragma unroll
                  for (int i = 0; i < 8; ++i) a[i] *= 0.08838834764831845f;
                  u32x4 w; w.x = cvt_pk_bf16(a[0], a[1]); w.y = cvt_pk_bf16(a[2], a[3]); w.z = cvt_pk_bf16(a[4], a[5]); w.w = cvt_pk_bf16(a[6], a[7]);
                  *(u32x4*)(MBr + d0) = w; }
                __syncthreads();
                have_cond = false;
        }
        SUBDUP(4) for (int it = O_MOD + ((wg + 128) % G); it < O_ROPE; it += G) {
                const int q = it - O_MOD, l = q / 96, n0 = (q % 96) * 128;
                if (!have_cond) { __syncthreads();
                    for (int i = tid; i < 5 * 2048; i += 512) { const int j = i >> 11, k = i & 2047; const float c = j < 4 ? INP(I_C)[j * 2048 + k] : INP(I_CCTX)[k]; condL[i] = silu_f(c); }
                    have_cond = true; __syncthreads(); }
                const int c4 = (tid & 31) * 4, kg = tid >> 5; f32x4 a[5];
#pragma unroll
                for (int j = 0; j < 5; ++j) a[j] = (f32x4){0.f, 0.f, 0.f, 0.f};
                const float* wp = INP(I_WADA) + (size_t)l * DM * 12288 + (size_t)(kg * 128) * 12288 + n0 + c4;
#pragma unroll 8
                for (int k = 0; k < 128; ++k) { const f32x4 wv = __builtin_nontemporal_load((const f32x4*)(wp + (size_t)k * 12288));
#pragma unroll
                    for (int j = 0; j < 5; ++j) a[j] += wv * condL[j * 2048 + kg * 128 + k]; }
                LAS float* red = (LAS float*)lds;
                __syncthreads();
#pragma unroll
                for (int j = 0; j < 5; ++j) *(LAS f32x4*)(red + (kg * 5 + j) * 128 + c4) = a[j];
                __syncthreads();
                if (tid < 128) {
#pragma unroll
                    for (int j = 0; j < 5; ++j) { float sacc = 0.f;
#pragma unroll
                        for (int g2 = 0; g2 < 16; ++g2) sacc += red[(g2 * 5 + j) * 128 + tid];
                        mod[(size_t)(l * 5 + j) * 12288 + n0 + tid] = sacc + INP(I_BADA)[l * 12288 + n0 + tid]; } }
                __syncthreads();
        }
        __syncthreads();
    }
    SEAM(0);

    for (int layer = 0; layer < 2; ++layer) {
        const int pb = 1 + 10 * layer;
#define LAYER_PTRS() unsigned char* wsb = WSB(); const float* modl = (const float*)(wsb + WS_MOD) + (size_t)layer * 5 * 12288; (void)modl
#define XIN_PTRS() const float* xin_lat = INP(I_X); const float* xin_ctx = INP(I_CTX); const bf16_t* xin_b = layer == 0 ? (const bf16_t*)nullptr : (const bf16_t*)(wsb + WS_X2)

        DUP(0) if (EN(0) && IN(pb + 0)) {
            PHASE_IDS();
            LAYER_PTRS(); XIN_PTRS(); bf16_t* HB = (bf16_t*)(wsb + WS_HB);
            const float* gn = INP(I_N1G) + layer * DM;
            f32x4 gv[8];
#pragma unroll
            for (int j = 0; j < 8; ++j) gv[j] = *(const f32x4*)(gn + lane * 4 + 256 * j);
#define NORM1_ROW(ROW, V) do { const int row_ = (ROW); const int mr = row_ < RL ? (row_ >> 12) : 4; const float* sh = modl + (size_t)mr * 12288; const float* sc = sh + 2048; float ss = 0.f; \
                _Pragma("unroll") for (int j = 0; j < 8; ++j) ss += (V[j][0] * V[j][0] + V[j][1] * V[j][1]) + (V[j][2] * V[j][2] + V[j][3] * V[j][3]); \
                const float rinv = rsqrtf(wave_sum(ss) * (1.0f / DM) + NORM_EPS); \
                _Pragma("unroll") for (int j = 0; j < 8; ++j) { const int c = lane * 4 + 256 * j; const f32x4 s1 = *(const f32x4*)(sc + c), s0 = *(const f32x4*)(sh + c); \
                    const f32x4 h = V[j] * rinv * gv[j] * (s1 + 1.0f) + s0; u32x2 w; w.x = cvt_pk_bf16(h[0], h[1]); w.y = cvt_pk_bf16(h[2], h[3]); \
                    *(u32x2*)(HB + (size_t)row_ * DM + c) = w; } } while (0)
            for (int row = gw; row < RT; row += 2 * NGW) {
                const int rowB = row + NGW; const bool hasB = rowB < RT; const int rb_ = hasB ? rowB : row;
                const float* xa = row < RL ? xin_lat + (size_t)row * DM : xin_ctx + (size_t)(row - RL) * DM;
                const float* xb = rb_ < RL ? xin_lat + (size_t)rb_ * DM : xin_ctx + (size_t)(rb_ - RL) * DM;
                f32x4 va[8], vb[8];
                if (layer == 0) {
#pragma unroll
                    for (int j = 0; j < 8; ++j) va[j] = *(const f32x4*)(xa + lane * 4 + 256 * j);
#pragma unroll
                    for (int j = 0; j < 8; ++j) vb[j] = *(const f32x4*)(xb + lane * 4 + 256 * j);
                } else { u32x2 qa[8], qb[8];
#pragma unroll
                    for (int j = 0; j < 8; ++j) qa[j] = *(const u32x2*)(xin_b + (size_t)row * DM + lane * 4 + 256 * j);
#pragma unroll
                    for (int j = 0; j < 8; ++j) qb[j] = *(const u32x2*)(xin_b + (size_t)rb_ * DM + lane * 4 + 256 * j);
#pragma unroll
                    for (int j = 0; j < 8; ++j) { va[j] = bf4(qa[j]); vb[j] = bf4(qb[j]); } }
                NORM1_ROW(row, va);
                if (hasB) NORM1_ROW(rowB, vb);
            }
#undef NORM1_ROW
        }
        SEAM(pb + 0);

        DUP(1) if (EN(1) && IN(pb + 1)) {
            unsigned char* wsb = WSB(); bf16_t* HB = (bf16_t*)(wsb + WS_HB); bf16_t* Win_t = (bf16_t*)(wsb + WS_WIN); bf16_t* P = (bf16_t*)(wsb + WS_P);
            pg8::Gemm g{HB, Win_t + (size_t)layer * NP * DM, 2 * DM};
            pg8::InProjOrder S; S.init(G, wg, layer == 1);
            pg8::EpiInProj E{P, (bf16_t*)(wsb + WS_NV), (bf16_t*)(wsb + WS_GV)};
            pg8::gemm_phase<pg8::EpiInProj, pg8::InProjOrder>(lds, g, S, E);
            { const int def_ = DEFICIT((RL / 256) * (NP / 256) + 4 * (layer == 1 ? 6 : NP / 256)); if (def_ > 0) MOE_GRAB(def_ * 14); }
        }
        SEAM(pb + 1);

        DUP(2) if (EN(2) && IN(pb + 2)) {
            PHASE_IDS();
            unsigned char* wsb = WSB(); const float* ropeT = (const float*)(wsb + WS_ROPE); const bf16_t* P = (const bf16_t*)(wsb + WS_P); bf16_t* Y = (bf16_t*)(wsb + WS_Y);
            bf16_t* NQ = (bf16_t*)(wsb + WS_NQ); bf16_t* NK = (bf16_t*)(wsb + WS_NK); bf16_t* NV = (bf16_t*)(wsb + WS_NV); bf16_t* GQ = (bf16_t*)(wsb + WS_GQ); bf16_t* GK = (bf16_t*)(wsb + WS_GK); bf16_t* GV = (bf16_t*)(wsb + WS_GV);
            bf16_t* PTC = (bf16_t*)(wsb + WS_PTC);
            const float* convw = INP(I_CONVW) + layer * 3 * 512;
            const float* g_nq = INP(I_NAQG) + layer * 128; const float* g_nk = INP(I_NAKG) + layer * 128;
            const float* g_gq = INP(I_GQG) + layer * 128; const float* g_gk = INP(I_GKG) + layer * 128;
            bf16_t* PF = (bf16_t*)(wsb + WS_PF);
            { const int nctx = layer == 0 ? 16 : 0; const int hh = wg & 3;
              struct CdftOrder { int G, c, nctx; __device__ __forceinline__ bool next(int i, pg8::Unit& u) const { const int L = i * G + c; if (L >= nctx) return false;
                  const int pm = RL / 256 + (L >> 2);
                  u.arow = 256 * pm; u.brow = 256 * (c & 3); u.orow = 256 * pm; u.ocol = 128 * (c & 3); return true; } };
              pg8::Gemm g{P + hh * 128, (const bf16_t*)(wsb + WS_MB) + (size_t)layer * PFW * NP, 2 * NP, 2 * 128};
              CdftOrder S{G, wg, nctx}; pg8::EpiStoreBf16 E{PF, PFW, 512};
              pg8::gemm_phase<pg8::EpiStoreBf16, CdftOrder>(lds, g, S, E);
              if (threadIdx.x == 0) { __builtin_amdgcn_fence(__ATOMIC_RELEASE, "agent"); asm volatile("s_waitcnt vmcnt(0)" ::: "memory");
                  for (int L = wg; L < nctx; L += G) xb_add(ctl + CW_CDF + 64 * (layer * 5 + 4), 1u); }
            }
            const int l16 = lane & 15;
            f32x4 cw[3][2], gq_[2], gk_[2], hq_[2], hk_[2];
#pragma unroll
            for (int k = 0; k < 3; ++k) { cw[k][0] = *(const f32x4*)(convw + k * 512 + lane * 8); cw[k][1] = *(const f32x4*)(convw + k * 512 + lane * 8 + 4); }
            gq_[0] = *(const f32x4*)(g_nq + l16 * 8); gq_[1] = *(const f32x4*)(g_nq + l16 * 8 + 4); gk_[0] = *(const f32x4*)(g_nk + l16 * 8); gk_[1] = *(const f32x4*)(g_nk + l16 * 8 + 4);
            hq_[0] = *(const f32x4*)(g_gq + l16 * 8); hq_[1] = *(const f32x4*)(g_gq + l16 * 8 + 4); hk_[0] = *(const f32x4*)(g_gk + l16 * 8); hk_[1] = *(const f32x4*)(g_gk + l16 * 8 + 4);
#define CDF_WAIT(f, n) do { __syncthreads(); if (threadIdx.x == 0) { while (__hip_atomic_load(ctl + CW_CDF + 64 * (layer * 5 + (f)), RLX_AGENT) < (unsigned)(n)) __builtin_amdgcn_s_sleep(2); \
                __builtin_amdgcn_fence(__ATOMIC_ACQUIRE, "agent"); asm volatile("s_waitcnt vmcnt(0)" ::: "memory"); } __syncthreads(); } while (0)
            struct PrepRaw { u32x4 gb, zc, zv, pc, pv, nc, nv, nq, nk, gq, gk; f32x4 rcs[4]; };
#define PREP_LOAD(ROW, R) do { const int row_ = (ROW); int t_, Ls_; if (row_ < RL) { t_ = row_ & 4095; Ls_ = SEQ; } else { t_ = (row_ - RL) & 255; Ls_ = CTXL; } \
                const bf16_t* Pr = P + (size_t)row_ * NP; const int ch = lane * 8; const u32x4 z4 = {0u, 0u, 0u, 0u}; \
                R.gb = *(const u32x4*)(Pr + PC_CB + ch); R.zc = *(const u32x4*)(Pr + PC_CC + ch); R.zv = *(const u32x4*)(Pr + PC_CV + ch); \
                R.pc = z4; R.pv = z4; R.nc = z4; R.nv = z4; \
                if (t_ > 0) { R.pc = *(const u32x4*)(Pr - NP + PC_CC + ch); R.pv = *(const u32x4*)(Pr - NP + PC_CV + ch); } \
                if (t_ < Ls_ - 1) { R.nc = *(const u32x4*)(Pr + NP + PC_CC + ch); R.nv = *(const u32x4*)(Pr + NP + PC_CV + ch); } \
                R.nq = *(const u32x4*)(Pr + PC_NQ + ch); R.nk = *(const u32x4*)(Pr + PC_NK + ch); R.gq = *(const u32x4*)(Pr + PC_GQ + ch); R.gk = *(const u32x4*)(Pr + PC_GK + (lane & 31) * 8); \
                { const int seg = l16 >> 2; const int p64 = (seg < 2) ? (t_ >> 6) : (t_ & 63); const float* cs_ = ropeT + (size_t)(p64 * 32 + (l16 & 3) * 8) * 2; \
                  _Pragma("unroll") for (int i = 0; i < 4; ++i) R.rcs[i] = *(const f32x4*)(cs_ + 4 * i); } } while (0)
#define HEADNORM(raw, gain, out) do { float _x[8]; _Pragma("unroll") for (int i = 0; i < 4; ++i) { _x[2 * i] = bf_lo(raw[i]); _x[2 * i + 1] = bf_hi(raw[i]); } \
                    float _ss = 0.f; _Pragma("unroll") for (int i = 0; i < 8; ++i) _ss += _x[i] * _x[i]; \
                    _ss += __shfl_xor(_ss, 1); _ss += __shfl_xor(_ss, 2); _ss += __shfl_xor(_ss, 4); _ss += __shfl_xor(_ss, 8); \
                    const float _ri = rsqrtf(_ss * (1.0f / 128.0f) + NORM_EPS); \
                    _Pragma("unroll") for (int i = 0; i < 8; ++i) out[i] = _x[i] * _ri * gain[i >> 2][i & 3]; } while (0)
#define ROPE8(v, R) do { const int seg = l16 >> 2; \
                    _Pragma("unroll") for (int i = 0; i < 8; ++i) { const float pvv = __shfl_xor(v[i], 4); const float c_ = R.rcs[i >> 1][(2 * i) & 3], s_ = R.rcs[i >> 1][(2 * i + 1) & 3]; v[i] = (seg & 1) ? (v[i] * c_ + pvv * s_) : (v[i] * c_ - pvv * s_); } } while (0)
#define PACK8(v, w) do { w.x = cvt_pk_bf16(v[0], v[1]); w.y = cvt_pk_bf16(v[2], v[3]); w.z = cvt_pk_bf16(v[4], v[5]); w.w = cvt_pk_bf16(v[6], v[7]); } while (0)
#define PREP_ROW(ROW, R) do { const int row_ = (ROW); int b, kvrow; bool lat; if (row_ < RL) { b = row_ >> 12; kvrow = CTXL + (row_ & 4095); lat = true; } else { const int rc = row_ - RL; b = rc >> 8; kvrow = rc & 255; lat = false; } \
                const int ch = lane * 8; \
                { float y[8]; \
                  _Pragma("unroll") for (int i = 0; i < 4; ++i) { \
                      const float w0a = cw[0][i >> 1][(2 * i) & 3], w1a = cw[1][i >> 1][(2 * i) & 3], w2a = cw[2][i >> 1][(2 * i) & 3]; \
                      const float w0b = cw[0][i >> 1][(2 * i + 1) & 3], w1b = cw[1][i >> 1][(2 * i + 1) & 3], w2b = cw[2][i >> 1][(2 * i + 1) & 3]; \
                      y[2 * i] = bf_lo(R.gb[i]) * (w0a * (bf_lo(R.pc[i]) * bf_lo(R.pv[i])) + w1a * (bf_lo(R.zc[i]) * bf_lo(R.zv[i])) + w2a * (bf_lo(R.nc[i]) * bf_lo(R.nv[i]))); \
                      y[2 * i + 1] = bf_hi(R.gb[i]) * (w0b * (bf_hi(R.pc[i]) * bf_hi(R.pv[i])) + w1b * (bf_hi(R.zc[i]) * bf_hi(R.zv[i])) + w2b * (bf_hi(R.nc[i]) * bf_hi(R.nv[i]))); } \
                  u32x4 w; PACK8(y, w); *(u32x4*)(Y + (size_t)row_ * DM + 512 + ch) = w; } \
                { float o[8]; HEADNORM(R.nq, gq_, o); u32x4 w; PACK8(o, w); *(u32x4*)(NQ + (size_t)row_ * 512 + ch) = w; } \
                { float o[8]; HEADNORM(R.nk, gk_, o); u32x4 w; PACK8(o, w); *(u32x4*)(NK + ((size_t)b * KVL + kvrow) * 512 + ch) = w; } \
                { float o[8]; HEADNORM(R.gq, hq_, o); if (lat) ROPE8(o, R); u32x4 w; PACK8(o, w); *(u32x4*)(GQ + (size_t)row_ * 512 + ch) = w; } \
                { float o[8]; HEADNORM(R.gk, hk_, o); if (lat) ROPE8(o, R); u32x4 w; PACK8(o, w); \
                  if (lane < 32) *(u32x4*)(GK + ((size_t)b * KVL + kvrow) * 256 + ch) = w; } } while (0)
            for (int row = gw; row < RT; row += 2 * NGW) {
                const int rowB = row + NGW; const bool hasB = rowB < RT;
                PrepRaw ra, rb;
                PREP_LOAD(row, ra); PREP_LOAD(hasB ? rowB : row, rb);
                PREP_ROW(row, ra);
                if (hasB) PREP_ROW(rowB, rb);
            }
#undef PREP_LOAD
#undef PREP_ROW
#undef HEADNORM
#undef ROPE8
#undef PACK8
            if (layer == 0) { LAS bf16_t* tscr = (LAS bf16_t*)(lds + wave * 8704);
              CDF_WAIT(4, 16);
              for (int item = (RL / 64) * 16 + gw; item < (RT / 64) * 16; item += NGW) {
                  const int rb = item >> 4, cb = item & 15, r0 = rb * 64, c0 = cb * 64;
#pragma unroll
                  for (int i = 0; i < 8; ++i) { const int rr = 8 * i + (lane >> 3), c8 = (lane & 7) * 8; const u32x4 v = *(const u32x4*)(PF + (size_t)(r0 + rr) * PFW + c0 + c8);
#pragma unroll
                      for (int k = 0; k < 4; ++k) { tscr[(c8 + 2 * k) * 66 + rr] = (bf16_t)(v[k] & 0xffffu); tscr[(c8 + 2 * k + 1) * 66 + rr] = (bf16_t)(v[k] >> 16); } }
                  LDS_WAIT();
#pragma unroll
                  for (int i = 0; i < 8; ++i) { const int cc = 8 * i + (lane >> 3), l8 = (lane & 7) * 8; const LAS unsigned* s = (const LAS unsigned*)(tscr + cc * 66 + l8);
                      u32x4 w; w.x = s[0]; w.y = s[1]; w.z = s[2]; w.w = s[3];
                      const int cg = c0 + cc; const int cm = cg & 511, sn = cg >> 9;
                      const int rc0 = r0 - RL, b = rc0 >> 8, l0 = rc0 & 255; *(u32x4*)(PTC + ((size_t)b * 512 + cm) * 512 + sn * 256 + l0 + l8) = w; }
                  LDS_WAIT();
              } }
            __syncthreads();
            for (int u = wg; u < NB * 64; u += G) {
                const int b = u >> 6, l2 = u & 63;
                const bf16_t* M1 = (const bf16_t*)(wsb + WS_FFT); const float* TW = (const float*)(wsb + WS_FFT + 49152); bf16_t* O1 = (bf16_t*)(wsb + WS_T);
                __syncthreads();
                cdft_to_slab(lds, P + ((size_t)b * SEQ + l2) * NP, (size_t)64 * NP, (const bf16_t*)(wsb + WS_MB) + (size_t)layer * PFW * NP, NP);
                auto rowp = [=](int) -> const bf16_t* { return nullptr; };
                auto epi = [=](int mbp, const f32x16 (&acc)[2][2], int wid, int r32, int hi) {
#pragma unroll
                        for (int r = 0; r < 16; ++r) { const int k1 = 32 * mbp + att::crow(r, hi); const f32x2 tw = *(const f32x2*)(TW + 2 * ((k1 * l2) & 4095));
                            bf16_t* o = O1 + ((((size_t)b * 64 + k1) * 2) * 64 + l2) * 512 + 64 * wid + r32;
#pragma unroll
                            for (int nb = 0; nb < 2; ++nb) { const float ur = acc[0][nb][r], ui = acc[1][nb][r]; const float vr = ur * tw.x + ui * tw.y, vi = ui * tw.x - ur * tw.y;
                                o[32 * nb] = (bf16_t)(cvt_pk_bf16(vr, vr) & 0xffffu); o[64 * 512 + 32 * nb] = (bf16_t)(cvt_pk_bf16(vi, vi) & 0xffffu); } } };
                fft_stage<2, false>(lds, M1, rowp, epi);
            }
#undef CDF_WAIT
        }
        SEAM(pb + 2);

        DUP(3) if (EN(3) && IN(pb + 3)) {
            PHASE_IDS();
            unsigned char* wsb = WSB(); bf16_t* Y = (bf16_t*)(wsb + WS_Y);
            const bf16_t* NQ = (const bf16_t*)(wsb + WS_NQ); const bf16_t* NK = (const bf16_t*)(wsb + WS_NK); const bf16_t* NV = (const bf16_t*)(wsb + WS_NV); const bf16_t* GQ = (const bf16_t*)(wsb + WS_GQ); const bf16_t* GK = (const bf16_t*)(wsb + WS_GK); const bf16_t* GV = (const bf16_t*)(wsb + WS_GV);
            const bf16_t* PTC = (const bf16_t*)(wsb + WS_PTC); const bf16_t* Tc = (const bf16_t*)(wsb + WS_TC);
            LAS float* rpbL = (LAS float*)(lds + RPB_OFF);
            if (MX(0)) for (int u = wg; u < NB * 64; u += G) {
                const int b = u >> 6, k1 = u & 63;
                const bf16_t* M2 = (const bf16_t*)(wsb + WS_FFT) + 128 * 128; const bf16_t* O1 = (const bf16_t*)(wsb + WS_T) + ((size_t)b * 64 + k1) * 2 * 64 * 512;
                auto rowp = [=](int kk) -> const bf16_t* { return O1 + (size_t)kk * 512; };
                auto epi = [=](int, const f32x16 (&acc)[2][2], int wid, int r32, int hi) {
#pragma unroll
                    for (int mb = 0; mb < 2; ++mb)
#pragma unroll
                        for (int r = 0; r < 16; ++r) { const int k2 = 32 * mb + att::crow(r, hi); bf16_t* o = Y + ((size_t)b * SEQ + k1 + 64 * k2) * DM + 64 * wid + r32;
#pragma unroll
                            for (int nb = 0; nb < 2; ++nb) { const float v = acc[mb][nb][r]; o[32 * nb] = (bf16_t)(cvt_pk_bf16(v, v) & 0xffffu); } } };
                fft_stage<1>(lds, M2, rowp, epi);
            }
            if (MX(5) && layer == 0) { pg8::Gemm g{Tc, PTC, 2 * 512}; pg8::DftOrder S{wg, 1}; pg8::EpiStoreBf16 E{Y, DM}; pg8::gemm_phase<pg8::EpiStoreBf16, pg8::DftOrder>(lds, g, S, E); }
            __syncthreads();
            if (MX(1)) for (int uu = wg; uu < 256; uu += G) {
                const int qb = uu & 15, h = (uu >> 4) & 3, b = uu >> 6;
                __syncthreads();
                for (int i = tid; i < 465; i += 512) rpbL[i] = INP(I_RPB)[(size_t)(layer * 4 + h) * 465 + i] * att::LOG2E;
                __syncthreads();
                const int r0 = qb * 4;
                const int rs_lo = min(max(r0 - 4, 0), 56), rs_hi = min(max(r0 + 3 - 4, 0), 56);
                int rlo = rs_lo, rhi = rs_hi + 7; if (((rhi - rlo + 1) & 1) != 0) { if (rhi < 63) ++rhi; else --rlo; }
                const int NT = 4 + (rhi - rlo + 1);
                attn_na_call(NQ + ((size_t)b * SEQ + qb * 256) * 512 + h * 128, NK + (size_t)b * KVL * 512 + h * 128, NV + (size_t)b * KVL * 512 + h * 128, Y + ((size_t)b * SEQ + qb * 256) * DM + 1024 + h * 128, NT, r0, rlo);
            }
            if (MX(2)) {
                const int w2 = (wg & 15) == 0 ? 2 * (wg >> 4) : (wg & 15) == 15 ? 2 * (wg >> 4) + 1 : -1;
                const int nun = 1 + ((layer == 0 && w2 >= 0) ? 1 : 0);
                for (int i = 0; i < nun; ++i) {
                    const bf16_t *qp, *kp, *vp; bf16_t* op; int ldk, nt;
                    if (i < 1) { const int uu = wg & 255, qb = uu & 15, h = (uu >> 4) & 3, b = uu >> 6, kvh = h >> 1;
                        qp = GQ + ((size_t)b * SEQ + qb * 256) * 512 + h * 128; kp = GK + (size_t)b * KVL * 256 + kvh * 128; vp = GV + (size_t)b * KVL * 256 + kvh * 128;
                        op = Y + ((size_t)b * SEQ + qb * 256) * DM + 1536 + h * 128; ldk = 256; nt = KVL / 64; }
                    else if (w2 < 16) { const int h = w2 & 3, b = w2 >> 2, kvh = h >> 1;
                        qp = GQ + ((size_t)RL + b * CTXL) * 512 + h * 128; kp = GK + (size_t)b * KVL * 256 + kvh * 128; vp = GV + (size_t)b * KVL * 256 + kvh * 128;
                        op = Y + ((size_t)RL + b * CTXL) * DM + 1536 + h * 128; ldk = 256; nt = CTXL / 64; }
                    else { const int h = w2 & 3, b = (w2 - 16) >> 2;
                        qp = NQ + ((size_t)RL + b * CTXL) * 512 + h * 128; kp = NK + (size_t)b * KVL * 512 + h * 128; vp = NV + (size_t)b * KVL * 512 + h * 128;
                        op = Y + ((size_t)RL + b * CTXL) * DM + 1024 + h * 128; ldk = 512; nt = CTXL / 64; }
                    attn_dense_call(qp, kp, vp, op, nt, ldk);
                }
            }
        }
        SEAM(pb + 3);

        DUP(4) if (EN(4) && IN(pb + 4)) {
            LAYER_PTRS(); XIN_PTRS(); const bf16_t* Y = (const bf16_t*)(wsb + WS_Y); const bf16_t* Wout_t = (const bf16_t*)(wsb + WS_WOUT); bf16_t* Xmid = (bf16_t*)(wsb + WS_X1);
            pg8::Gemm g{Y, Wout_t + (size_t)layer * DM * DM, 2 * DM};
            pg8::GridOrder S; S.init((layer == 0 ? RT : RL) / 256, DM / 256, G, wg, 0, 0, 0, 0, 256);
            pg8::EpiResid E{xin_lat, xin_ctx, xin_b, Xmid, modl + 2 * 2048, 1.0f};
            pg8::gemm_phase<pg8::EpiResid, pg8::GridOrder>(lds, g, S, E);
            { const int def_ = DEFICIT(((layer == 0 ? RT : RL) / 256) * (DM / 256)); if (def_ > 0) MOE_GRAB(def_ * 14); }
        }
        SEAM(pb + 4);

        if (EN(5) && IN(pb + 5)) {
            PHASE_IDS();
            LAYER_PTRS(); const bf16_t* Xmid = (const bf16_t*)(wsb + WS_X1); unsigned char* HB8 = (unsigned char*)(wsb + WS_HB);
            int* route_pos = (int*)(wsb + WS_ROUTE + 256 * 1024);
            const float* gn = INP(I_N2G) + layer * DM;
            LAS float* wrL = (LAS float*)(lds + ROUTER_LDS);
            if (layer == 1) { for (int i = tid; i < 2048 * 8; i += 512) wrL[i] = INP(I_ROUTER)[i]; __syncthreads(); }
            const int nrows = layer == 0 ? RT : RL;
            f32x4 gv[8];
#pragma unroll
            for (int j = 0; j < 8; ++j) gv[j] = *(const f32x4*)(gn + lane * 4 + 256 * j);
            for (int row0 = gw; row0 < nrows; row0 += 2 * NGW) {
                const int rowB = row0 + NGW; const bool hasB = rowB < nrows; const int rb_ = hasB ? rowB : row0;
                u32x2 va[8], vb[8];
#pragma unroll
                for (int j = 0; j < 8; ++j) va[j] = *(const u32x2*)(Xmid + (size_t)row0 * DM + lane * 4 + 256 * j);
#pragma unroll
                for (int j = 0; j < 8; ++j) vb[j] = *(const u32x2*)(Xmid + (size_t)rb_ * DM + lane * 4 + 256 * j);
#pragma unroll 1
                for (int half = 0; half < 2; ++half) {
                if (half == 1 && !hasB) break;
                const int row = half ? rowB : row0;
                f32x4 v[8];
#pragma unroll
                for (int j = 0; j < 8; ++j) v[j] = bf4(half ? vb[j] : va[j]);
                const int mr = row < RL ? (row >> 12) : 4;
                const float* sh = modl + (size_t)mr * 12288 + 3 * 2048; const float* sc = sh + 2048;
                float ss = 0.f;
#pragma unroll
                for (int j = 0; j < 8; ++j) ss += (v[j][0] * v[j][0] + v[j][1] * v[j][1]) + (v[j][2] * v[j][2] + v[j][3] * v[j][3]);
                const float rinv = rsqrtf(wave_sum(ss) * (1.0f / DM) + NORM_EPS);
                float lg[8] = {0.f, 0.f, 0.f, 0.f, 0.f, 0.f, 0.f, 0.f};
                unsigned hq[8];
#pragma unroll
                for (int j = 0; j < 8; ++j) { const int c = lane * 4 + 256 * j; const f32x4 g = gv[j], s1 = *(const f32x4*)(sc + c), s0 = *(const f32x4*)(sh + c);
                    const f32x4 h = v[j] * rinv * g * (s1 + 1.0f) + s0;
                    hq[j] = pk4_fp8(h[0] * F8_SH, h[1] * F8_SH, h[2] * F8_SH, h[3] * F8_SH);
                    if (layer == 0) *(unsigned*)(HB8 + (size_t)row * DM + c) = hq[j];
                    if (layer == 1) {
#pragma unroll
                        for (int k = 0; k < 4; ++k) { const f32x4 wa = *(const LAS f32x4*)(wrL + (c + k) * 8), wb = *(const LAS f32x4*)(wrL + (c + k) * 8 + 4);
                            lg[0] += h[k] * wa[0]; lg[1] += h[k] * wa[1]; lg[2] += h[k] * wa[2]; lg[3] += h[k] * wa[3]; lg[4] += h[k] * wb[0]; lg[5] += h[k] * wb[1]; lg[6] += h[k] * wb[2]; lg[7] += h[k] * wb[3]; } } }
                if (layer == 1) {
#pragma unroll
                    for (int e = 0; e < 8; ++e) lg[e] = wave_sum(lg[e]);
                    int i0 = 0; float v0 = lg[0];
#pragma unroll
                    for (int e = 1; e < 8; ++e) if (lg[e] > v0) { v0 = lg[e]; i0 = e; }
                    int i1 = -1; float v1 = -3.0e38f;
#pragma unroll
                    for (int e = 0; e < 8; ++e) if (e != i0 && lg[e] > v1) { v1 = lg[e]; i1 = e; }
                    const float w0 = 1.0f / (1.0f + __expf(v1 - v0)), w1 = 1.0f - w0;
                    int d0 = 0, d1 = 0;
                    if (lane == 0) {
                        const unsigned p0 = atomicAdd(ctl + CW_CNT + 64 * i0, 1u), p1 = atomicAdd(ctl + CW_CNT + 64 * i1, 1u);
                        unsigned* t0w = ctl + CW_TILE + 64 * i0 + (p0 >> 8); unsigned* t1w = ctl + CW_TILE + 64 * i1 + (p1 >> 8);
                        unsigned q0 = 0, q1 = 0;
                        if ((p0 & 255u) == 0u) { q0 = atomicAdd(ctl + CW_POOL, 1u) + 1u; __hip_atomic_store(t0w, q0, RLX_AGENT); }
                        if ((p1 & 255u) == 0u) { q1 = atomicAdd(ctl + CW_POOL, 1u) + 1u; __hip_atomic_store(t1w, q1, RLX_AGENT); }
                        while (q0 == 0u) { q0 = __hip_atomic_load(t0w, RLX_AGENT); if (q0 == 0u) __builtin_amdgcn_s_sleep(1); }
                        while (q1 == 0u) { q1 = __hip_atomic_load(t1w, RLX_AGENT); if (q1 == 0u) __builtin_amdgcn_s_sleep(1); }
                        d0 = (int)((q0 - 1u) * 256u + (p0 & 255u)); d1 = (int)((q1 - 1u) * 256u + (p1 & 255u));
                        route_pos[2 * row] = d0; route_pos[2 * row + 1] = d1; }
                    d0 = __builtin_amdgcn_readfirstlane(d0); d1 = __builtin_amdgcn_readfirstlane(d1);
                    unsigned char* APERM8 = wsb + WS_APERM; float* roww = (float*)(wsb + WS_ROUTE + 384 * 1024);
                    { const size_t d = (size_t)d0;
#pragma unroll
                        for (int j = 0; j < 8; ++j) *(unsigned*)(APERM8 + d * DM + lane * 4 + 256 * j) = hq[j];
                        if (lane == 0) roww[d] = w0; }
                    { const size_t d = (size_t)d1;
#pragma unroll
                        for (int j = 0; j < 8; ++j) *(unsigned*)(APERM8 + d * DM + lane * 4 + 256 * j) = hq[j];
                        if (lane == 0) roww[d] = w1; }
                }
                }
            }
            if (layer == 1) MOE_DRAIN(CW_QUP, 0, NT_MUP);
            __syncthreads();
        }
        SEAM(pb + 5);

        if (layer == 0) {
            DUP(7) if (EN(7) && IN(pb + 7)) {
                unsigned char* wsb = WSB(); const unsigned char* HB8 = wsb + WS_HB; const unsigned char* Wup8 = wsb + WS_WUP; unsigned char* ACT8 = wsb + WS_ACT;
                pg8::Gemm g{HB8, Wup8, DM};
                pg8::GridOrder S; S.init(RT / 256, 2 * DFF / 256, G, wg, 0, 0, 0, 0, 128);
                pg8::EpiSwiglu8 E{ACT8, DFF, 1.0f / (F8_SW * F8_SH), F8_SA};
                pg8::gemm_phase<pg8::EpiSwiglu8, pg8::GridOrder, true>(lds, g, S, E);
                { const int def_ = DEFICIT((RT / 256) * (2 * DFF / 256)); if (def_ > 0) MOE_GRAB(def_ * 7); }
            }
            SEAM(pb + 7);
            DUP(8) if (EN(8) && IN(pb + 8)) {
                LAYER_PTRS(); const unsigned char* ACT8 = wsb + WS_ACT; const unsigned char* Wdn8 = wsb + WS_WDN; const bf16_t* Xmid = (const bf16_t*)(wsb + WS_X1); bf16_t* X2 = (bf16_t*)(wsb + WS_X2);
                pg8::Gemm g{ACT8, Wdn8, DFF};
                pg8::GridOrder S; S.init(RT / 256, DM / 256, G, wg, 0, 0, 0, 0, 256);
                pg8::EpiResid E{nullptr, nullptr, Xmid, X2, modl + 5 * 2048, 1.0f / (F8_SW * F8_SA)};
                pg8::gemm_phase<pg8::EpiResid, pg8::GridOrder, true>(lds, g, S, E);
                { const int def_ = DEFICIT((RT / 256) * (DM / 256)); if (def_ > 0) MOE_GRAB(def_ * 20); }
            }
            SEAM(pb + 8);
        } else {
            volatile LAS int* tb = (volatile LAS int*)(MISC + 16); volatile LAS int* tl = (volatile LAS int*)(lds + TL_OFF);
            if (IN(pb + 7) || IN(pb + 8) || IN(pb + 9)) {
                __syncthreads();
                if (tid == 0) { int acc = 0; for (int e = 0; e < 8; ++e) { tb[e] = acc; const int c = (int)__hip_atomic_load(ctl + CW_CNT + 64 * e, RLX_AGENT); acc += (c + 255) >> 8; } tb[8] = acc; }
                __syncthreads();
                { int t_ = (int)threadIdx.x; asm volatile("" : "+v"(t_)); const int e = t_ >> 6, j = t_ & 63; if (j < tb[e + 1] - tb[e]) tl[tb[e] + j] = (int)__hip_atomic_load(ctl + CW_TILE + 64 * e + j, RLX_AGENT) - 1; }
                __syncthreads();
            }
            DUP(11) if (EN(11) && IN(pb + 7)) {
                unsigned char* wsb = WSB(); const unsigned char* APERM8 = wsb + WS_APERM; const unsigned char* Mup8 = wsb + WS_MUP; unsigned char* ACTM8 = wsb + WS_ACTM;
                pg8::Gemm g{APERM8, Mup8, DM};
                pg8::MoeOrder S{G, wg, 2 * DFE / 256, 128, 2 * DFE, tb, tl};
                pg8::EpiSwiglu8 E{ACTM8, DFE, 1.0f / (F8_SW * F8_SH), F8_SA};
                pg8::gemm_phase<pg8::EpiSwiglu8, pg8::MoeOrder, true>(lds, g, S, E);
                {
                    constexpr int MOE_SKEW = 10;
                    const int rem_ = (tb[8] * (2 * DFE / 256)) % G; const int nearly = rem_ > 0 ? G - rem_ : 0;
                    __syncthreads(); if (threadIdx.x == 0) MISC[40] = __hip_atomic_load(ctl + CW_QDN, RLX_AGENT); __syncthreads();
                    const int s0_ = min(__builtin_amdgcn_readfirstlane((int)MISC[40]), NT_MDN); const int left_ = NT_MDN - s0_;
                    const int ex_ = nearly > 0 ? min(MOE_SKEW, left_ / nearly) : 0; const int b0_ = NT_MUP + s0_;
                    if (ex_ > 0 && wg >= rem_) moe_convert(PTRS, (LAS unsigned*)lds, b0_ + (wg - rem_) * ex_, b0_ + (wg - rem_) * ex_ + ex_, 1);
                    moe_convert(PTRS, (LAS unsigned*)lds, b0_ + nearly * ex_ + wg, NT_MUP + NT_MDN, G);
                }
            }
            SEAM(pb + 7);
            DUP(12) if (EN(12) && IN(pb + 8)) {
                unsigned char* wsb = WSB(); const unsigned char* ACTM8 = wsb + WS_ACTM; const unsigned char* Mdn8 = wsb + WS_MDN; bf16_t* OPERM = (bf16_t*)(wsb + WS_OPERM); const float* roww = (const float*)(wsb + WS_ROUTE + 384 * 1024);
                pg8::Gemm g{ACTM8, Mdn8, DFE};
                const int T_ = tb[8] * (DM / 256), F_ = T_ / G, rem_ = T_ % G;
                const int KS = (rem_ > 0 && rem_ * 4 <= G) ? 4 : (rem_ > 0 && rem_ * 2 <= G) ? 2 : 1;
                pg8::MoeOrder S{G, wg, DM / 256, 256, DM, tb, tl, KS > 1 ? F_ * G : 0x7fffffff};
                pg8::EpiMoeDown E{OPERM, roww, 1.0f / (F8_SW * F8_SA)};
                pg8::gemm_phase<pg8::EpiMoeDown, pg8::MoeOrder, true>(lds, g, S, E);
                if (KS > 1) {
                    const int j = wg / KS, q = wg % KS; const bool mine = j < rem_;
                    float* slab = (float*)(wsb + WS_APERM) + (size_t)(j * KS + q) * 65536;
                    pg8::MoeTailOrder TS{S, mine ? F_ * G + j : -1};
                    pg8::Gemm g2{ACTM8 + q * (DFE / KS), Mdn8 + q * (DFE / KS), DFE, DFE / KS};
                    pg8::EpiPartial E2{slab};
                    pg8::gemm_phase<pg8::EpiPartial, pg8::MoeTailOrder, true>(lds, g2, TS, E2);
                    if (mine) {
                        if (threadIdx.x == 0) { __builtin_amdgcn_fence(__ATOMIC_RELEASE, "agent"); asm volatile("s_waitcnt vmcnt(0)" ::: "memory");
                            (void)xb_add(ctl + CW_KS + j, 1u);
                            while (xb_ld(ctl + CW_KS + j) < (unsigned)KS) __builtin_amdgcn_s_sleep(1);
                            __builtin_amdgcn_fence(__ATOMIC_ACQUIRE, "agent"); asm volatile("s_waitcnt vmcnt(0)" ::: "memory"); }
                        __syncthreads();
                        {   pg8::Unit u; (void)S.unit(F_ * G + j, u);
                            int t_ = (int)threadIdx.x; asm volatile("" : "+v"(t_));
                            const int rpw = 256 / KS;
                            const int r = q * rpw + t_ / (512 / rpw), ncol = 256 / (512 / rpw), hc = (t_ % (512 / rpw)) * ncol;
                            const float rw = roww[u.orow + r] * (1.0f / (F8_SW * F8_SA));
                            const float* sp = (const float*)(wsb + WS_APERM) + (size_t)(j * KS) * 65536 + (size_t)r * 256 + hc; bf16_t* op = OPERM + (size_t)(u.orow + r) * DM + u.ocol + hc;
#pragma unroll 4
                            for (int c8 = 0; c8 < ncol / 8; ++c8) { f32x4 a0 = {0.f, 0.f, 0.f, 0.f}, a1 = {0.f, 0.f, 0.f, 0.f};
                                for (int qq = 0; qq < KS; ++qq) { a0 += *(const f32x4*)(sp + (size_t)qq * 65536 + c8 * 8); a1 += *(const f32x4*)(sp + (size_t)qq * 65536 + c8 * 8 + 4); }
                                a0 *= rw; a1 *= rw;
                                u32x4 w; w.x = cvt_pk_bf16(a0[0], a0[1]); w.y = cvt_pk_bf16(a0[2], a0[3]); w.z = cvt_pk_bf16(a1[0], a1[1]); w.w = cvt_pk_bf16(a1[2], a1[3]);
                                *(u32x4*)(op + c8 * 8) = w; }
                        }
                        __syncthreads();
                    }
                }
            }
            SEAM(pb + 8);
            DUP(9) if (EN(9) && IN(pb + 9)) {
            PHASE_IDS();
                LAYER_PTRS(); const bf16_t* Xmid = (const bf16_t*)(wsb + WS_X1); const bf16_t* OPERM = (const bf16_t*)(wsb + WS_OPERM); float* outp = OUTP();
                const int* route_pos = (const int*)(wsb + WS_ROUTE + 256 * 1024);
                for (int t = gw; t < RL; t += 2 * NGW) {
                    const int tB = t + NGW; const bool hasB = tB < RL; const int tb_ = hasB ? tB : t;
                    const int a0 = route_pos[2 * t], a1 = route_pos[2 * t + 1];
                    const int c0 = route_pos[2 * tb_], c1 = route_pos[2 * tb_ + 1];
                    u32x2 xa[8], xb[8]; u32x2 pa0[8], pa1[8], pb0[8], pb1[8];
#pragma unroll
                    for (int j = 0; j < 8; ++j) { const int c = lane * 4 + 256 * j; xa[j] = *(const u32x2*)(Xmid + (size_t)t * DM + c); pa0[j] = *(const u32x2*)(OPERM + (size_t)a0 * DM + c); pa1[j] = *(const u32x2*)(OPERM + (size_t)a1 * DM + c); }
#pragma unroll
                    for (int j = 0; j < 8; ++j) { const int c = lane * 4 + 256 * j; xb[j] = *(const u32x2*)(Xmid + (size_t)tb_ * DM + c); pb0[j] = *(const u32x2*)(OPERM + (size_t)c0 * DM + c); pb1[j] = *(const u32x2*)(OPERM + (size_t)c1 * DM + c); }
                    { const float* g2 = modl + (size_t)(t >> 12) * 12288 + 5 * 2048;
#pragma unroll
                      for (int j = 0; j < 8; ++j) { const int c = lane * 4 + 256 * j; const f32x4 gg = *(const f32x4*)(g2 + c); const u32x2 a = pa0[j], b = pa1[j]; const f32x4 x = bf4(xa[j]);
                        f32x4 o; o[0] = x[0] + gg[0] * (bf_lo(a.x) + bf_lo(b.x)); o[1] = x[1] + gg[1] * (bf_hi(a.x) + bf_hi(b.x)); o[2] = x[2] + gg[2] * (bf_lo(a.y) + bf_lo(b.y)); o[3] = x[3] + gg[3] * (bf_hi(a.y) + bf_hi(b.y));
                        *(f32x4*)(outp + (size_t)t * DM + c) = o; } }
                    if (hasB) { const float* g2 = modl + (size_t)(tB >> 12) * 12288 + 5 * 2048;
#pragma unroll
                      for (int j = 0; j < 8; ++j) { const int c = lane * 4 + 256 * j; const f32x4 gg = *(const f32x4*)(g2 + c); const u32x2 a = pb0[j], b = pb1[j]; const f32x4 x = bf4(xb[j]);
                        f32x4 o; o[0] = x[0] + gg[0] * (bf_lo(a.x) + bf_lo(b.x)); o[1] = x[1] + gg[1] * (bf_hi(a.x) + bf_hi(b.x)); o[2] = x[2] + gg[2] * (bf_lo(a.y) + bf_lo(b.y)); o[3] = x[3] + gg[3] * (bf_hi(a.y) + bf_hi(b.y));
                        *(f32x4*)(outp + (size_t)tB * DM + c) = o; } }
                }
            }
        }
    }
#undef IN
#undef SEAM
}

template <unsigned PM, unsigned MM> static int prep_kernel() {
    if (hipFuncSetAttribute((const void*)mk_fwd<PM, MM>, hipFuncAttributeMaxDynamicSharedMemorySize, LDS_BYTES) != hipSuccess) { fprintf(stderr, "kernel_launch: hipFuncSetAttribute failed\n"); return -1; }
    return 0;
}
template <unsigned PM, unsigned MM> static void launch_ph(int grid, Args a, int lo, int hi, hipStream_t stream) {
    static int ok = 0; if (ok == 0) ok = prep_kernel<PM, MM>() == 0 ? 1 : -1; if (ok < 0) return;
    a.ph_lo = lo; a.ph_hi = hi;
    hipLaunchKernelGGL((mk_fwd<PM, MM>), dim3(grid), dim3(512), LDS_BYTES, stream, a);
}
extern "C" void kernel_launch(void* const* d_in, const int* in_sizes, int n_in, void* d_out, int out_size, void* d_ws, size_t ws_size, hipStream_t stream) {
    static int grid = 0;
    if (grid == 0) {
        if (n_in != 24 || out_size != RL * DM || ws_size < WS_END) { fprintf(stderr, "kernel_launch: unexpected shapes (n_in %d out %d ws %zu need %zu)\n", n_in, out_size, ws_size, (size_t)WS_END); grid = -1; return; }
        int dev = 0, cus = 0;
        if (hipGetDevice(&dev) != hipSuccess || hipDeviceGetAttribute(&cus, hipDeviceAttributeMultiprocessorCount, dev) != hipSuccess) { grid = -1; return; }
        grid = cus;
    }
    if (grid < 0) return;
    (void)hipMemsetAsync((char*)d_ws + WS_CTL, 0, CTL_ZERO_BYTES, stream);
    Args a{};
    for (int i = 0; i < 24; ++i) a.in[i] = (const float*)d_in[i];
    a.out = (float*)d_out; a.ws = (unsigned char*)d_ws;
#if MK_ONE_LAUNCH
    launch_ph<0xFFFFFFFFu, 0xFFu>(grid, a, 0, 21, stream);
#else
    launch_ph<1u << 10, 0>(grid, a, 0, 1, stream);
    for (int l = 0; l < 2; ++l) { const int pb = 1 + 10 * l;
        launch_ph<1u << 0, 0>(grid, a, pb + 0, pb + 1, stream);
        launch_ph<1u << 1, 0>(grid, a, pb + 1, pb + 2, stream);
        launch_ph<1u << 2, 0>(grid, a, pb + 2, pb + 3, stream);
        launch_ph<1u << 3, 1u>(grid, a, pb + 3, pb + 4, stream);
        if (l == 0) launch_ph<1u << 3, 32u>(grid, a, pb + 3, pb + 4, stream);
        launch_ph<1u << 3, 2u>(grid, a, pb + 3, pb + 4, stream);
        launch_ph<1u << 3, 4u>(grid, a, pb + 3, pb + 4, stream);
        launch_ph<1u << 4, 0>(grid, a, pb + 4, pb + 5, stream);
        launch_ph<1u << 5, 0>(grid, a, pb + 5, pb + 6, stream);
        if (l == 0) { launch_ph<1u << 7, 0>(grid, a, pb + 7, pb + 8, stream); launch_ph<1u << 8, 0>(grid, a, pb + 8, pb + 9, stream); }
        else { launch_ph<1u << 11, 0>(grid, a, pb + 7, pb + 8, stream); launch_ph<1u << 12, 0>(grid, a, pb + 8, pb + 9, stream); launch_ph<1u << 9, 0>(grid, a, pb + 9, pb + 10, stream); }
    }
#endif
}
```
